# Optimizing an MI355X kernel written in HIP

```python
import jax, jax.numpy as jnp
from jax import lax
import numpy as np

D_MODEL = 1024
BATCH = 8
SEQ = 2048
DEPTH = 1

HEAD_DIM = 64
N_HEADS_A = D_MODEL // (2 * HEAD_DIM)
N_HEADS_B = D_MODEL // (2 * HEAD_DIM)
WIDTH_A = N_HEADS_A * HEAD_DIM
WIDTH_B = N_HEADS_B * HEAD_DIM
MIX_WIDTH = WIDTH_A + WIDTH_B
IN_WIDTH = 2 * WIDTH_A + 3 * WIDTH_B
CHUNK = 128
MOBA_BLOCK = 256
MOBA_TOPK = 3
Q_BLOCK = 128
D_FF = -(-8 * D_MODEL // (3 * 256)) * 256
EPS = 1e-6

kernel_name = "hymba_sgu_moba_hybrid_layer"


def rms_norm(x, g):
    xf = x.astype(jnp.float32)
    y = xf * lax.rsqrt(jnp.mean(xf * xf, axis=-1, keepdims=True) + EPS)
    return (y * g.astype(jnp.float32)).astype(x.dtype)


def layer_norm(x, g, b):
    xf = x.astype(jnp.float32)
    mu = jnp.mean(xf, axis=-1, keepdims=True)
    var = jnp.mean(jnp.square(xf - mu), axis=-1, keepdims=True)
    y = (xf - mu) * lax.rsqrt(var + EPS)
    return (y * g.astype(jnp.float32) + b.astype(jnp.float32)).astype(x.dtype)


def chunked_sgu(u, v, ln_g, ln_b, w_s, b_s):
    B, S, _ = u.shape
    u = jax.nn.gelu(u)
    v = jax.nn.gelu(v).reshape(B, S, N_HEADS_A, HEAD_DIM)
    v = layer_norm(v, ln_g.reshape(N_HEADS_A, HEAD_DIM), ln_b.reshape(N_HEADS_A, HEAD_DIM))
    v = v.reshape(B, S // CHUNK, CHUNK, N_HEADS_A, HEAD_DIM)
    causal = jnp.tril(jnp.ones((CHUNK, CHUNK), dtype=bool))
    w = jnp.where(causal[None], w_s, 0)
    mixed = jnp.einsum('hts,bcshd->bcthd', w, v) + b_s.T[None, None, :, :, None]
    return u * mixed.reshape(B, S, WIDTH_A)


def to_qblocks(a):
    B, H, S = a.shape[:3]
    a = a.reshape(B, H, S // Q_BLOCK, Q_BLOCK, *a.shape[3:])
    return jnp.moveaxis(a, 2, 0)


def moba_attention(q, k, v, q_g, k_g):
    B, S, _ = q.shape
    H = N_HEADS_B
    q = rms_norm(q.reshape(B, S, H, HEAD_DIM), q_g).transpose(0, 2, 1, 3)
    k = rms_norm(k.reshape(B, S, H, HEAD_DIM), k_g).transpose(0, 2, 1, 3)
    v = v.reshape(B, S, H, HEAD_DIM).transpose(0, 2, 1, 3)
    nb = -(-S // MOBA_BLOCK)
    pad = nb * MOBA_BLOCK - S
    padw = ((0, 0), (0, 0), (0, pad), (0, 0))
    kb = jnp.pad(k, padw).reshape(B, H, nb, MOBA_BLOCK, HEAD_DIM)
    vb = jnp.pad(v, padw).reshape(B, H, nb, MOBA_BLOCK, HEAD_DIM)
    k_mean = jnp.mean(kb, axis=3)

    q_blk = jnp.arange(S) // MOBA_BLOCK
    past = jnp.arange(nb)[None, :] < q_blk[:, None]
    gate = jnp.einsum('bhsd,bhnd->bhsn', q, k_mean).astype(jnp.float32)
    gate = jnp.where(past[None, None], gate, -jnp.inf)
    topk = min(MOBA_TOPK, nb)
    g_vals, g_idx = lax.top_k(gate, topk)
    g_valid = jnp.isfinite(g_vals)

    scale = HEAD_DIM ** -0.5
    nq = S // Q_BLOCK
    bi = jnp.arange(B)[:, None, None, None]
    hi = jnp.arange(H)[None, :, None, None]
    sel_len = topk * MOBA_BLOCK

    def block_fn(args):
        q_c, idx_c, valid_c, c = args
        q0 = c * Q_BLOCK
        own = q0 // MOBA_BLOCK
        k_sel = kb[bi, hi, idx_c]
        v_sel = vb[bi, hi, idx_c]
        s_sel = jnp.einsum('bhqd,bhqjkd->bhqjk', q_c, k_sel).astype(jnp.float32) * scale
        s_sel = jnp.where(valid_c[..., None], s_sel, -jnp.inf).reshape(B, H, Q_BLOCK, sel_len)
        k_own = lax.dynamic_index_in_dim(kb, own, axis=2, keepdims=False)
        v_own = lax.dynamic_index_in_dim(vb, own, axis=2, keepdims=False)
        s_own = jnp.einsum('bhqd,bhkd->bhqk', q_c, k_own).astype(jnp.float32) * scale
        q_pos = q0 + jnp.arange(Q_BLOCK)
        k_pos = own * MOBA_BLOCK + jnp.arange(MOBA_BLOCK)
        s_own = jnp.where(k_pos[None, :] <= q_pos[:, None], s_own, -jnp.inf)
        p = jax.nn.softmax(jnp.concatenate([s_sel, s_own], axis=-1), axis=-1)
        p_sel = p[..., :sel_len].reshape(B, H, Q_BLOCK, topk, MOBA_BLOCK).astype(v.dtype)
        p_own = p[..., sel_len:].astype(v.dtype)
        return (jnp.einsum('bhqjk,bhqjkd->bhqd', p_sel, v_sel)
                + jnp.einsum('bhqk,bhkd->bhqd', p_own, v_own))

    outs = lax.map(block_fn, (to_qblocks(q), to_qblocks(g_idx), to_qblocks(g_valid),
                              jnp.arange(nq)))
    out = jnp.moveaxis(outs, 0, 2).reshape(B, H, S, HEAD_DIM)
    return out.transpose(0, 2, 1, 3).reshape(B, S, WIDTH_B)


def setup_inputs(seed: int = 0) -> dict:
    key = jax.random.key(seed)
    ks = jax.random.split(key, 17)
    f32 = jnp.float32
    nrm = lambda k, shape, s: jax.random.normal(k, shape, f32) * s
    gain = lambda k, n: 1.0 + 0.02 * jax.random.normal(k, (DEPTH, n), f32)
    return {
        "x": jax.random.normal(ks[0], (BATCH, SEQ, D_MODEL), f32),
        "norm1_g": gain(ks[1], D_MODEL),
        "w_in": nrm(ks[2], (DEPTH, D_MODEL, IN_WIDTH), D_MODEL ** -0.5),
        "sgu_ln_g": gain(ks[3], WIDTH_A),
        "sgu_ln_b": nrm(ks[4], (DEPTH, WIDTH_A), 0.02),
        "sgu_w": nrm(ks[5], (DEPTH, N_HEADS_A, CHUNK, CHUNK), CHUNK ** -0.5),
        "sgu_b": 1.0 + nrm(ks[6], (DEPTH, N_HEADS_A, CHUNK), 0.02),
        "q_norm_g": gain(ks[7], HEAD_DIM),
        "k_norm_g": gain(ks[8], HEAD_DIM),
        "out_norm_a_g": gain(ks[9], WIDTH_A),
        "out_norm_b_g": gain(ks[10], WIDTH_B),
        "w_out": nrm(ks[11], (DEPTH, MIX_WIDTH, D_MODEL), MIX_WIDTH ** -0.5),
        "norm2_g": gain(ks[12], D_MODEL),
        "w_gate": nrm(ks[13], (DEPTH, D_MODEL, D_FF), D_MODEL ** -0.5),
        "w_up": nrm(ks[14], (DEPTH, D_MODEL, D_FF), D_MODEL ** -0.5),
        "w_down": nrm(ks[15], (DEPTH, D_FF, D_MODEL), D_FF ** -0.5),
    }


def reference(x, norm1_g, w_in, sgu_ln_g, sgu_ln_b, sgu_w, sgu_b, q_norm_g, k_norm_g,
              out_norm_a_g, out_norm_b_g, w_out, norm2_g, w_gate, w_up, w_down):
    B, S, _ = x.shape
    for l in range(DEPTH):
        h = rms_norm(x, norm1_g[l])
        proj = h @ w_in[l]
        u_a, v_a, q_b, k_b, v_b = jnp.split(
            proj, [WIDTH_A, 2 * WIDTH_A, 2 * WIDTH_A + WIDTH_B, 2 * WIDTH_A + 2 * WIDTH_B], axis=-1)
        y_a = chunked_sgu(u_a, v_a, sgu_ln_g[l], sgu_ln_b[l], sgu_w[l], sgu_b[l])
        y_b = moba_attention(q_b, k_b, v_b, q_norm_g[l], k_norm_g[l])
        y_a = rms_norm(y_a.reshape(B, S, N_HEADS_A, HEAD_DIM),
                       out_norm_a_g[l].reshape(N_HEADS_A, HEAD_DIM)).reshape(B, S, WIDTH_A)
        y_b = rms_norm(y_b.reshape(B, S, N_HEADS_B, HEAD_DIM),
                       out_norm_b_g[l].reshape(N_HEADS_B, HEAD_DIM)).reshape(B, S, WIDTH_B)
        x = x + jnp.concatenate([y_a, y_b], axis=-1) @ w_out[l]
        h = rms_norm(x, norm2_g[l])
        x = x + (jax.nn.silu(h @ w_gate[l]) * (h @ w_up[l])) @ w_down[l]
    return x
```

```cpp
#include <hip/hip_runtime.h>
#include <hip/hip_bf16.h>
#include <cstdio>
#include <cstdint>
#include <cmath>

constexpr int BATCH = 8, SEQ = 2048, DM = 1024, M = BATCH * SEQ;
constexpr int NH = 8, HD = 64, WA = 512, INW = 2560, CHUNK = 128, MBLK = 256, NBLK = SEQ / MBLK, DFF = 2816, NGU = 2 * DFF;
constexpr float EPS = 1e-6f;
constexpr float C2 = 0.125f * 1.4426950408889634f;
constexpr int COL_U = 0, COL_VA = 512, COL_Q = 1024, COL_K = 1536, COL_V = 2048;

constexpr size_t MiB = 1u << 20;
constexpr size_t WS_CTL = 0, CTL_ZERO_BYTES = 1 * MiB;
constexpr size_t WS_KSUM = 512 * 1024;
constexpr size_t WS_WIN = 1 * MiB;
constexpr size_t WS_WO = 6 * MiB;
constexpr size_t WS_WGU = 8 * MiB;
constexpr size_t WS_WD = 19 * MiB;
constexpr size_t WS_SW = 25 * MiB;
constexpr size_t WS_ROWSS = 26 * MiB;
constexpr size_t WS_XN = 32 * MiB;
constexpr size_t WS_Y = 64 * MiB;
constexpr size_t WS_PROJ = 96 * MiB;
constexpr size_t WS_END = 184 * MiB;

namespace pg8 {
#define PG8_LAS __attribute__((address_space(3)))
typedef unsigned short bf16_t;
typedef short bf16x8 __attribute__((ext_vector_type(8)));
typedef float f32x4 __attribute__((ext_vector_type(4)));
typedef unsigned u32x4 __attribute__((ext_vector_type(4)));
constexpr int BM = 256, BK = 64, HALF = 128, HTB = HALF * BK * 2  , STAGE_BYTES = 8 * HTB, NXCD = 8, WGM = 8;

__host__ __device__ __forceinline__ int lds_byte(int r, int c) { const int st = (r >> 4) * 2 + (c >> 5), rr = r & 15, cc = c & 31, ob = rr * 64 + cc * 2; return st * 1024 + (ob ^ (((ob >> 9) & 1) << 5)); }
__host__ __device__ __forceinline__ void stage_rc(int b, int& R, int& C) { const int st = b / 1024, sb = b % 1024, swz = sb ^ (((sb >> 9) & 1) << 5); R = (st >> 1) * 16 + swz / 64; C = (st & 1) * 32 + (swz % 64) / 2; }
__host__ __device__ __forceinline__ int perm32(int rho) { const int n = rho >> 4, i = rho & 15; return 8 * (i >> 2) + 4 * n + (i & 3); }

struct Unit { int pm, pn; };
struct Gemm { const bf16_t* A; const bf16_t* Bt; int M, N, K; };

struct StaticOrder {
    int nM, nN, nwg, G, c;
    __host__ __device__ void init(int M, int N, int G_, int c_) { nM = M / BM; nN = N / BM; nwg = nM * nN; G = G_; c = c_; }
    __host__ __device__ bool next(int i, Unit& u) const {
        const long L = (long)i * G + c; if (L >= nwg) return false;
        int wgid = (int)L; { const int q = nwg / NXCD, r = nwg % NXCD, xcd = wgid % NXCD, off = wgid / NXCD; wgid = (xcd < r ? xcd * (q + 1) : r * (q + 1) + (xcd - r) * q) + off; }
        const int nig = WGM * nN, gid = wgid / nig, fm = gid * WGM, gsz = (nM - fm) < WGM ? (nM - fm) : WGM;
        u.pm = fm + ((wgid % nig) % gsz); u.pn = (wgid % nig) / gsz; return true;
    }
    __device__ __forceinline__ void a_ready(const Unit&) const {}
    __device__ __forceinline__ void done(const Unit&) const {}
};

__device__ __forceinline__ unsigned cvt_pk_bf16(float lo, float hi) { unsigned r; asm volatile("v_cvt_pk_bf16_f32 %0, %1, %2" : "=v"(r) : "v"(lo), "v"(hi)); return r; }
__device__ __forceinline__ float gelu_tanh_f(float x) {
    const float t = x * (-2.3022082f + -0.10294324f * (x * x));
    return x * __builtin_amdgcn_rcpf(1.0f + __builtin_amdgcn_exp2f(t));
}
__device__ __forceinline__ float silu_f(float x) { return x * __builtin_amdgcn_rcpf(1.0f + __builtin_amdgcn_exp2f(-1.4426950408889634f * x)); }
__device__ __forceinline__ float hsum4(const f32x4 v) { return (v[0] + v[1]) + (v[2] + v[3]); }
__device__ __forceinline__ float hsq4(const f32x4 v) { return (v[0] * v[0] + v[1] * v[1]) + (v[2] * v[2] + v[3] * v[3]); }
__device__ __forceinline__ float quad_sum(float s) { s += __shfl_xor(s, 16); s += __shfl_xor(s, 32); return s; }
__device__ __forceinline__ u32x4 pack8(const f32x4 a, const f32x4 b) { u32x4 w; w.x = cvt_pk_bf16(a[0], a[1]); w.y = cvt_pk_bf16(a[2], a[3]); w.z = cvt_pk_bf16(b[0], b[1]); w.w = cvt_pk_bf16(b[2], b[3]); return w; }

struct EpiInProj {
    static constexpr bool PERM = true, AFTER_DRAIN = false; static constexpr int BMAP = 1;
    bf16_t* P; const float* ln_g; const float* ln_b; const float* q_g; const float* k_g; float* ksum;
    __device__ __forceinline__ void operator()(const f32x4 (&acc)[2][2][4][2], const Unit& u, int wr, int wc, int fr, int fq) const {
        asm volatile("" : "+v"(fr), "+v"(fq));
        const int seg = u.pn >> 1, h = (u.pn & 1) * 4 + wc, dl = 8 * fq;
        bf16_t* base = P + (size_t)(u.pm * BM + wr * 64 + fr) * INW + u.pn * BM + wc * 64 + dl;
        if (seg == 0) {
#pragma unroll
            for (int ai = 0; ai < 2; ++ai)
#pragma unroll
                for (int m = 0; m < 4; ++m)
#pragma unroll
                    for (int bj = 0; bj < 2; ++bj) { f32x4 a = acc[ai][bj][m][0], b = acc[ai][bj][m][1];
#pragma unroll
                        for (int e = 0; e < 4; ++e) { a[e] = gelu_tanh_f(a[e]); b[e] = gelu_tanh_f(b[e]); }
                        *(u32x4*)(base + (size_t)(ai * HALF + m * 16) * INW + 32 * bj) = pack8(a, b); }
        } else if (seg == 1) {
            const float* lg = ln_g + h * 64 + dl; const float* lb = ln_b + h * 64 + dl;
#pragma unroll
            for (int ai = 0; ai < 2; ++ai)
#pragma unroll
                for (int m = 0; m < 4; ++m) { f32x4 g[2][2]; float s = 0.f;
#pragma unroll
                    for (int bj = 0; bj < 2; ++bj)
#pragma unroll
                        for (int n = 0; n < 2; ++n) { const f32x4 a = acc[ai][bj][m][n];
#pragma unroll
                            for (int e = 0; e < 4; ++e) g[bj][n][e] = gelu_tanh_f(a[e]);
                            s += hsum4(g[bj][n]); }
                    const float mean = quad_sum(s) * (1.0f / 64.0f); float q = 0.f;
#pragma unroll
                    for (int bj = 0; bj < 2; ++bj)
#pragma unroll
                        for (int n = 0; n < 2; ++n) { g[bj][n] = g[bj][n] - mean; q += hsq4(g[bj][n]); }
                    const float rstd = __builtin_amdgcn_rsqf(quad_sum(q) * (1.0f / 64.0f) + EPS);
#pragma unroll
                    for (int bj = 0; bj < 2; ++bj) { const f32x4 G0 = *(const f32x4*)(lg + 32 * bj), G1 = *(const f32x4*)(lg + 32 * bj + 4), B0 = *(const f32x4*)(lb + 32 * bj), B1 = *(const f32x4*)(lb + 32 * bj + 4);
                        *(u32x4*)(base + (size_t)(ai * HALF + m * 16) * INW + 32 * bj) = pack8(g[bj][0] * rstd * G0 + B0, g[bj][1] * rstd * G1 + B1); }
                    asm volatile("" ::: "memory"); __builtin_amdgcn_sched_barrier(0); }
        } else if (seg == 2 || seg == 3) {
            const float* gp = ((seg == 2) ? q_g : k_g) + dl; const float sc = (seg == 2) ? C2 : 1.0f;
            f32x4 cs[2][2];
#pragma unroll
            for (int bj = 0; bj < 2; ++bj)
#pragma unroll
                for (int n = 0; n < 2; ++n) cs[bj][n] = (f32x4){0.f, 0.f, 0.f, 0.f};
#pragma unroll
            for (int ai = 0; ai < 2; ++ai)
#pragma unroll
                for (int m = 0; m < 4; ++m) { float q = 0.f;
#pragma unroll
                    for (int bj = 0; bj < 2; ++bj)
#pragma unroll
                        for (int n = 0; n < 2; ++n) q += hsq4(acc[ai][bj][m][n]);
                    const float rstd = __builtin_amdgcn_rsqf(quad_sum(q) * (1.0f / 64.0f) + EPS) * sc;
#pragma unroll
                    for (int bj = 0; bj < 2; ++bj) { const f32x4 o0 = acc[ai][bj][m][0] * rstd * *(const f32x4*)(gp + 32 * bj), o1 = acc[ai][bj][m][1] * rstd * *(const f32x4*)(gp + 32 * bj + 4);
                        cs[bj][0] += o0; cs[bj][1] += o1;
                        *(u32x4*)(base + (size_t)(ai * HALF + m * 16) * INW + 32 * bj) = pack8(o0, o1); }
                    asm volatile("" : "+v"(cs[0][0]), "+v"(cs[0][1]), "+v"(cs[1][0]), "+v"(cs[1][1]));
                    asm volatile("" ::: "memory"); __builtin_amdgcn_sched_barrier(0); }
            if (seg == 3) {
#pragma unroll
                for (int bj = 0; bj < 2; ++bj)
#pragma unroll
                    for (int n = 0; n < 2; ++n)
#pragma unroll
                        for (int e = 0; e < 4; ++e) { float v = cs[bj][n][e]; v += __shfl_xor(v, 1); v += __shfl_xor(v, 2); v += __shfl_xor(v, 4); v += __shfl_xor(v, 8);
                            if (fr == 0) atomicAdd(ksum + ((size_t)u.pm * NH + h) * 64 + 32 * bj + dl + 4 * n + e, v); }
            }
        } else {
#pragma unroll
            for (int ai = 0; ai < 2; ++ai)
#pragma unroll
                for (int m = 0; m < 4; ++m)
#pragma unroll
                    for (int bj = 0; bj < 2; ++bj) *(u32x4*)(base + (size_t)(ai * HALF + m * 16) * INW + 32 * bj) = pack8(acc[ai][bj][m][0], acc[ai][bj][m][1]);
        }
    }
};

struct EpiOutProj {
    static constexpr bool PERM = true, AFTER_DRAIN = true; static constexpr int BMAP = 0;
    const float* x; float* out; bf16_t* x1b; float* rowss;
    __device__ __forceinline__ void operator()(const f32x4 (&)[2][2][4][2], const Unit&, int, int, int, int) const {}
    __device__ __forceinline__ void fused(f32x4 (&acc)[2][2][4][2], const Unit& u, int wr, int wc, int fr, int fq, PG8_LAS unsigned char* lds, int wid, int lane) const {
        PG8_LAS float* Pl = (PG8_LAS float*)lds;
        const int col0 = u.pn * BM + wc * 32 + 8 * fq;
#pragma unroll
        for (int ai = 0; ai < 2; ++ai)
#pragma unroll
            for (int m = 0; m < 4; ++m) { const int rt = ai * HALF + wr * 64 + m * 16 + fr; const size_t off = (size_t)(u.pm * BM + rt) * DM + col0; float s = 0.f;
#pragma unroll
                for (int bj = 0; bj < 2; ++bj) { const f32x4 v0 = acc[ai][bj][m][0] + *(const f32x4*)(x + off + bj * HALF), v1 = acc[ai][bj][m][1] + *(const f32x4*)(x + off + bj * HALF + 4);
                    *(f32x4*)(out + off + bj * HALF) = v0; *(f32x4*)(out + off + bj * HALF + 4) = v1; *(u32x4*)(x1b + off + bj * HALF) = pack8(v0, v1); s += hsq4(v0) + hsq4(v1); }
                s = quad_sum(s); if (fq == 0) Pl[rt * 4 + wc] = s;
                if (m & 1) asm volatile("" ::: "memory"); }
        asm volatile("s_waitcnt lgkmcnt(0)" ::: "memory"); __builtin_amdgcn_s_barrier(); asm volatile("" ::: "memory");
        const int t = wid * 64 + lane;
        if (t < 256) rowss[(size_t)(u.pm * BM + t) * 4 + u.pn] = (Pl[t * 4 + 0] + Pl[t * 4 + 1]) + (Pl[t * 4 + 2] + Pl[t * 4 + 3]);
    }
};

struct EpiGateUp {
    static constexpr bool PERM = true, AFTER_DRAIN = false; static constexpr int BMAP = 0;
    bf16_t* H; const float* rowss;
    __device__ __forceinline__ void operator()(const f32x4 (&acc)[2][2][4][2], const Unit& u, int wr, int wc, int fr, int fq) const {
        const int row0 = u.pm * BM + wr * 64 + fr, col0 = u.pn * HALF + wc * 32 + 8 * fq;
#pragma unroll
        for (int ai = 0; ai < 2; ++ai)
#pragma unroll
            for (int m = 0; m < 4; ++m) { const int row = row0 + ai * HALF + m * 16; const f32x4 r4 = *(const f32x4*)(rowss + (size_t)row * 4);
                const float rs = __builtin_amdgcn_rsqf(hsum4(r4) * (1.0f / DM) + EPS);
                f32x4 a = acc[ai][0][m][0] * rs, b = acc[ai][0][m][1] * rs; const f32x4 ua = acc[ai][1][m][0] * rs, ub = acc[ai][1][m][1] * rs;
#pragma unroll
                for (int e = 0; e < 4; ++e) { a[e] = silu_f(a[e]) * ua[e]; b[e] = silu_f(b[e]) * ub[e]; }
                *(u32x4*)(H + (size_t)row * DFF + col0) = pack8(a, b); }
    }
};

struct EpiDown {
    static constexpr bool PERM = false, AFTER_DRAIN = false; static constexpr int BMAP = 0;
    float* out;
    __device__ __forceinline__ void operator()(const f32x4 (&acc)[2][2][4][2], const Unit& u, int wr, int wc, int fr, int fq) const {
        const int row0 = u.pm * BM + wr * 64 + fr, col0 = u.pn * BM + wc * 32 + 4 * fq;
#pragma unroll
        for (int ai = 0; ai < 2; ++ai)
#pragma unroll
            for (int m = 0; m < 4; ++m) { float* rowp = out + (size_t)(row0 + ai * HALF + m * 16) * DM + col0;
#pragma unroll
                for (int bj = 0; bj < 2; ++bj)
#pragma unroll
                    for (int n = 0; n < 2; ++n) *(f32x4*)(rowp + bj * HALF + n * 16) = *(const f32x4*)(rowp + bj * HALF + n * 16) + acc[ai][bj][m][n];
                if (m & 1) asm volatile("" ::: "memory"); }
    }
};

template <class Epi, class Sched, bool ALIGN_EPI = false, bool SP2 = false>
__device__ __forceinline__ void gemm_phase(PG8_LAS unsigned char* lds, const Gemm g, const Sched& S, const Epi& E) {
    const int tid = threadIdx.x, wid = __builtin_amdgcn_readfirstlane(tid >> 6), lane = tid & 63, wr = wid >> 2, wc = wid & 3, fr = lane & 15, fq = lane >> 4;
    const int K = g.K, nt = K / BK;
    unsigned voffA[2], voffB[2];
#pragma unroll
    for (int i = 0; i < 2; ++i) { int R, C; stage_rc(tid * 16 + i * 8192, R, C); int Rb = Epi::PERM ? ((R & ~31) + perm32(R & 31)) : R;
        if (Epi::BMAP == 1) Rb = 64 * (R >> 5) + (Rb & 31);
        voffA[i] = (unsigned)(R * K + C) * 2u; voffB[i] = (unsigned)(Rb * K + C) * 2u; }
    const size_t kstep = (size_t)(BK * 2);
    const size_t hstep = (size_t)HALF * K * 2;
    const size_t hstepB = (size_t)(Epi::BMAP == 1 ? 32 : HALF) * K * 2;
    const size_t tstep = 2 * hstep;
    const unsigned ldsw = (unsigned)wid * 1024u;
    const int aoff = lds_byte(wr * 64 + fr, fq * 8), boff = lds_byte(wc * 32 + fr, fq * 8);
#define PG8_SA(b, h) (((b) * 2 + (h)) * HTB)
#define PG8_SB(b, h) ((4 + (b) * 2 + (h)) * HTB)
#define PG8_STAGE(bufoff, gbase, voff) do { _Pragma("unroll") for (int _i = 0; _i < 2; ++_i) \
        __builtin_amdgcn_global_load_lds((const unsigned*)((const char*)(gbase) + (voff)[_i]), (PG8_LAS unsigned*)(lds + (bufoff) + ldsw + _i * 8192), 16, 0, 0); } while (0)
#define PG8_LDA(dst, b, h) do { _Pragma("unroll") for (int m = 0; m < 4; ++m) _Pragma("unroll") for (int k = 0; k < 2; ++k) dst[m][k] = *(const PG8_LAS bf16x8*)(lds + PG8_SA(b, h) + aoff + m * 2048 + k * 1024); } while (0)
#define PG8_LDB(dst, b, h) do { _Pragma("unroll") for (int n = 0; n < 2; ++n) _Pragma("unroll") for (int k = 0; k < 2; ++k) dst[n][k] = *(const PG8_LAS bf16x8*)(lds + PG8_SB(b, h) + boff + n * 2048 + k * 1024); } while (0)
#define PG8_MMA(ai, bj, At, Bt) do { __builtin_amdgcn_s_setprio(1); _Pragma("unroll") for (int m = 0; m < 4; ++m) _Pragma("unroll") for (int n = 0; n < 2; ++n) _Pragma("unroll") for (int k = 0; k < 2; ++k) \
        acc[ai][bj][m][n] = __builtin_amdgcn_mfma_f32_16x16x32_bf16(Bt[n][k], At[m][k], acc[ai][bj][m][n], 0, 0, 0); __builtin_amdgcn_s_setprio(0); } while (0)
#define PG8_WAIT_V(n) asm volatile("s_waitcnt vmcnt(" #n ")" ::: "memory")
#define PG8_WAIT_L(n) asm volatile("s_waitcnt lgkmcnt(" #n ")" ::: "memory")
#define PG8_BAR __builtin_amdgcn_s_barrier()
#define PG8_SCHED __builtin_amdgcn_sched_barrier(0)
    Unit cur, nxt; int ui = 0;
    if (!S.next(0, cur)) return;
    f32x4 acc[2][2][4][2];
#pragma unroll
    for (int a = 0; a < 2; ++a)
#pragma unroll
        for (int b = 0; b < 2; ++b)
#pragma unroll
            for (int m = 0; m < 4; ++m)
#pragma unroll
                for (int n = 0; n < 2; ++n) acc[a][b][m][n] = (f32x4){0.f, 0.f, 0.f, 0.f};
    bf16x8 At[4][2], B0[2][2], B1[2][2];
    const char* cA = (const char*)g.A + (size_t)cur.pm * tstep; const char* cB = (const char*)g.Bt + (size_t)cur.pn * tstep;
    S.a_ready(cur);
    if constexpr (SP2) {
        PG8_STAGE(PG8_SB(0, 0), cB, voffB); PG8_STAGE(PG8_SB(0, 1), cB + hstepB, voffB); PG8_STAGE(PG8_SA(0, 0), cA, voffA); PG8_STAGE(PG8_SA(0, 1), cA + hstep, voffA);
        if (wr == 1) PG8_BAR;
        PG8_WAIT_V(2); PG8_BAR;
        PG8_STAGE(PG8_SB(1, 0), cB + kstep, voffB); PG8_STAGE(PG8_SA(1, 0), cA + kstep, voffA); PG8_STAGE(PG8_SB(1, 1), cB + hstepB + kstep, voffB);
        PG8_WAIT_V(6); PG8_BAR;
    } else {
        PG8_STAGE(PG8_SB(0, 0), cB, voffB); PG8_STAGE(PG8_SA(0, 0), cA, voffA); PG8_STAGE(PG8_SB(0, 1), cB + hstepB, voffB); PG8_STAGE(PG8_SA(0, 1), cA + hstep, voffA);
        if (wr == 1) PG8_BAR;
        PG8_WAIT_V(4); PG8_BAR;
        PG8_STAGE(PG8_SB(1, 0), cB + kstep, voffB); PG8_STAGE(PG8_SA(1, 0), cA + kstep, voffA); PG8_STAGE(PG8_SB(1, 1), cB + hstepB + kstep, voffB);
        PG8_WAIT_V(6); PG8_BAR;
    }
    for (;;) {
        const bool has_next = S.next(ui + 1, nxt);
        const char* nA = has_next ? (const char*)g.A + (size_t)nxt.pm * tstep : cA; const char* nB = has_next ? (const char*)g.Bt + (size_t)nxt.pn * tstep : cB;
        for (int t = 0; t < nt; t += 2) {
            const bool last = (t == nt - 2);
            const char* a1 = cA + (size_t)(t + 1) * kstep;
            const char* a2 = last ? nA : cA + (size_t)(t + 2) * kstep; const char* b2 = last ? nB : cB + (size_t)(t + 2) * kstep;
            const char* a3 = a2 + kstep; const char* b3 = b2 + kstep;
            if (last && has_next) S.a_ready(nxt);
            if constexpr (SP2) {
            PG8_LDB(B0, 0, 0); PG8_LDB(B1, 0, 1); PG8_SCHED; PG8_LDA(At, 0, 0); PG8_STAGE(PG8_SA(1, 1), a1 + hstep, voffA);
            PG8_WAIT_V(8); PG8_WAIT_L(0); PG8_BAR; PG8_MMA(0, 0, At, B0); PG8_MMA(0, 1, At, B1); PG8_BAR; PG8_SCHED;
            PG8_LDA(At, 0, 1); PG8_STAGE(PG8_SB(0, 0), b2, voffB); PG8_STAGE(PG8_SB(0, 1), b2 + hstepB, voffB); PG8_STAGE(PG8_SA(0, 0), a2, voffA);
            PG8_WAIT_V(8); PG8_WAIT_L(0); PG8_BAR; PG8_MMA(1, 0, At, B0); PG8_MMA(1, 1, At, B1); PG8_BAR; PG8_SCHED;
            PG8_LDB(B0, 1, 0); PG8_LDB(B1, 1, 1); PG8_SCHED; PG8_LDA(At, 1, 0); PG8_STAGE(PG8_SA(0, 1), a2 + hstep, voffA);
            PG8_WAIT_V(8); PG8_WAIT_L(0); PG8_BAR; PG8_MMA(0, 0, At, B0); PG8_MMA(0, 1, At, B1); PG8_BAR; PG8_SCHED;
            PG8_LDA(At, 1, 1); PG8_STAGE(PG8_SB(1, 0), b3, voffB); PG8_STAGE(PG8_SB(1, 1), b3 + hstepB, voffB); PG8_STAGE(PG8_SA(1, 0), a3, voffA);
            PG8_WAIT_V(8); PG8_WAIT_L(0); PG8_BAR; PG8_MMA(1, 0, At, B0); PG8_MMA(1, 1, At, B1); PG8_BAR; PG8_SCHED;
            } else {
            PG8_LDB(B0, 0, 0); PG8_SCHED; PG8_LDA(At, 0, 0); PG8_STAGE(PG8_SA(1, 1), a1 + hstep, voffA);
            PG8_WAIT_L(8); PG8_BAR; PG8_WAIT_L(0); PG8_MMA(0, 0, At, B0); PG8_BAR; PG8_SCHED;
            PG8_LDB(B1, 0, 1); PG8_STAGE(PG8_SB(0, 0), b2, voffB);
            PG8_BAR; PG8_WAIT_L(0); PG8_MMA(0, 1, At, B1); PG8_BAR;
            PG8_LDA(At, 0, 1); PG8_STAGE(PG8_SA(0, 0), a2, voffA);
            PG8_BAR; PG8_WAIT_L(0); PG8_MMA(1, 0, At, B0); PG8_BAR; PG8_SCHED;
            PG8_STAGE(PG8_SB(0, 1), b2 + hstepB, voffB);
            PG8_WAIT_V(6); PG8_BAR; PG8_MMA(1, 1, At, B1); PG8_BAR;
            PG8_LDB(B0, 1, 0); PG8_SCHED; PG8_LDA(At, 1, 0); PG8_STAGE(PG8_SA(0, 1), a2 + hstep, voffA);
            PG8_WAIT_L(8); PG8_BAR; PG8_WAIT_L(0); PG8_MMA(0, 0, At, B0); PG8_BAR; PG8_SCHED;
            PG8_LDB(B1, 1, 1); PG8_STAGE(PG8_SB(1, 0), b3, voffB);
            PG8_BAR; PG8_WAIT_L(0); PG8_MMA(0, 1, At, B1); PG8_BAR;
            PG8_LDA(At, 1, 1); PG8_STAGE(PG8_SA(1, 0), a3, voffA);
            PG8_BAR; PG8_WAIT_L(0); PG8_MMA(1, 0, At, B0); PG8_BAR; PG8_SCHED;
            PG8_STAGE(PG8_SB(1, 1), b3 + hstepB, voffB);
            PG8_WAIT_V(6); PG8_BAR; PG8_MMA(1, 1, At, B1); PG8_BAR;
            }
        }
        if constexpr (ALIGN_EPI) { if (wr == 0) PG8_BAR; }
        if constexpr (!Epi::AFTER_DRAIN) { E(acc, cur, wr, wc, fr, fq); S.done(cur); }
        if (!has_next) break;
#pragma unroll
        for (int a = 0; a < 2; ++a)
#pragma unroll
            for (int b = 0; b < 2; ++b)
#pragma unroll
                for (int m = 0; m < 4; ++m)
#pragma unroll
                    for (int n = 0; n < 2; ++n) acc[a][b][m][n] = (f32x4){0.f, 0.f, 0.f, 0.f};
        cur = nxt; cA = nA; cB = nB; ++ui;
        if constexpr (ALIGN_EPI) { if (wr == 1) PG8_BAR; }
    }
    PG8_WAIT_V(0);
    if constexpr (!ALIGN_EPI) { if (wr == 0) PG8_BAR; }
    PG8_BAR;
    if constexpr (Epi::AFTER_DRAIN) { E.fused(acc, cur, wr, wc, fr, fq, lds, wid, lane); S.done(cur); }
#undef PG8_SA
#undef PG8_SB
#undef PG8_STAGE
#undef PG8_LDA
#undef PG8_LDB
#undef PG8_MMA
#undef PG8_WAIT_V
#undef PG8_WAIT_L
#undef PG8_BAR
#undef PG8_SCHED
}
}

#ifndef PG8_SP2
#define PG8_SP2 true
#endif
#ifndef PG8_ALIGN
#define PG8_ALIGN true
#endif

namespace attn_body {
using bf16=__hip_bfloat16;
using bf16x8=__attribute__((ext_vector_type(8)))short;
using s16x4=__attribute__((ext_vector_type(4)))short;
using f32x16=__attribute__((ext_vector_type(16)))float;
using u32x4=__attribute__((ext_vector_type(4)))unsigned;
constexpr int BATCH=8,NHEAD=8,SEQ=2048,D=64,DM=2560,YP=1024;
constexpr int NW=8,QBLK=32,QB=QBLK*NW,KVBLK=64,NQB=SEQ/QB;
constexpr int ATTN_PITCH=DM, ATTN_UNIT_ROWS=QB;
__device__ __forceinline__ int crow(int r,int hi){return (r&3)+8*(r>>2)+4*hi;}
#define SBAR() __builtin_amdgcn_sched_barrier(0)
__device__ __forceinline__ void cmask(f32x16&p0,f32x16&p1,int jb,int qrel,int hi){
  const float NEG=-INFINITY; int kb=64*jb+4*hi;
  #pragma unroll
  for(int r=0;r<16;++r){int kv=kb+(r&3)+8*(r>>2); if(kv>qrel)p0[r]=NEG; if(kv+32>qrel)p1[r]=NEG;}
}

constexpr int NSLOT=3, SLOTB=8192;
constexpr int LDS_K=0, LDS_V=NSLOT*SLOTB, LDS_WS=2*NSLOT*SLOTB, LDS_OST=LDS_WS+NW*64*4, LDS_BYTES=LDS_OST+NW*8192;
constexpr float C2=0.125f*1.4426950408889634f;
__device__ __forceinline__ void glds16(const void*gsrc,unsigned lds_dst){unsigned keep;
  asm volatile("s_mov_b32 %0, m0\n\ts_mov_b32 m0, %2\n\ts_nop 0\n\tglobal_load_lds_dwordx4 %1, off\n\ts_mov_b32 m0, %0":"=&s"(keep):"v"(gsrc),"s"(lds_dst):"memory");}
__device__ __forceinline__ float max3f(float a,float b,float c){float r;asm("v_max3_f32 %0, %1, %2, %3":"=v"(r):"v"(a),"v"(b),"v"(c));return r;}
__device__ __forceinline__ float max2f(float a,float b){float r;asm("v_max_f32_e32 %0, %1, %2":"=v"(r):"v"(a),"v"(b));return r;}
__device__ __forceinline__ float fadd_s(float a,float b){float r;asm("v_add_f32_e32 %0, %1, %2":"=v"(r):"v"(a),"v"(b));return r;}
__device__ __forceinline__ float fsub_s(float a,float b){float r;asm("v_sub_f32_e32 %0, %1, %2":"=v"(r):"v"(a),"v"(b));return r;}
typedef float f32x2_t __attribute__((ext_vector_type(2))); typedef __bf16 bf16x2_t __attribute__((ext_vector_type(2))); typedef float f32x4_t __attribute__((ext_vector_type(4))); typedef unsigned u32x2_t __attribute__((ext_vector_type(2)));
__device__ __forceinline__ unsigned cvtpk_s(float lo,float hi){f32x2_t v={lo,hi};bf16x2_t b=__builtin_convertvector(v,bf16x2_t);return __builtin_bit_cast(unsigned,b);}
#define WAIT_BAR(N) asm volatile("s_waitcnt vmcnt(" #N ") lgkmcnt(0)\n\ts_barrier":::"memory")

__device__ __forceinline__ void qkt(f32x16&p0,f32x16&p1,const char*Kslot,const bf16x8*qr,const f32x16&negm,int r32,int hi){
  const char*kb=Kslot+hi*1024+r32*16;
  #pragma unroll
  for(int d0=0;d0<4;++d0){
    const bf16x8 b0=*reinterpret_cast<const bf16x8*>(kb+d0*2048);
    const bf16x8 b1=*reinterpret_cast<const bf16x8*>(kb+d0*2048+512);
    if(d0==0){p0=__builtin_amdgcn_mfma_f32_32x32x16_bf16(b0,qr[0],negm,0,0,0);p1=__builtin_amdgcn_mfma_f32_32x32x16_bf16(b1,qr[0],negm,0,0,0);}
    else{p0=__builtin_amdgcn_mfma_f32_32x32x16_bf16(b0,qr[d0],p0,0,0,0);p1=__builtin_amdgcn_mfma_f32_32x32x16_bf16(b1,qr[d0],p1,0,0,0);}}
}
typedef __attribute__((address_space(3))) const char* lds_cptr;
typedef short v4i16_t __attribute__((ext_vector_type(4)));
__device__ __forceinline__ void kload8(bf16x8*kf,lds_cptr kp){
  kf[0]=*(const __attribute__((address_space(3))) bf16x8*)(kp);      kf[1]=*(const __attribute__((address_space(3))) bf16x8*)(kp+512);
  kf[2]=*(const __attribute__((address_space(3))) bf16x8*)(kp+2048); kf[3]=*(const __attribute__((address_space(3))) bf16x8*)(kp+2560);
  kf[4]=*(const __attribute__((address_space(3))) bf16x8*)(kp+4096); kf[5]=*(const __attribute__((address_space(3))) bf16x8*)(kp+4608);
  kf[6]=*(const __attribute__((address_space(3))) bf16x8*)(kp+6144); kf[7]=*(const __attribute__((address_space(3))) bf16x8*)(kp+6656);
}
__device__ __forceinline__ void kload2(bf16x8*kf,lds_cptr kp,int j){ kf[2*j]=*(const __attribute__((address_space(3))) bf16x8*)(kp+j*2048); kf[2*j+1]=*(const __attribute__((address_space(3))) bf16x8*)(kp+j*2048+512); }
__device__ __forceinline__ s16x4 vtr(lds_cptr p){ return __builtin_bit_cast(s16x4,__builtin_amdgcn_ds_read_tr16_b64_v4i16((__attribute__((address_space(3))) v4i16_t*)p)); }
__device__ __forceinline__ float rowmax(const f32x16&p0,const f32x16&p1){
  float a=max3f(p0[0],p0[1],p1[0]),b=max3f(p0[2],p0[3],p1[1]);a=max3f(a,p1[2],p1[3]);
  #pragma unroll
  for(int r=4;r<16;r+=4){a=max3f(a,p0[r],p0[r+1]);b=max3f(b,p0[r+2],p0[r+3]);a=max3f(a,p1[r],p1[r+1]);b=max3f(b,p1[r+2],p1[r+3]);}
  const float m=max2f(a,b);
  auto rr=__builtin_amdgcn_permlane32_swap(__float_as_uint(m),__float_as_uint(m),false,false);
  return max2f(__uint_as_float(rr[0]),__uint_as_float(rr[1]));
}
__device__ __forceinline__ void pv(f32x16*o,int vb,bf16x8 pa0,bf16x8 pa1,bf16x8 pa2,bf16x8 pa3){
  #pragma unroll
  for(int d0=0;d0<2;++d0){s16x4 lo[4],hi[4];
    #pragma unroll
    for(int ks=0;ks<4;++ks){
      asm volatile("ds_read_b64_tr_b16 %0,%1 offset:%c2":"=&v"(lo[ks]):"v"(vb),"i"(d0*4096+ks*1024):"memory");
      asm volatile("ds_read_b64_tr_b16 %0,%1 offset:%c2":"=&v"(hi[ks]):"v"(vb),"i"(d0*4096+ks*1024+512):"memory");}
    asm volatile("s_waitcnt lgkmcnt(0)":::"memory");SBAR();
    #define PK(k) (bf16x8){lo[k][0],lo[k][1],lo[k][2],lo[k][3],hi[k][0],hi[k][1],hi[k][2],hi[k][3]}
    o[d0]=__builtin_amdgcn_mfma_f32_32x32x16_bf16(pa0,PK(0),o[d0],0,0,0);
    o[d0]=__builtin_amdgcn_mfma_f32_32x32x16_bf16(pa1,PK(1),o[d0],0,0,0);
    o[d0]=__builtin_amdgcn_mfma_f32_32x32x16_bf16(pa2,PK(2),o[d0],0,0,0);
    o[d0]=__builtin_amdgcn_mfma_f32_32x32x16_bf16(pa3,PK(3),o[d0],0,0,0);
    #undef PK
  }
}

#ifndef ATTN_STORE16
#define ATTN_STORE16(p,v) (*(u32x4*)(p)=(v))
#endif
template<int THRL> __device__ __forceinline__ void attn_unit(int b,int h,int qb,const bf16*Q,const bf16*__restrict__ K,const bf16*__restrict__ V,bf16*Y,const float*__restrict__ ksum,const float*__restrict__ onb_g,char*shm){
  const int tid=threadIdx.x,lane=tid&63,r32=lane&31,hi=lane>>5; const int wid=__builtin_amdgcn_readfirstlane(tid>>6);
  const long rowbase=(long)b*SEQ; const int q0=qb*QB;
  const bf16*Qw=Q+(rowbase+q0+wid*QBLK)*DM+h*D;
  const bf16*Kh=K+rowbase*DM+h*D,*Vh=V+rowbase*DM+h*D;
  const unsigned lds0=(unsigned)(uintptr_t)shm;
  float*wsf=(float*)(shm+LDS_WS)+wid*64;
  const bf16*ksrc=Kh+(long)lane*DM+wid*8;
  const bf16*vsrc=Vh+(long)(16*(wid&3)+(lane>>2))*DM+(wid>>2)*32+(lane&3)*8;
  const unsigned kdst=lds0+LDS_K+wid*1024, vdst=lds0+LDS_V+wid*1024;
  #define DMA_K(t,slot) glds16(ksrc+(long)(t)*KVBLK*DM,(unsigned)__builtin_amdgcn_readfirstlane(kdst+(slot)))
  #define DMA_V(t,slot) glds16(vsrc+(long)(t)*KVBLK*DM,(unsigned)__builtin_amdgcn_readfirstlane(vdst+(slot)))
  const int vb0=(int)(lds0+LDS_V)+((lane>>4)&1)*32+(lane&3)*8+(4*hi+((lane&15)>>2))*64;
  const char*Kbase=shm+LDS_K; bf16x8 kf[8];
  const lds_cptr shm3=(lds_cptr)shm; const lds_cptr kp0=shm3+LDS_K+hi*1024+r32*16; const lds_cptr vp0=shm3+LDS_V+((lane>>4)&1)*32+(lane&3)*8+(4*hi+((lane&15)>>2))*64;
  const int NT=(q0+QB)/KVBLK;
  DMA_K(0,0);DMA_V(0,0);DMA_K(1,SLOTB);
  bf16x8 qr[4];
  #pragma unroll
  for(int d0=0;d0<4;++d0)qr[d0]=*reinterpret_cast<const bf16x8*>(&Qw[(long)r32*DM+d0*16+hi*8]);
  unsigned selbits;
  { f32x16 g=f32x16{};
    const float*kr=ksum+(((long)(b*(SEQ/QB)+r32)*NHEAD+h)*D)+hi*8;
    #pragma unroll
    for(int d0=0;d0<4;++d0){ f32x4_t a0={0.f,0.f,0.f,0.f},a1={0.f,0.f,0.f,0.f}; if(r32<qb){a0=*reinterpret_cast<const f32x4_t*>(kr+d0*16);a1=*reinterpret_cast<const f32x4_t*>(kr+d0*16+4);}
      float hv[8],lv[8];
      #pragma unroll
      for(int e=0;e<4;++e){hv[e]=__builtin_bit_cast(float,__builtin_bit_cast(unsigned,a0[e])&0xffff0000u);lv[e]=a0[e]-hv[e];hv[4+e]=__builtin_bit_cast(float,__builtin_bit_cast(unsigned,a1[e])&0xffff0000u);lv[4+e]=a1[e]-hv[4+e];}
      u32x4 wh={cvtpk_s(hv[0],hv[1]),cvtpk_s(hv[2],hv[3]),cvtpk_s(hv[4],hv[5]),cvtpk_s(hv[6],hv[7])},wl={cvtpk_s(lv[0],lv[1]),cvtpk_s(lv[2],lv[3]),cvtpk_s(lv[4],lv[5]),cvtpk_s(lv[6],lv[7])};
      g=__builtin_amdgcn_mfma_f32_32x32x16_bf16(__builtin_bit_cast(bf16x8,wh),qr[d0],g,0,0,0);
      g=__builtin_amdgcn_mfma_f32_32x32x16_bf16(__builtin_bit_cast(bf16x8,wl),qr[d0],g,0,0,0);}
    float gt[8];
    #pragma unroll
    for(int r=0;r<4;++r){auto rr=__builtin_amdgcn_permlane32_swap(__float_as_uint(g[r]),__float_as_uint(g[r]),false,false);gt[r]=__uint_as_float(rr[0]);gt[4+r]=__uint_as_float(rr[1]);}
    selbits=1u<<qb;
    #pragma unroll
    for(int n=0;n<7;++n){int rank=0;
      #pragma unroll
      for(int m=0;m<7;++m)if(m!=n)rank+=(m<qb&&(gt[m]>gt[n]||(gt[m]==gt[n]&&m<n)))?1:0;
      if(n<qb&&rank<3)selbits|=1u<<n;}
  }
  #define MSKF(n) ((((selbits>>(n))&1u)!=0u)?0.f:-INFINITY)
  float mhat=0.f,l_reg=0.f;f32x16 o[2];o[0]=f32x16{};o[1]=f32x16{};f32x16 negm;{const float nm0=MSKF(0);
  #pragma unroll
  for(int r=0;r<16;++r)negm[r]=nm0;}asm volatile("":"+v"(negm));
  #define NEWBLK(tt) do{ if((((tt)&3)==0)){ const float nm_=MSKF((tt)>>2)-mhat; _Pragma("unroll") for(int r=0;r<16;++r)negm[r]=nm_; asm volatile("":"+v"(negm)); } }while(0)
  const int qrel=wid*QBLK+r32;
  #define CMASK(P0,P1,t) do{int jb_=(t)-(NT-4); if(jb_>=0)cmask(P0,P1,jb_,qrel,hi);}while(0)
  bool resc=false;
  #define START(P0,P1) do{ const float rm=rowmax(P0,P1); resc=false; \
    { const float dl=(rm==-INFINITY)?0.f:rm; mhat=fadd_s(mhat,dl); \
      _Pragma("unroll") for(int r=0;r<16;++r){P0[r]=fsub_s(P0[r],dl);P1[r]=fsub_s(P1[r],dl);} \
      const float nm_=MSKF(0)-mhat; _Pragma("unroll") for(int r=0;r<16;++r)negm[r]=nm_; asm volatile("":"+v"(negm)); } \
    _Pragma("unroll") for(int r=0;r<16;++r)P0[r]=__builtin_amdgcn_exp2f(P0[r]); }while(0)
  #define RESC() do{ if(resc){ asm volatile("s_waitcnt lgkmcnt(0)":::"memory"); \
      _Pragma("unroll") for(int d_=0;d_<2;++d_) _Pragma("unroll") for(int r=0;r<16;++r)o[d_][r]*=wsf[crow(r,hi)]; } }while(0)
  f32x16 pA0,pA1,pB0,pB1;
  int sl_prev=0,sl_cur=0,sl_next=SLOTB;
  #define ROT() do{sl_prev=sl_cur;sl_cur=sl_next;sl_next=(sl_next==(NSLOT-1)*SLOTB)?0:sl_next+SLOTB;}while(0)
  DMA_K(2,2*SLOTB);
  WAIT_BAR(3);
  qkt(pA0,pA1,Kbase,qr,negm,r32,hi);asm volatile("s_nop 15\n\ts_nop 7":"+v"(pA0),"+v"(pA1));CMASK(pA0,pA1,0);
  START(pA0,pA1);
  _Pragma("unroll") for(int r=0;r<16;++r)pA1[r]=__builtin_amdgcn_exp2f(pA1[r]);
  WAIT_BAR(0);
  DMA_K(3,0);DMA_V(1,SLOTB);
  ROT();
  kload8(kf,kp0+sl_cur);
  WAIT_BAR(2);
  s16x4 vlo[8],vhi[8]; u32x4 pw0,pw1,pw2,pw3;
  #define PKW(P,B) cvtpk_s(P[B],P[B+1])
  #define PAF(k) __builtin_bit_cast(bf16x8,pw##k)
  #define VFR(i) (bf16x8){vlo[i][0],vlo[i][1],vlo[i][2],vlo[i][3],vhi[i][0],vhi[i][1],vhi[i][2],vhi[i][3]}
  #define PIN(x) asm volatile("":"+v"(x))
  #define MX3(a,b,c) __builtin_fmaxf(__builtin_fmaxf((a),(b)),(c))
  #define GAPA(MF,A0,A1,A2,A3,W0,W1,PW) do{ MF; sacc+=A0; sacc+=A1; sacc+=A2; sacc+=A3; PIN(sacc); W0; W1; PIN(PW); SBAR(); }while(0)
  #define EX(v) __builtin_amdgcn_exp2f(v)
  #define GAPB(MF,X,B) do{ MF; X[B]=EX(X[B]); X[B+1]=EX(X[B+1]); X[B+2]=EX(X[B+2]); X[B+3]=EX(X[B+3]); PIN(X); SBAR(); }while(0)
  #define VRD(i) do{ vlo[i]=vtr(vp_+(((i)>>2)*4096+((i)&3)*1024)); vhi[i]=vtr(vp_+(((i)>>2)*4096+((i)&3)*1024+512)); }while(0)
  #define KRD(G,j) do{ if(G){ kload2(kf,kp0+sl_next,j); SBAR(); } }while(0)
  #define STEP(C0,C1,P0,P1,t,GK,GV,GL) do{ SBAR(); \
    const lds_cptr vp_=vp0+sl_prev; \
    VRD(0); SBAR(); float sacc=(P0[0]+P0[1]); \
    GAPA(C0=__builtin_amdgcn_mfma_f32_32x32x16_bf16(kf[0],qr[0],negm,0,0,0), P0[2],P0[3],P0[4],P0[5],     pw0[0]=PKW(P0,0), pw0[1]=PKW(P0,2), pw0); \
    VRD(4); SBAR(); GAPA(C1=__builtin_amdgcn_mfma_f32_32x32x16_bf16(kf[1],qr[0],negm,0,0,0), P0[6],P0[7],P0[8],P0[9],     pw0[2]=PKW(P0,4), pw0[3]=PKW(P0,6), pw0); \
    VRD(1); SBAR(); GAPA(C0=__builtin_amdgcn_mfma_f32_32x32x16_bf16(kf[2],qr[1],C0,0,0,0),   P0[10],P0[11],P0[12],P0[13], pw1[0]=PKW(P0,8), pw1[1]=PKW(P0,10), pw1); \
    VRD(5); SBAR(); GAPA(C1=__builtin_amdgcn_mfma_f32_32x32x16_bf16(kf[3],qr[1],C1,0,0,0),   P0[14],P0[15],P1[0],P1[1],   pw1[2]=PKW(P0,12),pw1[3]=PKW(P0,14), pw1); \
    VRD(2); SBAR(); GAPA(C0=__builtin_amdgcn_mfma_f32_32x32x16_bf16(kf[4],qr[2],C0,0,0,0),   P1[2],P1[3],P1[4],P1[5],     pw2[0]=PKW(P1,0), pw2[1]=PKW(P1,2), pw2); \
    VRD(6); SBAR(); GAPA(C1=__builtin_amdgcn_mfma_f32_32x32x16_bf16(kf[5],qr[2],C1,0,0,0),   P1[6],P1[7],P1[8],P1[9],     pw2[2]=PKW(P1,4), pw2[3]=PKW(P1,6), pw2); \
    VRD(3); SBAR(); GAPA(C0=__builtin_amdgcn_mfma_f32_32x32x16_bf16(kf[6],qr[3],C0,0,0,0),   P1[10],P1[11],P1[12],P1[13], pw3[0]=PKW(P1,8), pw3[1]=PKW(P1,10), pw3); \
    VRD(7); SBAR(); GAPA(C1=__builtin_amdgcn_mfma_f32_32x32x16_bf16(kf[7],qr[3],C1,0,0,0),   P1[14],P1[15],0.f,0.f,       pw3[2]=PKW(P1,12),pw3[3]=PKW(P1,14), pw3); \
    l_reg+=sacc; \
    if(GK){DMA_K((t)+3,sl_cur);} if(GV){DMA_V((t)+1,sl_next);} \
    CMASK(C0,C1,t); \
    { float a=MX3(C0[0],C0[1],C1[0]),b=MX3(C0[2],C0[3],C1[1]); a=MX3(a,C1[2],C1[3]); \
      _Pragma("unroll") for(int r=4;r<16;r+=4){a=MX3(a,C0[r],C0[r+1]);b=MX3(b,C0[r+2],C0[r+3]);a=MX3(a,C1[r],C1[r+1]);b=MX3(b,C1[r+2],C1[r+3]);} \
      float rm=__builtin_fmaxf(a,b); { auto rr=__builtin_amdgcn_permlane32_swap(__float_as_uint(rm),__float_as_uint(rm),false,false); rm=__builtin_fmaxf(__uint_as_float(rr[0]),__uint_as_float(rr[1])); } \
      resc=false; \
      if(__builtin_expect(__any(rm>(float)THRL),0)){ const float dl=__builtin_fmaxf(rm,0.f); mhat+=dl; \
        _Pragma("unroll") for(int r=0;r<16;++r){C0[r]-=dl;C1[r]-=dl;} \
        const float nm_=MSKF((t)>>2)-mhat; _Pragma("unroll") for(int r=0;r<16;++r)negm[r]=nm_; asm volatile("":"+v"(negm)); \
        const float f=__builtin_amdgcn_exp2f(-dl); l_reg*=f; if(hi==0)wsf[r32]=f; resc=true; } } \
    SBAR(); \
    GAPB(o[0]=__builtin_amdgcn_mfma_f32_32x32x16_bf16(PAF(0),VFR(0),o[0],0,0,0), C0,0); \
    GAPB(o[1]=__builtin_amdgcn_mfma_f32_32x32x16_bf16(PAF(0),VFR(4),o[1],0,0,0), C0,4); \
    KRD(GL,0); GAPB(o[0]=__builtin_amdgcn_mfma_f32_32x32x16_bf16(PAF(1),VFR(1),o[0],0,0,0), C0,8); \
    KRD(GL,1); GAPB(o[1]=__builtin_amdgcn_mfma_f32_32x32x16_bf16(PAF(1),VFR(5),o[1],0,0,0), C0,12); \
    KRD(GL,2); GAPB(o[0]=__builtin_amdgcn_mfma_f32_32x32x16_bf16(PAF(2),VFR(2),o[0],0,0,0), C1,0); \
    KRD(GL,3); GAPB(o[1]=__builtin_amdgcn_mfma_f32_32x32x16_bf16(PAF(2),VFR(6),o[1],0,0,0), C1,4); \
    GAPB(o[0]=__builtin_amdgcn_mfma_f32_32x32x16_bf16(PAF(3),VFR(3),o[0],0,0,0), C1,8); \
    GAPB(o[1]=__builtin_amdgcn_mfma_f32_32x32x16_bf16(PAF(3),VFR(7),o[1],0,0,0), C1,12); \
    }while(0)
  int t=1;
  #undef CMASK
  #define CMASK(P0,P1,t) do{}while(0)
  for(;t+5<NT;t+=2){
    STEP(pB0,pB1,pA0,pA1,t,true,true,true);     WAIT_BAR(2); RESC(); ROT(); NEWBLK(t+1);
    STEP(pA0,pA1,pB0,pB1,t+1,true,true,true);   WAIT_BAR(2); RESC(); ROT();
  }
  #undef CMASK
  #define CMASK(P0,P1,t) do{int jb_=(t)-(NT-4); if(jb_>=0)cmask(P0,P1,jb_,qrel,hi);}while(0)
  #define ENDW(tt) do{ if((tt)+3<NT){WAIT_BAR(2);} else if((tt)+2<NT){WAIT_BAR(1);} else {WAIT_BAR(0);} }while(0)
  for(;t+1<NT;t+=2){
    STEP(pB0,pB1,pA0,pA1,t,(t+3<NT),(t+1<NT),(t+1<NT));       ENDW(t);   RESC(); ROT(); NEWBLK(t+1);
    STEP(pA0,pA1,pB0,pB1,t+1,(t+4<NT),(t+2<NT),(t+2<NT));     ENDW(t+1); RESC(); ROT();
  }
  STEP(pB0,pB1,pA0,pA1,NT-1,false,false,false); RESC();
  { float sacc=pB0[0]+pB0[1]; _Pragma("unroll") for(int r=2;r<16;++r)sacc+=pB0[r]; _Pragma("unroll") for(int r=0;r<16;++r)sacc+=pB1[r]; l_reg+=sacc;
    pw0=(u32x4){PKW(pB0,0),PKW(pB0,2),PKW(pB0,4),PKW(pB0,6)};pw1=(u32x4){PKW(pB0,8),PKW(pB0,10),PKW(pB0,12),PKW(pB0,14)};pw2=(u32x4){PKW(pB1,0),PKW(pB1,2),PKW(pB1,4),PKW(pB1,6)};pw3=(u32x4){PKW(pB1,8),PKW(pB1,10),PKW(pB1,12),PKW(pB1,14)};
    SBAR(); pv(o,vb0+sl_cur,PAF(0),PAF(1),PAF(2),PAF(3)); }
  #undef PKW
  #undef PAF
  #undef VFR
  #undef PIN
  #undef MX3
  #undef GAPA
  #undef GAPB
  #undef EX
  #undef VRD
  #undef KRD
  #undef STEP
  #undef ENDW
  {auto rr=__builtin_amdgcn_permlane32_swap(__float_as_uint(l_reg),__float_as_uint(l_reg),false,false);l_reg=__uint_as_float(rr[0])+__uint_as_float(rr[1]);}
  if(hi==0)wsf[32+r32]=l_reg;asm volatile("s_waitcnt lgkmcnt(0)":::"memory");
  float rli[16];
  #pragma unroll
  for(int r=0;r<16;++r)rli[r]=__builtin_amdgcn_rcpf(wsf[32+crow(r,hi)]);
  bf16*Yw=Y+(rowbase+q0+wid*QBLK)*YP+h*D;
  { float*stg=(float*)(shm+LDS_OST)+wid*2048;
    #pragma unroll
    for(int r=0;r<16;++r){const int orow=crow(r,hi);
      #pragma unroll
      for(int d0=0;d0<2;++d0)stg[orow*64+d0*32+r32]=o[d0][r]*rli[r];}
    asm volatile("s_waitcnt lgkmcnt(0)":::"memory");
    const int c4=lane&15; const f32x4_t g4=*reinterpret_cast<const f32x4_t*>(onb_g+h*D+c4*4);
    #pragma unroll
    for(int i=0;i<8;++i){const int row=i*4+(lane>>4); const f32x4_t v=*(const f32x4_t*)(stg+row*64+c4*4);
      float ss=(v[0]*v[0]+v[1]*v[1])+(v[2]*v[2]+v[3]*v[3]); ss+=__shfl_xor(ss,1); ss+=__shfl_xor(ss,2); ss+=__shfl_xor(ss,4); ss+=__shfl_xor(ss,8);
      const float rs=__builtin_amdgcn_rsqf(ss*(1.0f/64.0f)+1e-6f);
      u32x2_t w; w.x=cvtpk_s(v[0]*rs*g4[0],v[1]*rs*g4[1]); w.y=cvtpk_s(v[2]*rs*g4[2],v[3]*rs*g4[3]);
      *(u32x2_t*)(Yw+(long)row*YP+c4*4)=w;} }
  asm volatile("s_waitcnt lgkmcnt(0)\n\ts_barrier":::"memory");
  #undef DMA_K
  #undef DMA_V
  #undef MSKF
  #undef NEWBLK
  #undef CMASK
  #undef START
  #undef RESC
  #undef ROT
}
constexpr int ATTN_LDS_BYTES=LDS_BYTES;
struct AttnTensors { const bf16* Q; const bf16* K; const bf16* V; bf16* Y; const float* ksum; const float* onb_g; };
struct AttnUnit { int bh; int qb; };
struct StaticOrder {
  int vcu,G;
  __device__ __forceinline__ explicit StaticOrder(int grid,int block):vcu((grid%8==0)?(block%8)*(grid/8)+block/8:block),G(grid){}
  __device__ __forceinline__ bool next(int i,AttnUnit&u)const{ const int p=vcu+(i>>1)*G; if(p>=BATCH*NHEAD*4)return false; const int s=p&3; u.bh=p>>2; u.qb=(i&1)?7-s:s; return true; }
  __device__ __forceinline__ void a_ready(const AttnUnit&)const{}
  __device__ __forceinline__ void done(const AttnUnit&)const{}
};
template<class Sched,int THRL=8> __device__ __forceinline__ void attn_phase(char*lds,const AttnTensors&T,const Sched&S){
  AttnUnit u;
  for(int i=0;S.next(i,u);++i){ S.a_ready(u); attn_unit<THRL>(u.bh/NHEAD,u.bh%NHEAD,u.qb,T.Q,T.K,T.V,T.Y,T.ksum,T.onb_g,lds); S.done(u); }
}
#undef SBAR
#undef WAIT_BAR
}
constexpr int NWAVES = 8;
#ifndef MK_N_LAUNCHES
#define MK_N_LAUNCHES 1
#endif
constexpr int PER_PHASE = 6;
constexpr int CW_TMO = 0, CW_CODE = 1;
constexpr int CW_BAR = 4096;
constexpr int RING_OFF = 0, RING_BYTES = 131072;
constexpr int LDSCTL_OFF = RING_BYTES, MISC_OFF = LDSCTL_OFF + 320;
constexpr int LDS_BYTES = 147456;
static_assert(MISC_OFF + 128 <= LDS_BYTES, "LDS map");

#define GAS __attribute__((address_space(1)))
#define LAS __attribute__((address_space(3)))
typedef unsigned short bf16;
typedef unsigned v4u __attribute__((ext_vector_type(4)));
typedef float f32x4 __attribute__((ext_vector_type(4)));
typedef short bf16x8 __attribute__((ext_vector_type(8)));
typedef GAS unsigned gu32;
typedef GAS unsigned long long gu64;
#define RLX_AGENT __ATOMIC_RELAXED, __HIP_MEMORY_SCOPE_AGENT
#define LDS_WAIT() asm volatile("s_waitcnt lgkmcnt(0)" ::: "memory")
#define VM_WAIT() asm volatile("s_waitcnt vmcnt(0)" ::: "memory")
__device__ __forceinline__ unsigned long long rt() { return __builtin_amdgcn_s_memrealtime(); }
__device__ __forceinline__ unsigned f2bf(float f) { unsigned u = __builtin_bit_cast(unsigned, f); return (u + 0x7fffu + ((u >> 16) & 1u)) >> 16; }
__device__ __forceinline__ unsigned pk2(float lo, float hi) { return f2bf(lo) | (f2bf(hi) << 16); }

#define XB_TMO      128
#define XB_XCNT(j)  (256  + 64 * (j))
#define XB_XSUB(j)  (1280 + 64 * (j))
#define XB_XGEN(j)  (2304 + 64 * (j))
#define XB_TOP      3328
#define XB_TOPGEN   3392
#define XCD_BAR_WORDS 3456
#define XB_SPIN_CAP (1u << 18)

__device__ __forceinline__ unsigned xb_ld(unsigned* p)              { return __hip_atomic_load(p, __ATOMIC_RELAXED, __HIP_MEMORY_SCOPE_AGENT); }
__device__ __forceinline__ unsigned xb_add(unsigned* p, unsigned v) { return __hip_atomic_fetch_add(p, v, __ATOMIC_RELAXED, __HIP_MEMORY_SCOPE_AGENT); }
__device__ __forceinline__ unsigned xb_xcc_id() { return (unsigned)__builtin_amdgcn_s_getreg((3 << 11) | 20) & 0xFu; }
#define XB_SPIN(cond, bar) do { unsigned _sp = 0; while (cond) { __builtin_amdgcn_s_sleep(1); \
    if ((++_sp & 255u) == 0u) { if (xb_ld(&(bar)[XB_TMO])) break; if (_sp > XB_SPIN_CAP) { atomicAdd(&(bar)[XB_TMO], 1u); break; } } } } while (0)

struct XcdBarrier {
    unsigned* bar; unsigned x;
    volatile LAS unsigned* st;
};

__device__ __forceinline__ XcdBarrier xcd_barrier_post(unsigned* bar, volatile LAS unsigned* st) {
    XcdBarrier b; b.bar = bar; b.x = xb_xcc_id(); b.st = st;
    if (threadIdx.x == 0) (void)xb_add(&bar[XB_XCNT(b.x)], 1u);
    return b;
}
__device__ __forceinline__ void xcd_barrier_complete(unsigned* bar, unsigned x, unsigned& nloc, unsigned& nx) {
    const unsigned G = gridDim.x * gridDim.y * gridDim.z;
    unsigned sum, cnt, mine, sp = 0u;
    for (;;) {
        sum = 0u; cnt = 0u; mine = 0u;
#pragma unroll
        for (unsigned j = 0; j < 16; ++j) { const unsigned c = xb_ld(&bar[XB_XCNT(j)]); sum += c; cnt += (c > 0u) ? 1u : 0u; mine = (j == x) ? c : mine; }
        if (sum == G) break;
        __builtin_amdgcn_s_sleep(1);
        if ((++sp & 255u) == 0u) { if (xb_ld(&bar[XB_TMO])) break; if (sp > XB_SPIN_CAP) { atomicAdd(&bar[XB_TMO], 1u); break; } }
    }
    nloc = mine > 0u ? mine : 1u; nx = cnt > 0u ? cnt : 1u;
}

__device__ __forceinline__ void xcd_barrier(const XcdBarrier& b) {
    asm volatile("s_waitcnt vmcnt(0)" ::: "memory");
    __syncthreads();
    if (threadIdx.x == 0) {
        unsigned* bar = b.bar;
        __builtin_amdgcn_s_waitcnt(0);
        unsigned nloc = b.st[0], nx = b.st[1];
        if (nloc == 0u) { xcd_barrier_complete(bar, b.x, nloc, nx); b.st[0] = nloc; b.st[1] = nx; }
        const unsigned old = xb_add(&bar[XB_XSUB(b.x)], 1u);
        const unsigned gen = old / nloc;
        if (old + 1u == (gen + 1u) * nloc) {
            __builtin_amdgcn_fence(__ATOMIC_RELEASE, "agent");
            asm volatile("s_waitcnt vmcnt(0)" ::: "memory");
            const unsigned og = xb_add(&bar[XB_TOP], 1u);
            const unsigned tg = og / nx;
            if (og + 1u == (tg + 1u) * nx) xb_add(&bar[XB_TOPGEN], 1u);
            else XB_SPIN(xb_ld(&bar[XB_TOPGEN]) == tg, bar);
            __builtin_amdgcn_fence(__ATOMIC_ACQUIRE, "agent");
            xb_add(&bar[XB_XGEN(b.x)], 1u);
            asm volatile("s_waitcnt vmcnt(0)" ::: "memory");
        } else {
            XB_SPIN(xb_ld(&bar[XB_XGEN(b.x)]) == gen, bar);
            __builtin_amdgcn_fence(__ATOMIC_ACQUIRE, "agent");
            asm volatile("s_waitcnt vmcnt(0)" ::: "memory");
        }
    }
    __syncthreads();
}

struct Frame {
    LAS unsigned char* lds;
    volatile LAS unsigned* MISC;
    gu32* ctl;
    int tid, lane, wave;
    int vcu, G;
};

__device__ __forceinline__ float wave_sum(float v) {
#pragma unroll
    for (int o = 1; o < 64; o <<= 1) v += __shfl_xor(v, o);
    return v;
}
__device__ __forceinline__ void p0_transpose_item(const float* W, int K, int N, const float* g, bf16* WT, int k0, int n0, int orow0, LAS float* scr, int lane) {
#pragma unroll 8
    for (int i = 0; i < 32; ++i) { const int kk = 2 * i + (lane >> 5); float v = W[(size_t)(k0 + kk) * N + n0 + (lane & 31)]; if (g) v *= g[k0 + kk]; scr[kk * 33 + (lane & 31)] = v; }
    LDS_WAIT(); asm volatile("" ::: "memory");
    const int c = lane & 7;
#pragma unroll
    for (int j = 0; j < 4; ++j) { const int n = (lane >> 3) + 8 * j; const LAS float* s = scr + (8 * c) * 33 + n;
        v4u o; o.x = pk2(s[0 * 33], s[1 * 33]); o.y = pk2(s[2 * 33], s[3 * 33]); o.z = pk2(s[4 * 33], s[5 * 33]); o.w = pk2(s[6 * 33], s[7 * 33]);
        *(GAS v4u*)(WT + (size_t)(orow0 + n) * K + k0 + 8 * c) = o; }
    LDS_WAIT(); asm volatile("" ::: "memory");
}
__device__ __forceinline__ void rms_row_to_bf16(int lane, const float* xrow, const float* gain, bf16* orow) {
    const GAS f32x4* xr = (const GAS f32x4*)xrow + lane; const GAS f32x4* gr = (const GAS f32x4*)gain + lane;
    f32x4 v[4]; float s = 0.f;
#pragma unroll
    for (int j = 0; j < 4; ++j) { v[j] = xr[64 * j]; s += (v[j].x * v[j].x + v[j].y * v[j].y) + (v[j].z * v[j].z + v[j].w * v[j].w); }
    const float rstd = 1.f / sqrtf(wave_sum(s) * (1.f / DM) + EPS);
    GAS unsigned long long* o8 = (GAS unsigned long long*)orow + lane;
#pragma unroll
    for (int j = 0; j < 4; ++j) { const f32x4 gg = gr[64 * j]; o8[64 * j] = (unsigned long long)pk2(v[j].x * rstd * gg.x, v[j].y * rstd * gg.y) | ((unsigned long long)pk2(v[j].z * rstd * gg.z, v[j].w * rstd * gg.w) << 32); }
}
struct P0Args { const float *x, *norm1_g, *w_in, *sgu_w, *w_out, *norm2_g, *w_gate, *w_up, *w_down; bf16 *WinT, *WoT, *WguT, *WdT, *SW, *XN; };
__device__ __forceinline__ void p0_prologue(Frame& F, const P0Args& a) {
    LAS float* scr = (LAS float*)(F.lds + RING_OFF + F.wave * 16384);
    const int gw = F.vcu * NWAVES + F.wave, NGW = F.G * NWAVES;
    constexpr int I_IN = (DM / 64) * (INW / 32), I_O = (DM / 64) * (DM / 32), I_G = (DM / 64) * (DFF / 32), I_D = (DFF / 64) * (DM / 32);
    constexpr int NITEMS = I_IN + I_O + 2 * I_G + I_D;
    for (int it = gw; it < NITEMS; it += NGW) {
        int r = it;
        if (r < I_IN) { const int nb = INW / 32, kb = r / nb, n0 = 32 * (r % nb); p0_transpose_item(a.w_in, DM, INW, nullptr, a.WinT, 64 * kb, n0, n0, scr, F.lane); continue; } r -= I_IN;
        if (r < I_O) { const int nb = DM / 32, kb = r / nb, n0 = 32 * (r % nb); p0_transpose_item(a.w_out, DM, DM, nullptr, a.WoT, 64 * kb, n0, n0, scr, F.lane); continue; } r -= I_O;
        if (r < 2 * I_G) { const bool up = r >= I_G; if (up) r -= I_G; const int nb = DFF / 32, kb = r / nb, n0 = 32 * (r % nb);
            p0_transpose_item(up ? a.w_up : a.w_gate, DM, DFF, a.norm2_g, a.WguT, 64 * kb, n0, (n0 >> 7) * 256 + (n0 & 127) + (up ? 128 : 0), scr, F.lane); continue; } r -= 2 * I_G;
        { const int nb = DM / 32, kb = r / nb, n0 = 32 * (r % nb); p0_transpose_item(a.w_down, DFF, DM, nullptr, a.WdT, 64 * kb, n0, n0, scr, F.lane); }
    }
    for (int m = gw; m < M; m += NGW) rms_row_to_bf16(F.lane, a.x + (size_t)m * DM, a.norm1_g, a.XN + (size_t)m * DM);
    for (int i = (F.vcu * NWAVES * 64 + F.tid); i < NH * CHUNK * CHUNK; i += F.G * NWAVES * 64) { const int t = (i / CHUNK) % CHUNK, s = i % CHUNK; a.SW[i] = (bf16)f2bf(s <= t ? a.sgu_w[i] : 0.0f); }
}

constexpr int SGU_V_BYTES = 16384, SGU_U_PITCH = 144, SGU_U_BYTES = 128 * SGU_U_PITCH, SGU_UOFF = 2 * SGU_V_BYTES;
struct SguArgs { const bf16* P; const bf16* SW; const float* sgu_b; const float* ona_g; bf16* Y; };
typedef float f32x16 __attribute__((ext_vector_type(16)));
typedef short s16x4 __attribute__((ext_vector_type(4)));
typedef unsigned u32x2 __attribute__((ext_vector_type(2)));
__device__ __forceinline__ int crow16(int r, int hi) { return (r & 3) + 8 * (r >> 2) + 4 * hi; }
__device__ __forceinline__ void sgu_unit(Frame& F, const SguArgs& a, int unit) {
    const int b = unit >> 6, c = (unit >> 2) & 15, hp = unit & 3;
    const int tid = F.tid, lane = F.lane, wid = F.wave, r32 = lane & 31, hi = lane >> 5;
    const size_t row0 = (size_t)b * SEQ + c * CHUNK;
#pragma unroll
    for (int k = 0; k < 4; ++k) { const int i = tid + 512 * k, hl = i >> 10, row = (i >> 3) & 127, ch = i & 7;
        const bf16* src = a.P + (row0 + row) * INW + (2 * hp + hl) * 64 + ch * 8;
        const v4u vv = *(const GAS v4u*)(src + COL_VA), uu = *(const GAS v4u*)(src + COL_U);
        *(LAS v4u*)(F.lds + RING_OFF + hl * SGU_V_BYTES + (ch >> 2) * 8192 + row * 64 + (ch & 3) * 16) = vv;
        *(LAS v4u*)(F.lds + RING_OFF + SGU_UOFF + hl * SGU_U_BYTES + row * SGU_U_PITCH + ch * 16) = uu; }
    LDS_WAIT(); __syncthreads();
    const int hl = wid >> 2, h = 2 * hp + hl, t0 = 32 * (wid & 3);
    f32x16 acc[2]; acc[0] = f32x16{}; acc[1] = f32x16{};
    const bf16* wrow = a.SW + ((size_t)h * CHUNK + t0 + r32) * CHUNK + 8 * hi;
    const LAS unsigned char* vbase = F.lds + RING_OFF + hl * SGU_V_BYTES + (8 * hi + ((lane & 15) >> 2)) * 64 + 32 * ((lane >> 4) & 1) + 8 * (lane & 3);
    for (int s0 = 0; s0 < t0 + 32; s0 += 16) {
        const bf16x8 wf = *(const GAS bf16x8*)(wrow + s0);
#pragma unroll
        for (int d0 = 0; d0 < 2; ++d0) {
            const s16x4 lo = __builtin_bit_cast(s16x4, __builtin_amdgcn_ds_read_tr16_b64_v4i16((LAS s16x4*)(vbase + d0 * 8192 + s0 * 64)));
            const s16x4 hh = __builtin_bit_cast(s16x4, __builtin_amdgcn_ds_read_tr16_b64_v4i16((LAS s16x4*)(vbase + d0 * 8192 + s0 * 64 + 256)));
            const bf16x8 vf = (bf16x8){lo[0], lo[1], lo[2], lo[3], hh[0], hh[1], hh[2], hh[3]};
            acc[d0] = __builtin_amdgcn_mfma_f32_32x32x16_bf16(vf, wf, acc[d0], 0, 0, 0);
        }
    }
    const float bias = a.sgu_b[h * CHUNK + t0 + r32];
    LAS unsigned char* urow = F.lds + RING_OFF + SGU_UOFF + hl * SGU_U_BYTES + (t0 + r32) * SGU_U_PITCH;
    float y[2][16]; float ss = 0.f;
#pragma unroll
    for (int d0 = 0; d0 < 2; ++d0)
#pragma unroll
        for (int g = 0; g < 4; ++g) { const u32x2 uw = *(const LAS u32x2*)(urow + (32 * d0 + 8 * g + 4 * hi) * 2);
            const float u0 = __builtin_bit_cast(float, uw.x << 16), u1 = __builtin_bit_cast(float, uw.x & 0xffff0000u), u2 = __builtin_bit_cast(float, uw.y << 16), u3 = __builtin_bit_cast(float, uw.y & 0xffff0000u);
            y[d0][4 * g + 0] = u0 * (acc[d0][4 * g + 0] + bias); y[d0][4 * g + 1] = u1 * (acc[d0][4 * g + 1] + bias); y[d0][4 * g + 2] = u2 * (acc[d0][4 * g + 2] + bias); y[d0][4 * g + 3] = u3 * (acc[d0][4 * g + 3] + bias);
            ss += (y[d0][4 * g] * y[d0][4 * g] + y[d0][4 * g + 1] * y[d0][4 * g + 1]) + (y[d0][4 * g + 2] * y[d0][4 * g + 2] + y[d0][4 * g + 3] * y[d0][4 * g + 3]); }
    ss += __shfl_xor(ss, 32);
    const float rs = __builtin_amdgcn_rsqf(ss * (1.0f / 64.0f) + EPS);
#pragma unroll
    for (int d0 = 0; d0 < 2; ++d0)
#pragma unroll
        for (int g = 0; g < 4; ++g) { const f32x4 gg = *(const GAS f32x4*)(a.ona_g + h * 64 + 32 * d0 + 8 * g + 4 * hi);
            u32x2 w; w.x = pk2(y[d0][4 * g] * rs * gg.x, y[d0][4 * g + 1] * rs * gg.y); w.y = pk2(y[d0][4 * g + 2] * rs * gg.z, y[d0][4 * g + 3] * rs * gg.w);
            *(LAS u32x2*)(urow + (32 * d0 + 8 * g + 4 * hi) * 2) = w; }
    LDS_WAIT(); asm volatile("" ::: "memory");
#pragma unroll
    for (int i = 0; i < 4; ++i) { const int row = t0 + i * 8 + (lane >> 3), ch = lane & 7;
        const v4u vv = *(const LAS v4u*)(F.lds + RING_OFF + SGU_UOFF + hl * SGU_U_BYTES + row * SGU_U_PITCH + ch * 16);
        *(GAS v4u*)(a.Y + (row0 + row) * DM + h * 64 + ch * 8) = vv; }
    LDS_WAIT(); __syncthreads();
}

struct Args { const float* in[16]; float* out; unsigned char* ws; int ph_lo, ph_hi; };
__global__ void __launch_bounds__(NWAVES * 64, 2) mega_fwd(Args args) {
    extern __shared__ __attribute__((aligned(16))) unsigned char lds[];
    Frame F;
    F.lds = (LAS unsigned char*)lds;
    F.MISC = (volatile LAS unsigned*)(F.lds + MISC_OFF);
    F.tid = threadIdx.x; F.lane = F.tid & 63; F.wave = __builtin_amdgcn_readfirstlane(F.tid >> 6);
    F.G = gridDim.x; { const int bx = blockIdx.x; F.vcu = (F.G % 8 == 0) ? (bx % 8) * (F.G / 8) + bx / 8 : bx; }
    unsigned char* ws = args.ws;
    F.ctl = (gu32*)(ws + WS_CTL);
    const float* x = args.in[0]; const float* norm1_g = args.in[1]; const float* w_in = args.in[2]; const float* ln_g = args.in[3]; const float* ln_b = args.in[4];
    const float* sgu_w = args.in[5]; const float* sgu_b = args.in[6]; const float* q_g = args.in[7]; const float* k_g = args.in[8]; const float* ona_g = args.in[9]; const float* onb_g = args.in[10];
    const float* w_out = args.in[11]; const float* norm2_g = args.in[12]; const float* w_gate = args.in[13]; const float* w_up = args.in[14]; const float* w_down = args.in[15];
    float* out = args.out;
    bf16* WinT = (bf16*)(ws + WS_WIN); bf16* WoT = (bf16*)(ws + WS_WO); bf16* WguT = (bf16*)(ws + WS_WGU); bf16* WdT = (bf16*)(ws + WS_WD); bf16* SW = (bf16*)(ws + WS_SW);
    float* ksum = (float*)(ws + WS_KSUM); float* rowss = (float*)(ws + WS_ROWSS);
    bf16* XN = (bf16*)(ws + WS_XN); bf16* X1B = XN; bf16* Yb = (bf16*)(ws + WS_Y); bf16* PROJ = (bf16*)(ws + WS_PROJ); bf16* HID = PROJ;
    for (int u = F.tid; u < (LDS_BYTES - LDSCTL_OFF) / 4; u += NWAVES * 64) ((LAS unsigned*)(F.lds + LDSCTL_OFF))[u] = 0u;
    __syncthreads();
    const bool one_launch = (args.ph_hi - args.ph_lo) > 1;
    XcdBarrier bar; bar.bar = (unsigned*)(F.ctl + CW_BAR); bar.x = 0; bar.st = nullptr;
    if (one_launch) bar = xcd_barrier_post((unsigned*)(F.ctl + CW_BAR), F.MISC + 8);
    const int lo = args.ph_lo, hi = args.ph_hi;
#ifndef PH_MASK
#define PH_MASK 63
#endif
#define IN(k) (((PH_MASK >> (k)) & 1) && lo <= (k) && (k) < hi)
#define BOTH(k) (IN(k) && IN((k) + 1))
#define GRID_BAR() xcd_barrier(bar)

    if (IN(0)) { const P0Args a{x, norm1_g, w_in, sgu_w, w_out, norm2_g, w_gate, w_up, w_down, WinT, WoT, WguT, WdT, SW, XN}; p0_prologue(F, a); if (BOTH(0)) GRID_BAR(); }

    if (IN(1)) {
        pg8::Gemm g{XN, WinT, M, INW, DM}; pg8::StaticOrder S; S.init(M, INW, F.G, (int)blockIdx.x);
        pg8::EpiInProj E{PROJ, ln_g, ln_b, q_g, k_g, ksum};
        pg8::gemm_phase<pg8::EpiInProj, pg8::StaticOrder, PG8_ALIGN, PG8_SP2>(F.lds + RING_OFF, g, S, E);
        if (BOTH(1)) GRID_BAR();
    }

    if (IN(2)) {
        const SguArgs sa{PROJ, SW, sgu_b, ona_g, Yb};
        for (int u = F.vcu; u < BATCH * 16 * 4; u += F.G) sgu_unit(F, sa, u);
        static_assert(attn_body::ATTN_LDS_BYTES <= RING_BYTES && attn_body::ATTN_PITCH == INW, "attention body geometry vs frame");
        const attn_body::AttnTensors AT{(const attn_body::bf16*)(PROJ + COL_Q), (const attn_body::bf16*)(PROJ + COL_K), (const attn_body::bf16*)(PROJ + COL_V), (attn_body::bf16*)(Yb + WA), ksum, onb_g};
        const attn_body::StaticOrder S((int)F.G, (int)blockIdx.x);
        attn_body::attn_phase<attn_body::StaticOrder>((char*)lds + RING_OFF, AT, S);
        if (BOTH(2)) GRID_BAR();
    }

    if (IN(3)) {
        pg8::Gemm g{Yb, WoT, M, DM, DM}; pg8::StaticOrder S; S.init(M, DM, F.G, (int)blockIdx.x);
        pg8::EpiOutProj E{x, out, X1B, rowss};
        if (F.G == 256) pg8::gemm_phase<pg8::EpiOutProj, pg8::StaticOrder, false, PG8_SP2>(F.lds + RING_OFF, g, S, E);
        if (BOTH(3)) GRID_BAR();
    }

    if (IN(4)) {
        pg8::Gemm g{X1B, WguT, M, NGU, DM}; pg8::StaticOrder S; S.init(M, NGU, F.G, (int)blockIdx.x);
        pg8::EpiGateUp E{HID, rowss};
        pg8::gemm_phase<pg8::EpiGateUp, pg8::StaticOrder, PG8_ALIGN, PG8_SP2>(F.lds + RING_OFF, g, S, E);
        if (BOTH(4)) GRID_BAR();
    }

    if (IN(5)) {
        pg8::Gemm g{HID, WdT, M, DM, DFF}; pg8::StaticOrder S; S.init(M, DM, F.G, (int)blockIdx.x);
        pg8::EpiDown E{out};
        pg8::gemm_phase<pg8::EpiDown, pg8::StaticOrder, PG8_ALIGN, PG8_SP2>(F.lds + RING_OFF, g, S, E);
    }
#undef IN
#undef BOTH
#undef GRID_BAR
}


#ifndef NAIVE_MASK
#define NAIVE_MASK 0
#endif
#if NAIVE_MASK
namespace naive {
typedef unsigned short bf16_t;
typedef float f32x4 __attribute__((ext_vector_type(4)));
typedef unsigned u32x4 __attribute__((ext_vector_type(4)));
__device__ __forceinline__ unsigned f2bf(float f) { unsigned u = __builtin_bit_cast(unsigned, f); return (u + 0x7fffu + ((u >> 16) & 1u)) >> 16; }
__device__ __forceinline__ float bf2f(bf16_t b) { return __builtin_bit_cast(float, (unsigned)b << 16); }
__device__ __forceinline__ float wave_sum(float v) {
#pragma unroll
    for (int o = 1; o < 64; o <<= 1) v += __shfl_xor(v, o);
    return v;
}
__device__ __forceinline__ float wave_max(float v) {
#pragma unroll
    for (int o = 1; o < 64; o <<= 1) v = fmaxf(v, __shfl_xor(v, o));
    return v;
}
__device__ __forceinline__ float gelu_tanh(float x) {
    const float z = 0.7978845608028654f * (x + 0.044715f * x * x * x);
    return x / (1.0f + __expf(-2.0f * z));
}
__device__ __forceinline__ float silu(float x) { return x / (1.0f + __expf(-x)); }

__global__ void k_rmsnorm_x(const float* __restrict__ x, const float* __restrict__ g, bf16_t* __restrict__ xn) {
    const int row = blockIdx.x * 4 + (threadIdx.x >> 6), lane = threadIdx.x & 63;
    const float* xr = x + (size_t)row * DM;
    float v[16]; float s = 0.f;
#pragma unroll
    for (int j = 0; j < 16; ++j) { v[j] = xr[lane + 64 * j]; s += v[j] * v[j]; }
    const float rstd = 1.0f / sqrtf(wave_sum(s) * (1.0f / DM) + EPS);
#pragma unroll
    for (int j = 0; j < 16; ++j) xn[(size_t)row * DM + lane + 64 * j] = (bf16_t)f2bf(v[j] * rstd * g[lane + 64 * j]);
}
__global__ void k_transpose_w(const float* __restrict__ W, int K, int N, const float* __restrict__ g, bf16_t* __restrict__ WT) {
    const size_t i = (size_t)blockIdx.x * 256 + threadIdx.x; if (i >= (size_t)K * N) return;
    const int n = (int)(i / K), k = (int)(i % K);
    WT[i] = (bf16_t)f2bf(W[(size_t)k * N + n] * (g ? g[k] : 1.0f));
}
__global__ void k_transpose_gu(const float* __restrict__ Wg, const float* __restrict__ Wu, const float* __restrict__ g, bf16_t* __restrict__ WT) {
    const size_t i = (size_t)blockIdx.x * 256 + threadIdx.x; if (i >= (size_t)2 * DFF * DM) return;
    const int r = (int)(i / DM), k = (int)(i % DM);
    const int blk = r / 256, w = r % 256, j = blk * 128 + (w & 127);
    const float* W = (w < 128) ? Wg : Wu;
    WT[i] = (bf16_t)f2bf(W[(size_t)k * DFF + j] * g[k]);
}
__global__ void k_sgu_w(const float* __restrict__ w, bf16_t* __restrict__ sw) {
    const int i = blockIdx.x * 256 + threadIdx.x; if (i >= NH * CHUNK * CHUNK) return;
    const int t = (i / CHUNK) % CHUNK, s = i % CHUNK;
    sw[i] = (bf16_t)f2bf(s <= t ? w[i] : 0.0f);
}

__device__ __forceinline__ void naive_tile(const bf16_t* __restrict__ A, int lda, const bf16_t* __restrict__ B, int ldb, int K, float (&acc)[4][4], float* As, float* Bs) {
    const int tid = threadIdx.x, ty = tid >> 4, tx = tid & 15;
    const int lr = tid >> 2, lk = (tid & 3) * 8;
#pragma unroll
    for (int i = 0; i < 4; ++i)
#pragma unroll
        for (int j = 0; j < 4; ++j) acc[i][j] = 0.f;
    for (int k0 = 0; k0 < K; k0 += 32) {
        const u32x4 av = *(const u32x4*)(A + (size_t)lr * lda + k0 + lk);
        const u32x4 bv = *(const u32x4*)(B + (size_t)lr * ldb + k0 + lk);
        __syncthreads();
#pragma unroll
        for (int e = 0; e < 4; ++e) {
            As[(lk + 2 * e) * 65 + lr] = __builtin_bit_cast(float, av[e] << 16);
            As[(lk + 2 * e + 1) * 65 + lr] = __builtin_bit_cast(float, av[e] & 0xffff0000u);
            Bs[(lk + 2 * e) * 65 + lr] = __builtin_bit_cast(float, bv[e] << 16);
            Bs[(lk + 2 * e + 1) * 65 + lr] = __builtin_bit_cast(float, bv[e] & 0xffff0000u);
        }
        __syncthreads();
#pragma unroll 8
        for (int kk = 0; kk < 32; ++kk) {
            float a[4], b[4];
#pragma unroll
            for (int i = 0; i < 4; ++i) { a[i] = As[kk * 65 + ty * 4 + i]; b[i] = Bs[kk * 65 + tx * 4 + i]; }
#pragma unroll
            for (int i = 0; i < 4; ++i)
#pragma unroll
                for (int j = 0; j < 4; ++j) acc[i][j] += a[i] * b[j];
        }
    }
}

__global__ void __launch_bounds__(256) k_inproj(const bf16_t* __restrict__ XN, const bf16_t* __restrict__ WinT, bf16_t* __restrict__ PROJ,
                                               const float* __restrict__ ln_g, const float* __restrict__ ln_b, const float* __restrict__ q_g, const float* __restrict__ k_g) {
    __shared__ float As[32 * 65], Bs[32 * 65], T[64 * 65];
    const int rb = blockIdx.x, cb = blockIdx.y;
    float acc[4][4];
    naive_tile(XN + (size_t)rb * 64 * DM, DM, WinT + (size_t)cb * 64 * DM, DM, DM, acc, As, Bs);
    const int tid = threadIdx.x, ty = tid >> 4, tx = tid & 15;
#pragma unroll
    for (int i = 0; i < 4; ++i)
#pragma unroll
        for (int j = 0; j < 4; ++j) T[(ty * 4 + i) * 65 + tx * 4 + j] = acc[i][j];
    __syncthreads();
    if (tid < 64) {
        const int seg = cb >> 3, h = cb & 7; const float* t = T + tid * 65;
        bf16_t* o = PROJ + (size_t)(rb * 64 + tid) * INW + cb * 64;
        if (seg == 0) { for (int d = 0; d < 64; ++d) o[d] = (bf16_t)f2bf(gelu_tanh(t[d])); }
        else if (seg == 1) {
            float mu = 0.f; for (int d = 0; d < 64; ++d) mu += gelu_tanh(t[d]); mu *= (1.0f / 64);
            float var = 0.f; for (int d = 0; d < 64; ++d) { const float c = gelu_tanh(t[d]) - mu; var += c * c; } var *= (1.0f / 64);
            const float rs = 1.0f / sqrtf(var + EPS);
            for (int d = 0; d < 64; ++d) o[d] = (bf16_t)f2bf((gelu_tanh(t[d]) - mu) * rs * ln_g[h * 64 + d] + ln_b[h * 64 + d]);
        } else if (seg == 2 || seg == 3) {
            float ss = 0.f; for (int d = 0; d < 64; ++d) ss += t[d] * t[d];
            const float rs = 1.0f / sqrtf(ss * (1.0f / 64) + EPS);
            const float* g = (seg == 2) ? q_g : k_g; const float sc = (seg == 2) ? C2 : 1.0f;
            for (int d = 0; d < 64; ++d) o[d] = (bf16_t)f2bf(t[d] * rs * g[d] * sc);
        } else { for (int d = 0; d < 64; ++d) o[d] = (bf16_t)f2bf(t[d]); }
    }
}
__global__ void k_kmean(const bf16_t* __restrict__ PROJ, float* __restrict__ kmean) {
    const int i = blockIdx.x * 256 + threadIdx.x;
    const int d = i & 63, h = (i >> 6) & 7, n = (i >> 9) & 7, b = i >> 12;
    float s = 0.f;
    for (int r = 0; r < MBLK; ++r) s += bf2f(PROJ[(size_t)(b * SEQ + n * MBLK + r) * INW + COL_K + h * 64 + d]);
    kmean[i] = s * (1.0f / MBLK);
}
__global__ void __launch_bounds__(256) k_sgu(const bf16_t* __restrict__ PROJ, const bf16_t* __restrict__ SW, const float* __restrict__ sgu_b, const float* __restrict__ ona_g, bf16_t* __restrict__ Y) {
    const int gw = blockIdx.x * 4 + (threadIdx.x >> 6), lane = threadIdx.x & 63;
    const int token = gw >> 3, h = gw & 7, t = token & (CHUNK - 1), c0 = token - t;
    const bf16_t* w = SW + ((size_t)h * CHUNK + t) * CHUNK;
    float mixed = 0.f;
    for (int s = 0; s <= t; ++s) mixed += bf2f(w[s]) * bf2f(PROJ[(size_t)(c0 + s) * INW + COL_VA + h * 64 + lane]);
    mixed += sgu_b[h * CHUNK + t];
    const float y = bf2f(PROJ[(size_t)token * INW + COL_U + h * 64 + lane]) * mixed;
    const float rs = 1.0f / sqrtf(wave_sum(y * y) * (1.0f / 64) + EPS);
    Y[(size_t)token * DM + h * 64 + lane] = (bf16_t)f2bf(y * rs * ona_g[h * 64 + lane]);
}
__global__ void __launch_bounds__(256) k_moba(const bf16_t* __restrict__ PROJ, const float* __restrict__ kmean, const float* __restrict__ onb_g, bf16_t* __restrict__ Y) {
    __shared__ float qs[4][64], ps[4][64];
    const int wid = threadIdx.x >> 6, lane = threadIdx.x & 63;
    const int gw = blockIdx.x * 4 + wid;
    const int token = gw >> 3, h = gw & 7, b = token / SEQ, s = token % SEQ, j = s / MBLK;
    const float qv = bf2f(PROJ[(size_t)token * INW + COL_Q + h * 64 + lane]);
    qs[wid][lane] = qv;
    float gate[7];
#pragma unroll
    for (int n = 0; n < 7; ++n) gate[n] = (n < j) ? wave_sum(qv * kmean[((b * NBLK + n) * NH + h) * 64 + lane]) : -INFINITY;
    unsigned sel = 0;
#pragma unroll
    for (int n = 0; n < 7; ++n) {
        int rank = 0;
#pragma unroll
        for (int m = 0; m < 7; ++m) if (m != n && m < j) rank += (gate[m] > gate[n] || (gate[m] == gate[n] && m < n)) ? 1 : 0;
        if (n < j && rank < 3) sel |= 1u << n;
    }
    __syncthreads();
    float mrun = -INFINITY, l = 0.f, o = 0.f;
    for (int n = 0; n <= j; ++n) {
        if (n < j && !((sel >> n) & 1u)) continue;
        for (int kt = 0; kt < 4; ++kt) {
            const int key0 = n * MBLK + kt * 64;
            if (n == j && key0 > s) break;
            const int key = key0 + lane;
            const bf16_t* kr = PROJ + (size_t)(b * SEQ + key) * INW + COL_K + h * 64;
            float sc = 0.f;
            for (int d = 0; d < 64; ++d) sc += qs[wid][d] * bf2f(kr[d]);
            if (key > s) sc = -INFINITY;
            const float mnew = fmaxf(mrun, wave_max(sc));
            const float alpha = exp2f(mrun - mnew);
            const float p = exp2f(sc - mnew);
            l = l * alpha + wave_sum(p);
            ps[wid][lane] = p;
            __builtin_amdgcn_s_waitcnt(0xC07F);
            o *= alpha;
            const bf16_t* vr = PROJ + (size_t)(b * SEQ + key0) * INW + COL_V + h * 64 + lane;
            for (int kk = 0; kk < 64; ++kk) o += ps[wid][kk] * bf2f(vr[(size_t)kk * INW]);
            mrun = mnew;
        }
    }
    o /= l;
    const float rs = 1.0f / sqrtf(wave_sum(o * o) * (1.0f / 64) + EPS);
    Y[(size_t)token * DM + WA + h * 64 + lane] = (bf16_t)f2bf(o * rs * onb_g[h * 64 + lane]);
}
__global__ void __launch_bounds__(256) k_outproj(const bf16_t* __restrict__ Yb, const bf16_t* __restrict__ WoT, const float* __restrict__ x, float* __restrict__ x1, bf16_t* __restrict__ x1b) {
    __shared__ float As[32 * 65], Bs[32 * 65];
    const int rb = blockIdx.x, cb = blockIdx.y;
    float acc[4][4];
    naive_tile(Yb + (size_t)rb * 64 * DM, DM, WoT + (size_t)cb * 64 * DM, DM, DM, acc, As, Bs);
    const int tid = threadIdx.x, ty = tid >> 4, tx = tid & 15;
#pragma unroll
    for (int i = 0; i < 4; ++i)
#pragma unroll
        for (int j = 0; j < 4; ++j) { const size_t off = (size_t)(rb * 64 + ty * 4 + i) * DM + cb * 64 + tx * 4 + j; const float v = x[off] + acc[i][j]; x1[off] = v; x1b[off] = (bf16_t)f2bf(v); }
}
__global__ void k_rowss(const float* __restrict__ x1, float* __restrict__ rowss) {
    const int row = blockIdx.x * 4 + (threadIdx.x >> 6), lane = threadIdx.x & 63;
    float s = 0.f;
    for (int j = 0; j < 16; ++j) { const float v = x1[(size_t)row * DM + lane + 64 * j]; s += v * v; }
    s = wave_sum(s);
    if (lane < 4) rowss[row * 4 + lane] = (lane == 0) ? s : 0.f;
}
__global__ void __launch_bounds__(256) k_gateup(const bf16_t* __restrict__ X1B, const bf16_t* __restrict__ WguT, const float* __restrict__ rowss, bf16_t* __restrict__ HID) {
    __shared__ float As[32 * 65], Bs[32 * 65];
    const int rb = blockIdx.x, cb = blockIdx.y;
    const int j0 = cb * 64, grow = (j0 / 128) * 256 + (j0 % 128);
    float ag[4][4], au[4][4];
    naive_tile(X1B + (size_t)rb * 64 * DM, DM, WguT + (size_t)grow * DM, DM, DM, ag, As, Bs);
    naive_tile(X1B + (size_t)rb * 64 * DM, DM, WguT + (size_t)(grow + 128) * DM, DM, DM, au, As, Bs);
    const int tid = threadIdx.x, ty = tid >> 4, tx = tid & 15;
#pragma unroll
    for (int i = 0; i < 4; ++i) {
        const int row = rb * 64 + ty * 4 + i;
        const float ss = (rowss[row * 4] + rowss[row * 4 + 1]) + (rowss[row * 4 + 2] + rowss[row * 4 + 3]);
        const float rs = 1.0f / sqrtf(ss * (1.0f / DM) + EPS);
#pragma unroll
        for (int j = 0; j < 4; ++j) HID[(size_t)row * DFF + j0 + tx * 4 + j] = (bf16_t)f2bf(silu(ag[i][j] * rs) * (au[i][j] * rs));
    }
}
__global__ void __launch_bounds__(256) k_down(const bf16_t* __restrict__ HID, const bf16_t* __restrict__ WdT, float* __restrict__ out) {
    __shared__ float As[32 * 65], Bs[32 * 65];
    const int rb = blockIdx.x, cb = blockIdx.y;
    float acc[4][4];
    naive_tile(HID + (size_t)rb * 64 * DFF, DFF, WdT + (size_t)cb * 64 * DFF, DFF, DFF, acc, As, Bs);
    const int tid = threadIdx.x, ty = tid >> 4, tx = tid & 15;
#pragma unroll
    for (int i = 0; i < 4; ++i)
#pragma unroll
        for (int j = 0; j < 4; ++j) { const size_t off = (size_t)(rb * 64 + ty * 4 + i) * DM + cb * 64 + tx * 4 + j; out[off] = out[off] + acc[i][j]; }
}


}
#endif

extern "C" void kernel_launch(void* const* d_in, const int* in_sizes, int n_in, void* d_out, int out_size, void* d_ws, size_t ws_size, hipStream_t stream) {
    static int grid = 0;
    if (grid == 0) {
        if (n_in != 16 || in_sizes[0] != M * DM || out_size != M * DM || ws_size < WS_END) { fprintf(stderr, "kernel_launch: built for 16 inputs, x and out of %d floats, >= %zu bytes of workspace; got n_in %d, in0 %d, out %d, ws %zu; nothing launched\n", M * DM, (size_t)WS_END, n_in, n_in > 0 ? in_sizes[0] : -1, out_size, ws_size); grid = -1; return; }
        int dev = 0, cus = 0, per_cu = 0;
        if (hipGetDevice(&dev) != hipSuccess || hipDeviceGetAttribute(&cus, hipDeviceAttributeMultiprocessorCount, dev) != hipSuccess) { fprintf(stderr, "kernel_launch: hipGetDevice / hipDeviceGetAttribute failed; nothing launched\n"); grid = -1; return; }
        if (hipFuncSetAttribute((const void*)mega_fwd, hipFuncAttributeMaxDynamicSharedMemorySize, LDS_BYTES) != hipSuccess) { fprintf(stderr, "kernel_launch: hipFuncSetAttribute failed\n"); grid = -1; return; }
        if (hipOccupancyMaxActiveBlocksPerMultiprocessor(&per_cu, (const void*)mega_fwd, NWAVES * 64, LDS_BYTES) != hipSuccess || per_cu < 1) { fprintf(stderr, "kernel_launch: occupancy query reports %d workgroups per CU; nothing launched\n", per_cu); (void)hipGetLastError(); grid = -1; return; }
        grid = cus;
        if (grid != 256) fprintf(stderr, "kernel_launch: %d CUs; the out-proj phase needs exactly 256 workgroups\n", grid);
    }
    if (grid < 0) return;
    if (hipMemsetAsync((char*)d_ws + WS_CTL, 0, CTL_ZERO_BYTES, stream) != hipSuccess) { fprintf(stderr, "kernel_launch: hipMemsetAsync of the control words failed; nothing launched\n"); return; }
    Args a{};
    for (int i = 0; i < 16; ++i) a.in[i] = (const float*)d_in[i];
    a.out = (float*)d_out; a.ws = (unsigned char*)d_ws;
    for (int li = 0; li < MK_N_LAUNCHES; ++li) {
        a.ph_lo = (MK_N_LAUNCHES == PER_PHASE) ? li : 0; a.ph_hi = (MK_N_LAUNCHES == PER_PHASE) ? li + 1 : PER_PHASE;
#if NAIVE_MASK
        if (MK_N_LAUNCHES == PER_PHASE && ((NAIVE_MASK >> li) & 1)) {
            using namespace naive; unsigned char* ws = (unsigned char*)d_ws; float* out = (float*)d_out; const float* const* in = (const float* const*)d_in;
            bf16_t* WinT = (bf16_t*)(ws + WS_WIN); bf16_t* WoT = (bf16_t*)(ws + WS_WO); bf16_t* WguT = (bf16_t*)(ws + WS_WGU); bf16_t* WdT = (bf16_t*)(ws + WS_WD); bf16_t* SW = (bf16_t*)(ws + WS_SW);
            float* kmean = (float*)(ws + WS_KSUM); float* rowss = (float*)(ws + WS_ROWSS); bf16_t* XN = (bf16_t*)(ws + WS_XN); bf16_t* Yb = (bf16_t*)(ws + WS_Y); bf16_t* PROJ = (bf16_t*)(ws + WS_PROJ); bf16_t* HID = PROJ; bf16_t* X1B = XN;
            if (li == 0) { k_rmsnorm_x<<<M / 4, 256, 0, stream>>>(in[0], in[1], XN); k_transpose_w<<<(DM * INW + 255) / 256, 256, 0, stream>>>(in[2], DM, INW, nullptr, WinT); k_transpose_w<<<(DM * DM + 255) / 256, 256, 0, stream>>>(in[11], DM, DM, nullptr, WoT);
                k_transpose_gu<<<(2 * DFF * DM + 255) / 256, 256, 0, stream>>>(in[13], in[14], in[12], WguT); k_transpose_w<<<(DFF * DM + 255) / 256, 256, 0, stream>>>(in[15], DFF, DM, nullptr, WdT); k_sgu_w<<<(NH * CHUNK * CHUNK + 255) / 256, 256, 0, stream>>>(in[5], SW); }
            if (li == 1) { k_inproj<<<dim3(M / 64, INW / 64), 256, 0, stream>>>(XN, WinT, PROJ, in[3], in[4], in[7], in[8]); k_kmean<<<BATCH * NBLK * NH * 64 / 256, 256, 0, stream>>>(PROJ, kmean); }
            if (li == 2) { k_sgu<<<M * NH / 4, 256, 0, stream>>>(PROJ, SW, in[6], in[9], Yb); k_moba<<<M * NH / 4, 256, 0, stream>>>(PROJ, kmean, in[10], Yb); }
            if (li == 3) { k_outproj<<<dim3(M / 64, DM / 64), 256, 0, stream>>>(Yb, WoT, in[0], out, X1B); k_rowss<<<M / 4, 256, 0, stream>>>(out, rowss); }
            if (li == 4) k_gateup<<<dim3(M / 64, DFF / 64), 256, 0, stream>>>(X1B, WguT, rowss, HID);
            if (li == 5) k_down<<<dim3(M / 64, DM / 64), 256, 0, stream>>>(HID, WdT, out);
            continue;
        }
#endif
        hipLaunchKernelGGL(mega_fwd, dim3(grid), dim3(NWAVES * 64), LDS_BYTES, stream, a);
        const hipError_t le = hipPeekAtLastError();
        if (le != hipSuccess) { fprintf(stderr, "kernel_launch: launch %d failed: %s (grid %d x %d threads, %d B LDS)\n", li, hipGetErrorName(le), grid, NWAVES * 64, LDS_BYTES); break; }
    }
}
```

```cpp
#include <hip/hip_runtime.h>
#include <hip/hip_bf16.h>
#include <cstdio>
#include <cstdint>
#include <cmath>

constexpr int BATCH = 8, SEQ = 2048, DM = 1024, M = BATCH * SEQ;
constexpr int NH = 8, HD = 64, WA = 512, INW = 2560, CHUNK = 128, MBLK = 256, NBLK = SEQ / MBLK, DFF = 2816, NGU = 2 * DFF;
constexpr float EPS = 1e-6f;
constexpr float WGU_SCALE = 32.0f, WD_SCALE = 64.0f;
constexpr float C2 = 0.125f * 1.4426950408889634f;
constexpr int COL_U = 0, COL_VA = 512, COL_Q = 1024, COL_K = 1536, COL_V = 2048;

constexpr size_t MiB = 1u << 20;
constexpr size_t WS_CTL = 0;
constexpr size_t WS_KSUM = 512 * 1024;
constexpr size_t WS_WIN = 1 * MiB;
constexpr size_t WS_WO = 6 * MiB;
constexpr size_t WS_WGU = 8 * MiB;
constexpr size_t WS_WD = 19 * MiB;
constexpr size_t WS_SW = 25 * MiB;
constexpr size_t WS_ROWSS = 26 * MiB;
constexpr size_t WS_XN = 32 * MiB;
constexpr size_t WS_Y = 64 * MiB;
constexpr size_t WS_PROJ = 96 * MiB;
constexpr size_t WS_X1Q = 184 * MiB;
constexpr size_t WS_END = 200 * MiB;

namespace pg8 {
#define PG8_LAS __attribute__((address_space(3)))
typedef unsigned short bf16_t;
typedef short bf16x8 __attribute__((ext_vector_type(8)));
typedef float f32x4 __attribute__((ext_vector_type(4)));
typedef unsigned u32x4 __attribute__((ext_vector_type(4)));
typedef int v4i_t __attribute__((ext_vector_type(4)));
typedef unsigned u32x2 __attribute__((ext_vector_type(2)));
constexpr int BM = 256, BK = 64, HALF = 128, HTB = HALF * BK * 2  , STAGE_BYTES = 8 * HTB, NXCD = 8, WGM = 8;

__host__ __device__ __forceinline__ int lds_byte(int r, int c) { const int st = (r >> 4) * 2 + (c >> 5), rr = r & 15, cc = c & 31, ob = rr * 64 + cc * 2; return st * 1024 + (ob ^ (((ob >> 9) & 1) << 5)); }
__host__ __device__ __forceinline__ void stage_rc(int b, int& R, int& C) { const int st = b / 1024, sb = b % 1024, swz = sb ^ (((sb >> 9) & 1) << 5); R = (st >> 1) * 16 + swz / 64; C = (st & 1) * 32 + (swz % 64) / 2; }
__host__ __device__ __forceinline__ int perm32(int rho) { const int n = rho >> 4, i = rho & 15; return 8 * (i >> 2) + 4 * n + (i & 3); }

struct Unit { int pm, pn; };
struct Gemm { const bf16_t* A; const bf16_t* Bt; int M, N, K; };

struct StaticOrder {
    int nM, nN, nwg, G, c;
    __host__ __device__ void init(int M, int N, int G_, int c_) { nM = M / BM; nN = N / BM; nwg = nM * nN; G = G_; c = c_; }
    __host__ __device__ bool next(int i, Unit& u) const {
        const long L = (long)i * G + c; if (L >= nwg) return false;
        int wgid = (int)L; { const int q = nwg / NXCD, r = nwg % NXCD, xcd = wgid % NXCD, off = wgid / NXCD; wgid = (xcd < r ? xcd * (q + 1) : r * (q + 1) + (xcd - r) * q) + off; }
        const int nig = WGM * nN, gid = wgid / nig, fm = gid * WGM, gsz = (nM - fm) < WGM ? (nM - fm) : WGM;
        u.pm = fm + ((wgid % nig) % gsz); u.pn = (wgid % nig) / gsz; return true;
    }
    __device__ __forceinline__ void a_ready(const Unit&) const {}
    __device__ __forceinline__ void done(const Unit&) const {}
};

__device__ __forceinline__ unsigned cvt_pk_bf16(float lo, float hi) { unsigned r; asm volatile("v_cvt_pk_bf16_f32 %0, %1, %2" : "=v"(r) : "v"(lo), "v"(hi)); return r; }
__device__ __forceinline__ float gelu_tanh_f(float x) {
    const float t = x * (-2.3022082f + -0.10294324f * (x * x));
    return x * __builtin_amdgcn_rcpf(1.0f + __builtin_amdgcn_exp2f(t));
}
__device__ __forceinline__ float silu_f(float x) { return x * __builtin_amdgcn_rcpf(1.0f + __builtin_amdgcn_exp2f(-1.4426950408889634f * x)); }
__device__ __forceinline__ float hsum4(const f32x4 v) { return (v[0] + v[1]) + (v[2] + v[3]); }
__device__ __forceinline__ float hsq4(const f32x4 v) { return (v[0] * v[0] + v[1] * v[1]) + (v[2] * v[2] + v[3] * v[3]); }
__device__ __forceinline__ float quad_sum(float s) {
    auto a = __builtin_amdgcn_permlane16_swap(__float_as_uint(s), __float_as_uint(s), false, false); s = __uint_as_float(a[0]) + __uint_as_float(a[1]);
    auto b = __builtin_amdgcn_permlane32_swap(__float_as_uint(s), __float_as_uint(s), false, false); return __uint_as_float(b[0]) + __uint_as_float(b[1]); }
__device__ __forceinline__ u32x2 pack8_f8(const f32x4 a, const f32x4 b) {
    int lo = __builtin_amdgcn_cvt_pk_fp8_f32(a[0], a[1], 0, false); lo = __builtin_amdgcn_cvt_pk_fp8_f32(a[2], a[3], lo, true);
    int hi = __builtin_amdgcn_cvt_pk_fp8_f32(b[0], b[1], 0, false); hi = __builtin_amdgcn_cvt_pk_fp8_f32(b[2], b[3], hi, true);
    u32x2 w; w.x = (unsigned)lo; w.y = (unsigned)hi; return w; }
__device__ __forceinline__ u32x4 pack8(const f32x4 a, const f32x4 b) { u32x4 w; w.x = cvt_pk_bf16(a[0], a[1]); w.y = cvt_pk_bf16(a[2], a[3]); w.z = cvt_pk_bf16(b[0], b[1]); w.w = cvt_pk_bf16(b[2], b[3]); return w; }

struct EpiInProj {
    static constexpr bool PERM = true, AFTER_DRAIN = false; static constexpr int BMAP = 1;
    bf16_t* P; const PG8_LAS float* par; float* ksum;
    __device__ __forceinline__ void operator()(const f32x4 (&acc)[2][2][4][2], const Unit& u, int wr, int wc, int fr, int fq) const {
        asm volatile("" : "+v"(fr), "+v"(fq));
        const int seg = u.pn >> 1, h = (u.pn & 1) * 4 + wc, dl = 8 * fq;
        bf16_t* base = P + (size_t)(u.pm * BM + wr * 64 + fr) * INW + u.pn * BM + wc * 64 + dl;
        if (seg == 0) {
#pragma unroll
            for (int ai = 0; ai < 2; ++ai)
#pragma unroll
                for (int m = 0; m < 4; ++m)
#pragma unroll
                    for (int bj = 0; bj < 2; ++bj) { f32x4 a = acc[ai][bj][m][0], b = acc[ai][bj][m][1];
#pragma unroll
                        for (int e = 0; e < 4; ++e) { a[e] = gelu_tanh_f(a[e]); b[e] = gelu_tanh_f(b[e]); }
                        *(u32x4*)(base + (size_t)(ai * HALF + m * 16) * INW + 32 * bj) = pack8(a, b); }
        } else if (seg == 1) {
            const PG8_LAS float* lg = par + h * 64 + dl; const PG8_LAS float* lb = par + 512 + h * 64 + dl;
#pragma unroll
            for (int ai = 0; ai < 2; ++ai)
#pragma unroll
                for (int m = 0; m < 4; ++m) { f32x4 g[2][2]; float s = 0.f;
#pragma unroll
                    for (int bj = 0; bj < 2; ++bj)
#pragma unroll
                        for (int n = 0; n < 2; ++n) { const f32x4 a = acc[ai][bj][m][n];
#pragma unroll
                            for (int e = 0; e < 4; ++e) g[bj][n][e] = gelu_tanh_f(a[e]);
                            s += hsum4(g[bj][n]); }
                    const float mean = quad_sum(s) * (1.0f / 64.0f); float q = 0.f;
#pragma unroll
                    for (int bj = 0; bj < 2; ++bj)
#pragma unroll
                        for (int n = 0; n < 2; ++n) { g[bj][n] = g[bj][n] - mean; q += hsq4(g[bj][n]); }
                    const float rstd = __builtin_amdgcn_rsqf(quad_sum(q) * (1.0f / 64.0f) + EPS);
#pragma unroll
                    for (int bj = 0; bj < 2; ++bj) { const f32x4 G0 = *(const PG8_LAS f32x4*)(lg + 32 * bj), G1 = *(const PG8_LAS f32x4*)(lg + 32 * bj + 4), B0 = *(const PG8_LAS f32x4*)(lb + 32 * bj), B1 = *(const PG8_LAS f32x4*)(lb + 32 * bj + 4);
                        *(u32x4*)(base + (size_t)(ai * HALF + m * 16) * INW + 32 * bj) = pack8(g[bj][0] * rstd * G0 + B0, g[bj][1] * rstd * G1 + B1); }
                    asm volatile("" ::: "memory"); __builtin_amdgcn_sched_barrier(0); }
        } else if (seg == 2 || seg == 3) {
            const PG8_LAS float* gp = par + ((seg == 2) ? 1024 : 1088) + dl;
            f32x4 cs[2][2];
#pragma unroll
            for (int bj = 0; bj < 2; ++bj)
#pragma unroll
                for (int n = 0; n < 2; ++n) cs[bj][n] = (f32x4){0.f, 0.f, 0.f, 0.f};
#pragma unroll
            for (int ai = 0; ai < 2; ++ai)
#pragma unroll
                for (int m = 0; m < 4; ++m) { float q = 0.f;
#pragma unroll
                    for (int bj = 0; bj < 2; ++bj)
#pragma unroll
                        for (int n = 0; n < 2; ++n) q += hsq4(acc[ai][bj][m][n]);
                    const float rstd = __builtin_amdgcn_rsqf(quad_sum(q) * (1.0f / 64.0f) + EPS);
#pragma unroll
                    for (int bj = 0; bj < 2; ++bj) { const f32x4 o0 = acc[ai][bj][m][0] * rstd * *(const PG8_LAS f32x4*)(gp + 32 * bj), o1 = acc[ai][bj][m][1] * rstd * *(const PG8_LAS f32x4*)(gp + 32 * bj + 4);
                        cs[bj][0] += o0; cs[bj][1] += o1;
                        *(u32x4*)(base + (size_t)(ai * HALF + m * 16) * INW + 32 * bj) = pack8(o0, o1); }
                    asm volatile("" : "+v"(cs[0][0]), "+v"(cs[0][1]), "+v"(cs[1][0]), "+v"(cs[1][1]));
                    asm volatile("" ::: "memory"); __builtin_amdgcn_sched_barrier(0); }
            if (seg == 3) {
#pragma unroll
                for (int bj = 0; bj < 2; ++bj)
#pragma unroll
                    for (int n = 0; n < 2; ++n) { f32x4 v = cs[bj][n];
#pragma unroll
                        for (int e = 0; e < 4; ++e) { float t = v[e]; t += __shfl_xor(t, 1); t += __shfl_xor(t, 2); t += __shfl_xor(t, 4); t += __shfl_xor(t, 8); v[e] = t; }
                        if (fr == 0) *(f32x4*)(ksum + (((size_t)u.pm * 2 + wr) * NH + h) * 64 + 32 * bj + dl + 4 * n) = v; }
            }
        } else {
#pragma unroll
            for (int ai = 0; ai < 2; ++ai)
#pragma unroll
                for (int m = 0; m < 4; ++m)
#pragma unroll
                    for (int bj = 0; bj < 2; ++bj) *(u32x4*)(base + (size_t)(ai * HALF + m * 16) * INW + 32 * bj) = pack8(acc[ai][bj][m][0], acc[ai][bj][m][1]);
        }
    }
};

struct EpiOutProj {
    static constexpr bool PERM = true, AFTER_DRAIN = true; static constexpr int BMAP = 0;
    const float* x; bf16_t* x1b; unsigned char* x1q; float* rowss;
    __device__ __forceinline__ void operator()(const f32x4 (&)[2][2][4][2], const Unit&, int, int, int, int) const {}
    __device__ __forceinline__ void fused(f32x4 (&acc)[2][2][4][2], const Unit& u, int wr, int wc, int fr, int fq, PG8_LAS unsigned char* lds, int wid, int lane) const {
        PG8_LAS float* Pl = (PG8_LAS float*)lds;
        const int col0 = u.pn * BM + wc * 32 + 8 * fq;
#pragma unroll
        for (int ai = 0; ai < 2; ++ai)
#pragma unroll
            for (int m = 0; m < 4; ++m) { const int rt = ai * HALF + wr * 64 + m * 16 + fr; const size_t off = (size_t)(u.pm * BM + rt) * DM + col0; float s = 0.f;
#pragma unroll
                for (int bj = 0; bj < 2; ++bj) { const f32x4 v0 = acc[ai][bj][m][0] + *(const f32x4*)(x + off + bj * HALF), v1 = acc[ai][bj][m][1] + *(const f32x4*)(x + off + bj * HALF + 4);
                    *(u32x4*)(x1b + off + bj * HALF) = pack8(v0, v1); *(u32x2*)(x1q + off + bj * HALF) = pack8_f8(v0, v1); s += hsq4(v0) + hsq4(v1); }
                s = quad_sum(s); if (fq == 0) Pl[rt * 4 + wc] = s;
                if (m & 1) asm volatile("" ::: "memory"); }
        asm volatile("s_waitcnt lgkmcnt(0)" ::: "memory"); __builtin_amdgcn_s_barrier(); asm volatile("" ::: "memory");
        const int t = wid * 64 + lane;
        if (t < 256) rowss[(size_t)(u.pm * BM + t) * 4 + u.pn] = (Pl[t * 4 + 0] + Pl[t * 4 + 1]) + (Pl[t * 4 + 2] + Pl[t * 4 + 3]);
    }
};

struct EpiGateUp {
    static constexpr bool PERM = true, AFTER_DRAIN = false; static constexpr int BMAP = 0;
    unsigned char* H; const float* rowss;
    __device__ __forceinline__ void operator()(const f32x4 (&acc)[2][2][4][2], const Unit& u, int wr, int wc, int fr, int fq) const {
        const int row0 = u.pm * BM + wr * 64 + fr, col0 = u.pn * HALF + wc * 32 + 8 * fq;
        f32x4 r4[2][4];
#pragma unroll
        for (int ai = 0; ai < 2; ++ai)
#pragma unroll
            for (int m = 0; m < 4; ++m) r4[ai][m] = *(const f32x4*)(rowss + (size_t)(row0 + ai * HALF + m * 16) * 4);
        float rs2[2][4], k1[2][4];
#pragma unroll
        for (int ai = 0; ai < 2; ++ai)
#pragma unroll
            for (int m = 0; m < 4; ++m) { const float rs = __builtin_amdgcn_rsqf(hsum4(r4[ai][m]) * (1.0f / DM) + EPS) * (1.0f / WGU_SCALE); rs2[ai][m] = rs * rs; k1[ai][m] = -1.4426950408889634f * rs; }
#pragma unroll
        for (int ai = 0; ai < 2; ++ai)
#pragma unroll
            for (int m = 0; m < 4; ++m) { const int row = row0 + ai * HALF + m * 16;
                f32x4 a = acc[ai][0][m][0], b = acc[ai][0][m][1]; const f32x4 ua = acc[ai][1][m][0], ub = acc[ai][1][m][1];
#pragma unroll
                for (int e = 0; e < 4; ++e) {
                    a[e] = (a[e] * ua[e]) * rs2[ai][m] * __builtin_amdgcn_rcpf(1.0f + __builtin_amdgcn_exp2f(a[e] * k1[ai][m]));
                    b[e] = (b[e] * ub[e]) * rs2[ai][m] * __builtin_amdgcn_rcpf(1.0f + __builtin_amdgcn_exp2f(b[e] * k1[ai][m])); }
                *(u32x2*)(H + (size_t)row * DFF + col0) = pack8_f8(a, b); }
    }
};

struct EpiDown {
    static constexpr bool PERM = true, AFTER_DRAIN = false; static constexpr int BMAP = 0;
    const bf16_t* x1b; float* out;
    __device__ __forceinline__ void operator()(const f32x4 (&acc)[2][2][4][2], const Unit& u, int wr, int wc, int fr, int fq) const {
        const int row0 = u.pm * BM + wr * 64 + fr, col0 = u.pn * BM + wc * 32 + 8 * fq;
#pragma unroll
        for (int ai = 0; ai < 2; ++ai) {
            u32x4 xv[4][2];
#pragma unroll
            for (int m = 0; m < 4; ++m)
#pragma unroll
                for (int bj = 0; bj < 2; ++bj) xv[m][bj] = *(const u32x4*)(x1b + (size_t)(row0 + ai * HALF + m * 16) * DM + col0 + bj * HALF);
#pragma unroll
            for (int m = 0; m < 4; ++m) { float* rowp = out + (size_t)(row0 + ai * HALF + m * 16) * DM + col0;
#pragma unroll
                for (int bj = 0; bj < 2; ++bj) { const u32x4 w = xv[m][bj];
                    const f32x4 x0 = {__builtin_bit_cast(float, w.x << 16), __builtin_bit_cast(float, w.x & 0xffff0000u), __builtin_bit_cast(float, w.y << 16), __builtin_bit_cast(float, w.y & 0xffff0000u)};
                    const f32x4 x1 = {__builtin_bit_cast(float, w.z << 16), __builtin_bit_cast(float, w.z & 0xffff0000u), __builtin_bit_cast(float, w.w << 16), __builtin_bit_cast(float, w.w & 0xffff0000u)};
                    *(f32x4*)(rowp + bj * HALF) = x0 + acc[ai][bj][m][0] * (1.0f / WD_SCALE); *(f32x4*)(rowp + bj * HALF + 4) = x1 + acc[ai][bj][m][1] * (1.0f / WD_SCALE); } }
            asm volatile("" ::: "memory"); }
    }
};

struct EpiNull {
    static constexpr bool PERM = true, AFTER_DRAIN = false; static constexpr int BMAP = 0;
    float* sink;
    __device__ __forceinline__ void operator()(const f32x4 (&acc)[2][2][4][2], const Unit& u, int wr, int wc, int fr, int fq) const {
        float s = 0.f;
#pragma unroll
        for (int ai = 0; ai < 2; ++ai)
#pragma unroll
            for (int bj = 0; bj < 2; ++bj)
#pragma unroll
                for (int m = 0; m < 4; ++m)
#pragma unroll
                    for (int n = 0; n < 2; ++n) s += acc[ai][bj][m][n][0];
        if (s == 123.456f) sink[0] = s;
    }
};

template <class Epi, class Sched, bool ALIGN_EPI = false, bool SP2 = false, bool F8 = false>
__device__ __forceinline__ void gemm_phase(PG8_LAS unsigned char* lds, const Gemm g, const Sched& S, const Epi& E) {
    int tid_ = threadIdx.x; asm volatile("" : "+v"(tid_));
    const int tid = tid_, wid = __builtin_amdgcn_readfirstlane(tid >> 6), lane = tid & 63, wr = wid >> 2, wc = wid & 3, fr = lane & 15, fq = lane >> 4;
    const int K = g.K, nt = K / BK;
    unsigned voffA[2], voffB[2];
#pragma unroll
    for (int i = 0; i < 2; ++i) { int R, C; stage_rc(tid * 16 + i * 8192, R, C); int Rb = Epi::PERM ? ((R & ~31) + perm32(R & 31)) : R;
        if (Epi::BMAP == 1) Rb = 64 * (R >> 5) + (Rb & 31);
        voffA[i] = (unsigned)(R * K + C) * 2u; voffB[i] = (unsigned)(Rb * K + C) * 2u; }
    const size_t kstep = (size_t)(BK * 2);
    const size_t hstep = (size_t)HALF * K * 2;
    const size_t hstepB = (size_t)(Epi::BMAP == 1 ? 32 : HALF) * K * 2;
    const size_t tstep = 2 * hstep;
    const unsigned ldsw = (unsigned)wid * 1024u;
    const int aoff = lds_byte(wr * 64 + fr, fq * 8), boff = lds_byte(wc * 32 + fr, fq * 8);
#define PG8_SA(b, h) (((b) * 2 + (h)) * HTB)
#define PG8_SB(b, h) ((4 + (b) * 2 + (h)) * HTB)
#define PG8_STAGE(bufoff, gbase, voff) do { _Pragma("unroll") for (int _i = 0; _i < 2; ++_i) \
        __builtin_amdgcn_global_load_lds((const unsigned*)((const char*)(gbase) + (voff)[_i]), (PG8_LAS unsigned*)(lds + (bufoff) + ldsw + _i * 8192), 16, 0, 0); } while (0)
#define PG8_LDA(dst, b, h) do { _Pragma("unroll") for (int m = 0; m < 4; ++m) _Pragma("unroll") for (int k = 0; k < 2; ++k) dst[m][k] = *(const PG8_LAS bf16x8*)(lds + PG8_SA(b, h) + aoff + m * 2048 + k * 1024); } while (0)
#define PG8_LDB(dst, b, h) do { _Pragma("unroll") for (int n = 0; n < 2; ++n) _Pragma("unroll") for (int k = 0; k < 2; ++k) dst[n][k] = *(const PG8_LAS bf16x8*)(lds + PG8_SB(b, h) + boff + n * 2048 + k * 1024); } while (0)
#define PG8_CAT(x) __builtin_shufflevector(__builtin_bit_cast(v4i_t, x[0]), __builtin_bit_cast(v4i_t, x[1]), 0, 1, 2, 3, 4, 5, 6, 7)
#define PG8_MMA(ai, bj, At, Bt) do { __builtin_amdgcn_s_setprio(1); _Pragma("unroll") for (int m = 0; m < 4; ++m) _Pragma("unroll") for (int n = 0; n < 2; ++n) { \
        if constexpr (F8) asm volatile("v_mfma_f32_16x16x128_f8f6f4 %0, %1, %2, %0" : "+v"(acc[ai][bj][m][n]) : "v"(PG8_CAT(Bt[n])), "v"(PG8_CAT(At[m])));       \
        else { _Pragma("unroll") for (int k = 0; k < 2; ++k) acc[ai][bj][m][n] = __builtin_amdgcn_mfma_f32_16x16x32_bf16(Bt[n][k], At[m][k], acc[ai][bj][m][n], 0, 0, 0); } } __builtin_amdgcn_s_setprio(0); } while (0)
#define PG8_WAIT_V(n) asm volatile("s_waitcnt vmcnt(" #n ")" ::: "memory")
#define PG8_WAIT_L(n) asm volatile("s_waitcnt lgkmcnt(" #n ")" ::: "memory")
#define PG8_BAR __builtin_amdgcn_s_barrier()
#define PG8_SCHED __builtin_amdgcn_sched_barrier(0)
#define PG8_PIN_ACC(txt) do { _Pragma("unroll") for (int a_ = 0; a_ < 2; ++a_) _Pragma("unroll") for (int b_ = 0; b_ < 2; ++b_) \
        asm volatile(txt : "+v"(acc[a_][b_][0][0]), "+v"(acc[a_][b_][0][1]), "+v"(acc[a_][b_][1][0]), "+v"(acc[a_][b_][1][1]), "+v"(acc[a_][b_][2][0]), "+v"(acc[a_][b_][2][1]), "+v"(acc[a_][b_][3][0]), "+v"(acc[a_][b_][3][1])); } while (0)
    Unit cur, nxt; int ui = 0;
    if (!S.next(0, cur)) return;
    f32x4 acc[2][2][4][2];
#pragma unroll
    for (int a = 0; a < 2; ++a)
#pragma unroll
        for (int b = 0; b < 2; ++b)
#pragma unroll
            for (int m = 0; m < 4; ++m)
#pragma unroll
                for (int n = 0; n < 2; ++n) acc[a][b][m][n] = (f32x4){0.f, 0.f, 0.f, 0.f};
    if constexpr (F8) PG8_PIN_ACC("");
    bf16x8 At[4][2], B0[2][2], B1[2][2];
    const char* cA = (const char*)g.A + (size_t)cur.pm * tstep; const char* cB = (const char*)g.Bt + (size_t)cur.pn * tstep;
    S.a_ready(cur);
    if constexpr (SP2) {
        PG8_STAGE(PG8_SB(0, 0), cB, voffB); PG8_STAGE(PG8_SB(0, 1), cB + hstepB, voffB); PG8_STAGE(PG8_SA(0, 0), cA, voffA); PG8_STAGE(PG8_SA(0, 1), cA + hstep, voffA);
        if (wr == 1) PG8_BAR;
        PG8_WAIT_V(2); PG8_BAR;
        PG8_STAGE(PG8_SB(1, 0), cB + kstep, voffB); PG8_STAGE(PG8_SA(1, 0), cA + kstep, voffA); PG8_STAGE(PG8_SB(1, 1), cB + hstepB + kstep, voffB);
        PG8_WAIT_V(6); PG8_BAR;
    } else {
        PG8_STAGE(PG8_SB(0, 0), cB, voffB); PG8_STAGE(PG8_SA(0, 0), cA, voffA); PG8_STAGE(PG8_SB(0, 1), cB + hstepB, voffB); PG8_STAGE(PG8_SA(0, 1), cA + hstep, voffA);
        if (wr == 1) PG8_BAR;
        PG8_WAIT_V(4); PG8_BAR;
        PG8_STAGE(PG8_SB(1, 0), cB + kstep, voffB); PG8_STAGE(PG8_SA(1, 0), cA + kstep, voffA); PG8_STAGE(PG8_SB(1, 1), cB + hstepB + kstep, voffB);
        PG8_WAIT_V(6); PG8_BAR;
    }
    for (;;) {
        const bool has_next = S.next(ui + 1, nxt);
        const char* nA = has_next ? (const char*)g.A + (size_t)nxt.pm * tstep : cA; const char* nB = has_next ? (const char*)g.Bt + (size_t)nxt.pn * tstep : cB;
        for (int t = 0; t < nt; t += 2) {
            const bool last = (t == nt - 2);
            const char* a1 = cA + (size_t)(t + 1) * kstep;
            const char* a2 = last ? nA : cA + (size_t)(t + 2) * kstep; const char* b2 = last ? nB : cB + (size_t)(t + 2) * kstep;
            const char* a3 = a2 + kstep; const char* b3 = b2 + kstep;
            if (last && has_next) S.a_ready(nxt);
            if constexpr (SP2) {
            PG8_LDB(B0, 0, 0); PG8_LDB(B1, 0, 1); PG8_SCHED; PG8_LDA(At, 0, 0); PG8_STAGE(PG8_SA(1, 1), a1 + hstep, voffA);
            PG8_WAIT_V(8); PG8_WAIT_L(0); PG8_BAR; PG8_MMA(0, 0, At, B0); PG8_MMA(0, 1, At, B1); PG8_BAR; PG8_SCHED;
            PG8_LDA(At, 0, 1); PG8_STAGE(PG8_SB(0, 0), b2, voffB); PG8_STAGE(PG8_SB(0, 1), b2 + hstepB, voffB); PG8_STAGE(PG8_SA(0, 0), a2, voffA);
            PG8_WAIT_V(8); PG8_WAIT_L(0); PG8_BAR; PG8_MMA(1, 0, At, B0); PG8_MMA(1, 1, At, B1); PG8_BAR; PG8_SCHED;
            PG8_LDB(B0, 1, 0); PG8_LDB(B1, 1, 1); PG8_SCHED; PG8_LDA(At, 1, 0); PG8_STAGE(PG8_SA(0, 1), a2 + hstep, voffA);
            PG8_WAIT_V(8); PG8_WAIT_L(0); PG8_BAR; PG8_MMA(0, 0, At, B0); PG8_MMA(0, 1, At, B1); PG8_BAR; PG8_SCHED;
            PG8_LDA(At, 1, 1); PG8_STAGE(PG8_SB(1, 0), b3, voffB); PG8_STAGE(PG8_SB(1, 1), b3 + hstepB, voffB); PG8_STAGE(PG8_SA(1, 0), a3, voffA);
            PG8_WAIT_V(8); PG8_WAIT_L(0); PG8_BAR; PG8_MMA(1, 0, At, B0); PG8_MMA(1, 1, At, B1); PG8_BAR; PG8_SCHED;
            } else {
            PG8_LDB(B0, 0, 0); PG8_SCHED; PG8_LDA(At, 0, 0); PG8_STAGE(PG8_SA(1, 1), a1 + hstep, voffA);
            PG8_WAIT_L(8); PG8_BAR; PG8_WAIT_L(0); PG8_MMA(0, 0, At, B0); PG8_BAR; PG8_SCHED;
            PG8_LDB(B1, 0, 1); PG8_STAGE(PG8_SB(0, 0), b2, voffB);
            PG8_BAR; PG8_WAIT_L(0); PG8_MMA(0, 1, At, B1); PG8_BAR;
            PG8_LDA(At, 0, 1); PG8_STAGE(PG8_SA(0, 0), a2, voffA);
            PG8_BAR; PG8_WAIT_L(0); PG8_MMA(1, 0, At, B0); PG8_BAR; PG8_SCHED;
            PG8_STAGE(PG8_SB(0, 1), b2 + hstepB, voffB);
            PG8_WAIT_V(6); PG8_BAR; PG8_MMA(1, 1, At, B1); PG8_BAR;
            PG8_LDB(B0, 1, 0); PG8_SCHED; PG8_LDA(At, 1, 0); PG8_STAGE(PG8_SA(0, 1), a2 + hstep, voffA);
            PG8_WAIT_L(8); PG8_BAR; PG8_WAIT_L(0); PG8_MMA(0, 0, At, B0); PG8_BAR; PG8_SCHED;
            PG8_LDB(B1, 1, 1); PG8_STAGE(PG8_SB(1, 0), b3, voffB);
            PG8_BAR; PG8_WAIT_L(0); PG8_MMA(0, 1, At, B1); PG8_BAR;
            PG8_LDA(At, 1, 1); PG8_STAGE(PG8_SA(1, 0), a3, voffA);
            PG8_BAR; PG8_WAIT_L(0); PG8_MMA(1, 0, At, B0); PG8_BAR; PG8_SCHED;
            PG8_STAGE(PG8_SB(1, 1), b3 + hstepB, voffB);
            PG8_WAIT_V(6); PG8_BAR; PG8_MMA(1, 1, At, B1); PG8_BAR;
            }
        }
        if constexpr (F8) PG8_PIN_ACC("s_nop 15");
        if constexpr (ALIGN_EPI) { if (wr == 0) PG8_BAR; }
        if constexpr (!Epi::AFTER_DRAIN) { E(acc, cur, wr, wc, fr, fq); S.done(cur); }
        if (!has_next) break;
#pragma unroll
        for (int a = 0; a < 2; ++a)
#pragma unroll
            for (int b = 0; b < 2; ++b)
#pragma unroll
                for (int m = 0; m < 4; ++m)
#pragma unroll
                    for (int n = 0; n < 2; ++n) acc[a][b][m][n] = (f32x4){0.f, 0.f, 0.f, 0.f};
        if constexpr (F8) PG8_PIN_ACC("");
        cur = nxt; cA = nA; cB = nB; ++ui;
        if constexpr (ALIGN_EPI) { if (wr == 1) PG8_BAR; }
    }
    PG8_WAIT_V(0);
    if constexpr (!ALIGN_EPI) { if (wr == 0) PG8_BAR; }
    PG8_BAR;
    if constexpr (Epi::AFTER_DRAIN) { E.fused(acc, cur, wr, wc, fr, fq, lds, wid, lane); S.done(cur); }
#undef PG8_SA
#undef PG8_SB
#undef PG8_STAGE
#undef PG8_LDA
#undef PG8_LDB
#undef PG8_MMA
#undef PG8_CAT
#undef PG8_PIN_ACC
#undef PG8_WAIT_V
#undef PG8_WAIT_L
#undef PG8_BAR
#undef PG8_SCHED
}
}

#ifndef PG8_SP2
#define PG8_SP2 true
#endif
#ifndef PG8_ALIGN
#define PG8_ALIGN true
#endif

namespace attn_body {
using bf16=__hip_bfloat16;
using bf16x8=__attribute__((ext_vector_type(8)))short;
using s16x4=__attribute__((ext_vector_type(4)))short;
using f32x16=__attribute__((ext_vector_type(16)))float;
using u32x4=__attribute__((ext_vector_type(4)))unsigned;
constexpr int BATCH=8,NHEAD=8,SEQ=2048,D=64,DM=2560,YP=1024;
constexpr int NW=8,QBLK=32,QB=QBLK*NW,KVBLK=64,NQB=SEQ/QB;
constexpr int ATTN_PITCH=DM, ATTN_UNIT_ROWS=QB;
__device__ __forceinline__ int crow(int r,int hi){return (r&3)+8*(r>>2)+4*hi;}
#define SBAR() __builtin_amdgcn_sched_barrier(0)
__device__ __forceinline__ void cmask(f32x16&p0,f32x16&p1,int jb,int qrel,int hi){
  const float NEG=-INFINITY; int kb=64*jb+4*hi;
  #pragma unroll
  for(int r=0;r<16;++r){int kv=kb+(r&3)+8*(r>>2); if(kv>qrel)p0[r]=NEG; if(kv+32>qrel)p1[r]=NEG;}
}

constexpr int NSLOT=3, SLOTB=8192;
constexpr int LDS_K=0, LDS_V=NSLOT*SLOTB, LDS_WS=2*NSLOT*SLOTB, LDS_OST=LDS_WS+NW*64*4, LDS_BYTES=LDS_OST+NW*8192;
constexpr float C2=0.125f*1.4426950408889634f;
__device__ __forceinline__ void glds16(const void*gsrc,unsigned lds_dst){unsigned keep;
  asm volatile("s_mov_b32 %0, m0\n\ts_mov_b32 m0, %2\n\ts_nop 0\n\tglobal_load_lds_dwordx4 %1, off\n\ts_mov_b32 m0, %0":"=&s"(keep):"v"(gsrc),"s"(lds_dst):"memory");}
__device__ __forceinline__ float max3f(float a,float b,float c){float r;asm("v_max3_f32 %0, %1, %2, %3":"=v"(r):"v"(a),"v"(b),"v"(c));return r;}
__device__ __forceinline__ float max2f(float a,float b){float r;asm("v_max_f32_e32 %0, %1, %2":"=v"(r):"v"(a),"v"(b));return r;}
__device__ __forceinline__ float fadd_s(float a,float b){float r;asm("v_add_f32_e32 %0, %1, %2":"=v"(r):"v"(a),"v"(b));return r;}
__device__ __forceinline__ float fsub_s(float a,float b){float r;asm("v_sub_f32_e32 %0, %1, %2":"=v"(r):"v"(a),"v"(b));return r;}
typedef float f32x2_t __attribute__((ext_vector_type(2))); typedef __bf16 bf16x2_t __attribute__((ext_vector_type(2))); typedef float f32x4_t __attribute__((ext_vector_type(4))); typedef unsigned u32x2_t __attribute__((ext_vector_type(2)));
__device__ __forceinline__ unsigned cvtpk_s(float lo,float hi){f32x2_t v={lo,hi};bf16x2_t b=__builtin_convertvector(v,bf16x2_t);return __builtin_bit_cast(unsigned,b);}
#define WAIT_BAR(N) asm volatile("s_waitcnt vmcnt(" #N ") lgkmcnt(0)\n\ts_barrier":::"memory")

__device__ __forceinline__ void qkt(f32x16&p0,f32x16&p1,const char*Kslot,const bf16x8*qr,const f32x16&negm,int r32,int hi){
  const char*kb=Kslot+hi*1024+r32*16;
  #pragma unroll
  for(int d0=0;d0<4;++d0){
    const bf16x8 b0=*reinterpret_cast<const bf16x8*>(kb+d0*2048);
    const bf16x8 b1=*reinterpret_cast<const bf16x8*>(kb+d0*2048+512);
    if(d0==0){p0=__builtin_amdgcn_mfma_f32_32x32x16_bf16(b0,qr[0],negm,0,0,0);p1=__builtin_amdgcn_mfma_f32_32x32x16_bf16(b1,qr[0],negm,0,0,0);}
    else{p0=__builtin_amdgcn_mfma_f32_32x32x16_bf16(b0,qr[d0],p0,0,0,0);p1=__builtin_amdgcn_mfma_f32_32x32x16_bf16(b1,qr[d0],p1,0,0,0);}}
}
typedef __attribute__((address_space(3))) const char* lds_cptr;
typedef short v4i16_t __attribute__((ext_vector_type(4)));
__device__ __forceinline__ void kload8(bf16x8*kf,lds_cptr kp){
  kf[0]=*(const __attribute__((address_space(3))) bf16x8*)(kp);      kf[1]=*(const __attribute__((address_space(3))) bf16x8*)(kp+512);
  kf[2]=*(const __attribute__((address_space(3))) bf16x8*)(kp+2048); kf[3]=*(const __attribute__((address_space(3))) bf16x8*)(kp+2560);
  kf[4]=*(const __attribute__((address_space(3))) bf16x8*)(kp+4096); kf[5]=*(const __attribute__((address_space(3))) bf16x8*)(kp+4608);
  kf[6]=*(const __attribute__((address_space(3))) bf16x8*)(kp+6144); kf[7]=*(const __attribute__((address_space(3))) bf16x8*)(kp+6656);
}
__device__ __forceinline__ void kload2(bf16x8*kf,lds_cptr kp,int j){ kf[2*j]=*(const __attribute__((address_space(3))) bf16x8*)(kp+j*2048); kf[2*j+1]=*(const __attribute__((address_space(3))) bf16x8*)(kp+j*2048+512); }
__device__ __forceinline__ s16x4 vtr(lds_cptr p){ return __builtin_bit_cast(s16x4,__builtin_amdgcn_ds_read_tr16_b64_v4i16((__attribute__((address_space(3))) v4i16_t*)p)); }
__device__ __forceinline__ float rowmax(const f32x16&p0,const f32x16&p1){
  float a=max3f(p0[0],p0[1],p1[0]),b=max3f(p0[2],p0[3],p1[1]);a=max3f(a,p1[2],p1[3]);
  #pragma unroll
  for(int r=4;r<16;r+=4){a=max3f(a,p0[r],p0[r+1]);b=max3f(b,p0[r+2],p0[r+3]);a=max3f(a,p1[r],p1[r+1]);b=max3f(b,p1[r+2],p1[r+3]);}
  const float m=max2f(a,b);
  auto rr=__builtin_amdgcn_permlane32_swap(__float_as_uint(m),__float_as_uint(m),false,false);
  return max2f(__uint_as_float(rr[0]),__uint_as_float(rr[1]));
}
__device__ __forceinline__ void pv(f32x16*o,int vb,bf16x8 pa0,bf16x8 pa1,bf16x8 pa2,bf16x8 pa3){
  #pragma unroll
  for(int d0=0;d0<2;++d0){s16x4 lo[4],hi[4];
    #pragma unroll
    for(int ks=0;ks<4;++ks){
      asm volatile("ds_read_b64_tr_b16 %0,%1 offset:%c2":"=&v"(lo[ks]):"v"(vb),"i"(d0*4096+ks*1024):"memory");
      asm volatile("ds_read_b64_tr_b16 %0,%1 offset:%c2":"=&v"(hi[ks]):"v"(vb),"i"(d0*4096+ks*1024+512):"memory");}
    asm volatile("s_waitcnt lgkmcnt(0)":::"memory");SBAR();
    #define PK(k) (bf16x8){lo[k][0],lo[k][1],lo[k][2],lo[k][3],hi[k][0],hi[k][1],hi[k][2],hi[k][3]}
    o[d0]=__builtin_amdgcn_mfma_f32_32x32x16_bf16(pa0,PK(0),o[d0],0,0,0);
    o[d0]=__builtin_amdgcn_mfma_f32_32x32x16_bf16(pa1,PK(1),o[d0],0,0,0);
    o[d0]=__builtin_amdgcn_mfma_f32_32x32x16_bf16(pa2,PK(2),o[d0],0,0,0);
    o[d0]=__builtin_amdgcn_mfma_f32_32x32x16_bf16(pa3,PK(3),o[d0],0,0,0);
    #undef PK
  }
}

#ifndef ATTN_STORE16
#define ATTN_STORE16(p,v) (*(u32x4*)(p)=(v))
#endif
template<int THRL> __device__ __forceinline__ void attn_unit(int b,int h,int qb,const bf16*Q,const bf16*__restrict__ K,const bf16*__restrict__ V,bf16*Y,const float*__restrict__ ksum,const float*__restrict__ onb_g,char*shm){
  int tid_=threadIdx.x; asm volatile("":"+v"(tid_)); const int tid=tid_,lane=tid&63,r32=lane&31,hi=lane>>5; const int wid=__builtin_amdgcn_readfirstlane(tid>>6);
  const long rowbase=(long)b*SEQ; const int q0=qb*QB;
  const bf16*Qw=Q+(rowbase+q0+wid*QBLK)*DM+h*D;
  const bf16*Kh=K+rowbase*DM+h*D,*Vh=V+rowbase*DM+h*D;
  const unsigned lds0=(unsigned)(uintptr_t)shm;
  float*wsf=(float*)(shm+LDS_WS)+wid*64;
  const bf16*ksrc=Kh+(long)lane*DM+wid*8;
  const bf16*vsrc=Vh+(long)(16*(wid&3)+(lane>>2))*DM+(wid>>2)*32+(lane&3)*8;
  const unsigned kdst=lds0+LDS_K+wid*1024, vdst=lds0+LDS_V+wid*1024;
  #define DMA_K(t,slot) glds16(ksrc+(long)(t)*KVBLK*DM,(unsigned)__builtin_amdgcn_readfirstlane(kdst+(slot)))
  #define DMA_V(t,slot) glds16(vsrc+(long)(t)*KVBLK*DM,(unsigned)__builtin_amdgcn_readfirstlane(vdst+(slot)))
  const int vb0=(int)(lds0+LDS_V)+((lane>>4)&1)*32+(lane&3)*8+(4*hi+((lane&15)>>2))*64;
  const char*Kbase=shm+LDS_K; bf16x8 kf[8];
  const lds_cptr shm3=(lds_cptr)shm; const lds_cptr kp0=shm3+LDS_K+hi*1024+r32*16; const lds_cptr vp0=shm3+LDS_V+((lane>>4)&1)*32+(lane&3)*8+(4*hi+((lane&15)>>2))*64;
  const int NT=(q0+QB)/KVBLK;
  DMA_K(0,0);DMA_V(0,0);DMA_K(1,SLOTB);
  bf16x8 qr[4];
  #pragma unroll
  for(int d0=0;d0<4;++d0)qr[d0]=*reinterpret_cast<const bf16x8*>(&Qw[(long)r32*DM+d0*16+hi*8]);
  unsigned selbits;
  { f32x16 g=f32x16{};
    const float*kr=ksum+((((long)(b*(SEQ/QB)+r32)*2)*NHEAD+h)*D)+hi*8;
    #pragma unroll
    for(int d0=0;d0<4;++d0){ f32x4_t a0={0.f,0.f,0.f,0.f},a1={0.f,0.f,0.f,0.f}; if(r32<qb){a0=*reinterpret_cast<const f32x4_t*>(kr+d0*16)+*reinterpret_cast<const f32x4_t*>(kr+NHEAD*D+d0*16);a1=*reinterpret_cast<const f32x4_t*>(kr+d0*16+4)+*reinterpret_cast<const f32x4_t*>(kr+NHEAD*D+d0*16+4);}
      float hv[8],lv[8];
      #pragma unroll
      for(int e=0;e<4;++e){hv[e]=__builtin_bit_cast(float,__builtin_bit_cast(unsigned,a0[e])&0xffff0000u);lv[e]=a0[e]-hv[e];hv[4+e]=__builtin_bit_cast(float,__builtin_bit_cast(unsigned,a1[e])&0xffff0000u);lv[4+e]=a1[e]-hv[4+e];}
      u32x4 wh={cvtpk_s(hv[0],hv[1]),cvtpk_s(hv[2],hv[3]),cvtpk_s(hv[4],hv[5]),cvtpk_s(hv[6],hv[7])},wl={cvtpk_s(lv[0],lv[1]),cvtpk_s(lv[2],lv[3]),cvtpk_s(lv[4],lv[5]),cvtpk_s(lv[6],lv[7])};
      g=__builtin_amdgcn_mfma_f32_32x32x16_bf16(__builtin_bit_cast(bf16x8,wh),qr[d0],g,0,0,0);
      g=__builtin_amdgcn_mfma_f32_32x32x16_bf16(__builtin_bit_cast(bf16x8,wl),qr[d0],g,0,0,0);}
    float gt[8];
    #pragma unroll
    for(int r=0;r<4;++r){auto rr=__builtin_amdgcn_permlane32_swap(__float_as_uint(g[r]),__float_as_uint(g[r]),false,false);gt[r]=__uint_as_float(rr[0]);gt[4+r]=__uint_as_float(rr[1]);}
    selbits=1u<<qb;
    #pragma unroll
    for(int n=0;n<7;++n){int rank=0;
      #pragma unroll
      for(int m=0;m<7;++m)if(m!=n)rank+=(m<qb&&(gt[m]>gt[n]||(gt[m]==gt[n]&&m<n)))?1:0;
      if(n<qb&&rank<3)selbits|=1u<<n;}
  }
  #define MSKF(n) ((((selbits>>(n))&1u)!=0u)?0.f:-INFINITY)
  float mhat=0.f,l_reg=0.f;f32x16 o[2];o[0]=f32x16{};o[1]=f32x16{};f32x16 negm;{const float nm0=MSKF(0);
  #pragma unroll
  for(int r=0;r<16;++r)negm[r]=nm0;}asm volatile("":"+v"(negm));
  #define NEWBLK(tt) do{ if((((tt)&3)==0)){ const float nm_=MSKF((tt)>>2)-mhat; _Pragma("unroll") for(int r=0;r<16;++r)negm[r]=nm_; asm volatile("":"+v"(negm)); } }while(0)
  const int qrel=wid*QBLK+r32;
  #define CMASK(P0,P1,t) do{int jb_=(t)-(NT-4); if(jb_>=0)cmask(P0,P1,jb_,qrel,hi);}while(0)
  bool resc=false;
  #define START(P0,P1) do{ const float rm=rowmax(P0,P1); resc=false; \
    { const float dl=(rm==-INFINITY)?0.f:rm; mhat=fadd_s(mhat,dl); \
      _Pragma("unroll") for(int r=0;r<16;++r){P0[r]=fsub_s(P0[r],dl);P1[r]=fsub_s(P1[r],dl);} \
      const float nm_=MSKF(0)-mhat; _Pragma("unroll") for(int r=0;r<16;++r)negm[r]=nm_; asm volatile("":"+v"(negm)); } \
    _Pragma("unroll") for(int r=0;r<16;++r)P0[r]=__builtin_amdgcn_exp2f(P0[r]); }while(0)
  #define RESC() do{ if(resc){ asm volatile("s_waitcnt lgkmcnt(0)":::"memory"); \
      _Pragma("unroll") for(int d_=0;d_<2;++d_) _Pragma("unroll") for(int r=0;r<16;++r)o[d_][r]*=wsf[crow(r,hi)]; } }while(0)
  f32x16 pA0,pA1,pB0,pB1;
  int sl_prev=0,sl_cur=0,sl_next=SLOTB;
  #define ROT() do{sl_prev=sl_cur;sl_cur=sl_next;sl_next=(sl_next==(NSLOT-1)*SLOTB)?0:sl_next+SLOTB;}while(0)
  DMA_K(2,2*SLOTB);
  WAIT_BAR(3);
  qkt(pA0,pA1,Kbase,qr,negm,r32,hi);asm volatile("s_nop 15\n\ts_nop 7":"+v"(pA0),"+v"(pA1));CMASK(pA0,pA1,0);
  START(pA0,pA1);
  _Pragma("unroll") for(int r=0;r<16;++r)pA1[r]=__builtin_amdgcn_exp2f(pA1[r]);
  WAIT_BAR(0);
  DMA_K(3,0);DMA_V(1,SLOTB);
  ROT();
  kload8(kf,kp0+sl_cur);
  WAIT_BAR(2);
  s16x4 vlo[8],vhi[8]; u32x4 pw0,pw1,pw2,pw3;
  #define PKW(P,B) cvtpk_s(P[B],P[B+1])
  #define PAF(k) __builtin_bit_cast(bf16x8,pw##k)
  #define VFR(i) (bf16x8){vlo[i][0],vlo[i][1],vlo[i][2],vlo[i][3],vhi[i][0],vhi[i][1],vhi[i][2],vhi[i][3]}
  #define PIN(x) asm volatile("":"+v"(x))
  #define MX3(a,b,c) __builtin_fmaxf(__builtin_fmaxf((a),(b)),(c))
  #define GAPA(MF,A0,A1,A2,A3,W0,W1,PW) do{ MF; sacc+=A0; sacc+=A1; sacc+=A2; sacc+=A3; PIN(sacc); W0; W1; PIN(PW); SBAR(); }while(0)
  #define EX(v) __builtin_amdgcn_exp2f(v)
  #define GAPB(MF,X,B) do{ MF; X[B]=EX(X[B]); X[B+1]=EX(X[B+1]); X[B+2]=EX(X[B+2]); X[B+3]=EX(X[B+3]); PIN(X); SBAR(); }while(0)
  #define VRD(i) do{ vlo[i]=vtr(vp_+(((i)>>2)*4096+((i)&3)*1024)); vhi[i]=vtr(vp_+(((i)>>2)*4096+((i)&3)*1024+512)); }while(0)
  #define KRD(G,j) do{ if(G){ kload2(kf,kp0+sl_next,j); SBAR(); } }while(0)
  #define STEP(C0,C1,P0,P1,t,GK,GV,GL) do{ SBAR(); \
    const lds_cptr vp_=vp0+sl_prev; \
    VRD(0); SBAR(); float sacc=(P0[0]+P0[1]); \
    GAPA(C0=__builtin_amdgcn_mfma_f32_32x32x16_bf16(kf[0],qr[0],negm,0,0,0), P0[2],P0[3],P0[4],P0[5],     pw0[0]=PKW(P0,0), pw0[1]=PKW(P0,2), pw0); \
    VRD(4); SBAR(); GAPA(C1=__builtin_amdgcn_mfma_f32_32x32x16_bf16(kf[1],qr[0],negm,0,0,0), P0[6],P0[7],P0[8],P0[9],     pw0[2]=PKW(P0,4), pw0[3]=PKW(P0,6), pw0); \
    VRD(1); SBAR(); GAPA(C0=__builtin_amdgcn_mfma_f32_32x32x16_bf16(kf[2],qr[1],C0,0,0,0),   P0[10],P0[11],P0[12],P0[13], pw1[0]=PKW(P0,8), pw1[1]=PKW(P0,10), pw1); \
    VRD(5); SBAR(); GAPA(C1=__builtin_amdgcn_mfma_f32_32x32x16_bf16(kf[3],qr[1],C1,0,0,0),   P0[14],P0[15],P1[0],P1[1],   pw1[2]=PKW(P0,12),pw1[3]=PKW(P0,14), pw1); \
    VRD(2); SBAR(); GAPA(C0=__builtin_amdgcn_mfma_f32_32x32x16_bf16(kf[4],qr[2],C0,0,0,0),   P1[2],P1[3],P1[4],P1[5],     pw2[0]=PKW(P1,0), pw2[1]=PKW(P1,2), pw2); \
    VRD(6); SBAR(); GAPA(C1=__builtin_amdgcn_mfma_f32_32x32x16_bf16(kf[5],qr[2],C1,0,0,0),   P1[6],P1[7],P1[8],P1[9],     pw2[2]=PKW(P1,4), pw2[3]=PKW(P1,6), pw2); \
    VRD(3); SBAR(); GAPA(C0=__builtin_amdgcn_mfma_f32_32x32x16_bf16(kf[6],qr[3],C0,0,0,0),   P1[10],P1[11],P1[12],P1[13], pw3[0]=PKW(P1,8), pw3[1]=PKW(P1,10), pw3); \
    VRD(7); SBAR(); GAPA(C1=__builtin_amdgcn_mfma_f32_32x32x16_bf16(kf[7],qr[3],C1,0,0,0),   P1[14],P1[15],0.f,0.f,       pw3[2]=PKW(P1,12),pw3[3]=PKW(P1,14), pw3); \
    l_reg+=sacc; \
    if(GK){DMA_K((t)+3,sl_cur);} if(GV){DMA_V((t)+1,sl_next);} \
    CMASK(C0,C1,t); \
    { float a=MX3(C0[0],C0[1],C1[0]),b=MX3(C0[2],C0[3],C1[1]); a=MX3(a,C1[2],C1[3]); \
      _Pragma("unroll") for(int r=4;r<16;r+=4){a=MX3(a,C0[r],C0[r+1]);b=MX3(b,C0[r+2],C0[r+3]);a=MX3(a,C1[r],C1[r+1]);b=MX3(b,C1[r+2],C1[r+3]);} \
      float rm=__builtin_fmaxf(a,b); { auto rr=__builtin_amdgcn_permlane32_swap(__float_as_uint(rm),__float_as_uint(rm),false,false); rm=__builtin_fmaxf(__uint_as_float(rr[0]),__uint_as_float(rr[1])); } \
      resc=false; \
      if(__builtin_expect(__any(rm>(float)THRL),0)){ const float dl=__builtin_fmaxf(rm,0.f); mhat+=dl; \
        _Pragma("unroll") for(int r=0;r<16;++r){C0[r]-=dl;C1[r]-=dl;} \
        const float nm_=MSKF((t)>>2)-mhat; _Pragma("unroll") for(int r=0;r<16;++r)negm[r]=nm_; asm volatile("":"+v"(negm)); \
        const float f=__builtin_amdgcn_exp2f(-dl); l_reg*=f; if(hi==0)wsf[r32]=f; resc=true; } } \
    SBAR(); \
    GAPB(o[0]=__builtin_amdgcn_mfma_f32_32x32x16_bf16(PAF(0),VFR(0),o[0],0,0,0), C0,0); \
    GAPB(o[1]=__builtin_amdgcn_mfma_f32_32x32x16_bf16(PAF(0),VFR(4),o[1],0,0,0), C0,4); \
    KRD(GL,0); GAPB(o[0]=__builtin_amdgcn_mfma_f32_32x32x16_bf16(PAF(1),VFR(1),o[0],0,0,0), C0,8); \
    KRD(GL,1); GAPB(o[1]=__builtin_amdgcn_mfma_f32_32x32x16_bf16(PAF(1),VFR(5),o[1],0,0,0), C0,12); \
    KRD(GL,2); GAPB(o[0]=__builtin_amdgcn_mfma_f32_32x32x16_bf16(PAF(2),VFR(2),o[0],0,0,0), C1,0); \
    KRD(GL,3); GAPB(o[1]=__builtin_amdgcn_mfma_f32_32x32x16_bf16(PAF(2),VFR(6),o[1],0,0,0), C1,4); \
    GAPB(o[0]=__builtin_amdgcn_mfma_f32_32x32x16_bf16(PAF(3),VFR(3),o[0],0,0,0), C1,8); \
    GAPB(o[1]=__builtin_amdgcn_mfma_f32_32x32x16_bf16(PAF(3),VFR(7),o[1],0,0,0), C1,12); \
    }while(0)
  int t=1;
  #undef CMASK
  #define CMASK(P0,P1,t) do{}while(0)
  for(;t+5<NT;t+=2){
    STEP(pB0,pB1,pA0,pA1,t,true,true,true);     WAIT_BAR(2); RESC(); ROT(); NEWBLK(t+1);
    STEP(pA0,pA1,pB0,pB1,t+1,true,true,true);   WAIT_BAR(2); RESC(); ROT();
  }
  #undef CMASK
  #define CMASK(P0,P1,t) do{int jb_=(t)-(NT-4); if(jb_>=0)cmask(P0,P1,jb_,qrel,hi);}while(0)
  #define ENDW(tt) do{ if((tt)+3<NT){WAIT_BAR(2);} else if((tt)+2<NT){WAIT_BAR(1);} else {WAIT_BAR(0);} }while(0)
  for(;t+1<NT;t+=2){
    STEP(pB0,pB1,pA0,pA1,t,(t+3<NT),(t+1<NT),(t+1<NT));       ENDW(t);   RESC(); ROT(); NEWBLK(t+1);
    STEP(pA0,pA1,pB0,pB1,t+1,(t+4<NT),(t+2<NT),(t+2<NT));     ENDW(t+1); RESC(); ROT();
  }
  STEP(pB0,pB1,pA0,pA1,NT-1,false,false,false); RESC();
  { float sacc=pB0[0]+pB0[1]; _Pragma("unroll") for(int r=2;r<16;++r)sacc+=pB0[r]; _Pragma("unroll") for(int r=0;r<16;++r)sacc+=pB1[r]; l_reg+=sacc;
    pw0=(u32x4){PKW(pB0,0),PKW(pB0,2),PKW(pB0,4),PKW(pB0,6)};pw1=(u32x4){PKW(pB0,8),PKW(pB0,10),PKW(pB0,12),PKW(pB0,14)};pw2=(u32x4){PKW(pB1,0),PKW(pB1,2),PKW(pB1,4),PKW(pB1,6)};pw3=(u32x4){PKW(pB1,8),PKW(pB1,10),PKW(pB1,12),PKW(pB1,14)};
    SBAR(); pv(o,vb0+sl_cur,PAF(0),PAF(1),PAF(2),PAF(3)); }
  #undef PKW
  #undef PAF
  #undef VFR
  #undef PIN
  #undef MX3
  #undef GAPA
  #undef GAPB
  #undef EX
  #undef VRD
  #undef KRD
  #undef STEP
  #undef ENDW
  {auto rr=__builtin_amdgcn_permlane32_swap(__float_as_uint(l_reg),__float_as_uint(l_reg),false,false);l_reg=__uint_as_float(rr[0])+__uint_as_float(rr[1]);}
  if(hi==0)wsf[32+r32]=l_reg;asm volatile("s_waitcnt lgkmcnt(0)":::"memory");
  float rli[16];
  #pragma unroll
  for(int r=0;r<16;++r)rli[r]=__builtin_amdgcn_rcpf(wsf[32+crow(r,hi)]);
  bf16*Yw=Y+(rowbase+q0+wid*QBLK)*YP+h*D;
  { float*stg=(float*)(shm+LDS_OST)+wid*2048;
    #pragma unroll
    for(int r=0;r<16;++r){const int orow=crow(r,hi);
      #pragma unroll
      for(int d0=0;d0<2;++d0)stg[orow*64+d0*32+r32]=o[d0][r]*rli[r];}
    asm volatile("s_waitcnt lgkmcnt(0)":::"memory");
    const int c4=lane&15; const f32x4_t g4=*reinterpret_cast<const f32x4_t*>(onb_g+h*D+c4*4);
    #pragma unroll
    for(int i=0;i<8;++i){const int row=i*4+(lane>>4); const f32x4_t v=*(const f32x4_t*)(stg+row*64+c4*4);
      float ss=(v[0]*v[0]+v[1]*v[1])+(v[2]*v[2]+v[3]*v[3]); ss+=__shfl_xor(ss,1); ss+=__shfl_xor(ss,2); ss+=__shfl_xor(ss,4); ss+=__shfl_xor(ss,8);
      const float rs=__builtin_amdgcn_rsqf(ss*(1.0f/64.0f)+1e-6f);
      u32x2_t w; w.x=cvtpk_s(v[0]*rs*g4[0],v[1]*rs*g4[1]); w.y=cvtpk_s(v[2]*rs*g4[2],v[3]*rs*g4[3]);
      *(u32x2_t*)(Yw+(long)row*YP+c4*4)=w;} }
  asm volatile("s_waitcnt lgkmcnt(0)\n\ts_barrier":::"memory");
  #undef DMA_K
  #undef DMA_V
  #undef MSKF
  #undef NEWBLK
  #undef CMASK
  #undef START
  #undef RESC
  #undef ROT
}
constexpr int ATTN_LDS_BYTES=LDS_BYTES;
struct AttnTensors { const bf16* Q; const bf16* K; const bf16* V; bf16* Y; const float* ksum; const float* onb_g; };
struct AttnUnit { int bh; int qb; };
struct StaticOrder {
  int vcu,G;
  __device__ __forceinline__ explicit StaticOrder(int grid,int block):vcu((grid%8==0)?(block%8)*(grid/8)+block/8:block),G(grid){}
  __device__ __forceinline__ bool next(int i,AttnUnit&u)const{ const int p=vcu+(i>>1)*G; if(p>=BATCH*NHEAD*4)return false; const int s=p&3; u.bh=p>>2; u.qb=(i&1)?7-s:s; return true; }
  __device__ __forceinline__ void a_ready(const AttnUnit&)const{}
  __device__ __forceinline__ void done(const AttnUnit&)const{}
};
template<class Sched,int THRL=8> __device__ __forceinline__ void attn_phase(char*lds,const AttnTensors&T,const Sched&S){
  AttnUnit u;
  for(int i=0;S.next(i,u);++i){ S.a_ready(u); attn_unit<THRL>(u.bh/NHEAD,u.bh%NHEAD,u.qb,T.Q,T.K,T.V,T.Y,T.ksum,T.onb_g,lds); S.done(u); }
}
#undef SBAR
#undef WAIT_BAR
}
constexpr int NWAVES = 8;
#ifndef MK_N_LAUNCHES
#define MK_N_LAUNCHES 1
#endif
constexpr int PER_PHASE = 6;
constexpr int CW_TMO = 0, CW_CODE = 1, CW_EXIT = 2, CW_START = 64;
constexpr int CW_BAR = 4096;
constexpr int RING_OFF = 0, RING_BYTES = 131072;
constexpr int LDSCTL_OFF = RING_BYTES, MISC_OFF = LDSCTL_OFF + 320;
constexpr int LDS_BYTES = 147456;
constexpr int PAR_OFF = LDSCTL_OFF + 1024;
static_assert(MISC_OFF + 128 <= PAR_OFF && PAR_OFF + 1152 * 4 <= LDS_BYTES, "LDS map");

#define GAS __attribute__((address_space(1)))
#define LAS __attribute__((address_space(3)))
typedef unsigned short bf16;
typedef unsigned v4u __attribute__((ext_vector_type(4)));
typedef float f32x4 __attribute__((ext_vector_type(4)));
typedef short bf16x8 __attribute__((ext_vector_type(8)));
typedef GAS unsigned gu32;
typedef GAS unsigned long long gu64;
#define RLX_AGENT __ATOMIC_RELAXED, __HIP_MEMORY_SCOPE_AGENT
#define LDS_WAIT() asm volatile("s_waitcnt lgkmcnt(0)" ::: "memory")
#define VM_WAIT() asm volatile("s_waitcnt vmcnt(0)" ::: "memory")
__device__ __forceinline__ unsigned long long rt() { return __builtin_amdgcn_s_memrealtime(); }
__device__ __forceinline__ unsigned f2bf(float f) { unsigned u = __builtin_bit_cast(unsigned, f); return (u + 0x7fffu + ((u >> 16) & 1u)) >> 16; }
__device__ __forceinline__ unsigned pk2(float lo, float hi) { return f2bf(lo) | (f2bf(hi) << 16); }

#define XB_TMO      128
#define XB_XCNT(j)  (256  + 64 * (j))
#define XB_XSUB(j)  (1280 + 64 * (j))
#define XB_XGEN(j)  (2304 + 64 * (j))
#define XB_TOP      3328
#define XB_TOPGEN   3392
#define XCD_BAR_WORDS 3456
#define XB_SPIN_CAP (1u << 18)

__device__ __forceinline__ unsigned xb_ld(unsigned* p)              { return __hip_atomic_load(p, __ATOMIC_RELAXED, __HIP_MEMORY_SCOPE_AGENT); }
__device__ __forceinline__ unsigned xb_add(unsigned* p, unsigned v) { return __hip_atomic_fetch_add(p, v, __ATOMIC_RELAXED, __HIP_MEMORY_SCOPE_AGENT); }
__device__ __forceinline__ unsigned xb_xcc_id() { return (unsigned)__builtin_amdgcn_s_getreg((3 << 11) | 20) & 0xFu; }
#define XB_SPIN(cond, bar) do { unsigned _sp = 0; while (cond) { __builtin_amdgcn_s_sleep(1); \
    if ((++_sp & 255u) == 0u) { if (xb_ld(&(bar)[XB_TMO])) break; if (_sp > XB_SPIN_CAP) { atomicAdd(&(bar)[XB_TMO], 1u); break; } } } } while (0)

struct XcdBarrier {
    unsigned* bar; unsigned x;
    volatile LAS unsigned* st;
};

__device__ __forceinline__ XcdBarrier xcd_barrier_post(unsigned* bar, volatile LAS unsigned* st) {
    XcdBarrier b; b.bar = bar; b.x = xb_xcc_id(); b.st = st;
    if (threadIdx.x == 0) (void)xb_add(&bar[XB_XCNT(b.x)], 1u);
    return b;
}
__device__ __forceinline__ void xcd_barrier_complete(unsigned* bar, unsigned x, unsigned& nloc, unsigned& nx) {
    const unsigned G = gridDim.x * gridDim.y * gridDim.z;
    unsigned sum, cnt, mine, sp = 0u;
    for (;;) {
        sum = 0u; cnt = 0u; mine = 0u;
#pragma unroll
        for (unsigned j = 0; j < 16; ++j) { const unsigned c = xb_ld(&bar[XB_XCNT(j)]); sum += c; cnt += (c > 0u) ? 1u : 0u; mine = (j == x) ? c : mine; }
        if (sum == G) break;
        __builtin_amdgcn_s_sleep(1);
        if ((++sp & 255u) == 0u) { if (xb_ld(&bar[XB_TMO])) break; if (sp > XB_SPIN_CAP) { atomicAdd(&bar[XB_TMO], 1u); break; } }
    }
    nloc = mine > 0u ? mine : 1u; nx = cnt > 0u ? cnt : 1u;
}

__device__ __forceinline__ void xcd_barrier(const XcdBarrier& b) {
    asm volatile("s_waitcnt vmcnt(0)" ::: "memory");
    __syncthreads();
    if (threadIdx.x == 0) {
        unsigned* bar = b.bar;
        __builtin_amdgcn_s_waitcnt(0);
        unsigned nloc = b.st[0], nx = b.st[1];
        if (nloc == 0u) { xcd_barrier_complete(bar, b.x, nloc, nx); b.st[0] = nloc; b.st[1] = nx; }
        const unsigned old = xb_add(&bar[XB_XSUB(b.x)], 1u);
        const unsigned gen = old / nloc;
        if (old + 1u == (gen + 1u) * nloc) {
            __builtin_amdgcn_fence(__ATOMIC_RELEASE, "agent");
            asm volatile("s_waitcnt vmcnt(0)" ::: "memory");
            const unsigned og = xb_add(&bar[XB_TOP], 1u);
            const unsigned tg = og / nx;
            if (og + 1u == (tg + 1u) * nx) xb_add(&bar[XB_TOPGEN], 1u);
            else XB_SPIN(xb_ld(&bar[XB_TOPGEN]) == tg, bar);
            __builtin_amdgcn_fence(__ATOMIC_ACQUIRE, "agent");
            xb_add(&bar[XB_XGEN(b.x)], 1u);
            asm volatile("s_waitcnt vmcnt(0)" ::: "memory");
        } else {
            XB_SPIN(xb_ld(&bar[XB_XGEN(b.x)]) == gen, bar);
            __builtin_amdgcn_fence(__ATOMIC_ACQUIRE, "agent");
            asm volatile("s_waitcnt vmcnt(0)" ::: "memory");
        }
    }
    __syncthreads();
}

struct Frame {
    LAS unsigned char* lds;
    volatile LAS unsigned* MISC;
    gu32* ctl;
    int tid, lane, wave;
    int vcu, G;
};

__device__ __forceinline__ float wave_sum(float v) {
#pragma unroll
    for (int o = 1; o < 64; o <<= 1) v += __shfl_xor(v, o);
    return v;
}
struct WTile { const float* W; const float* g; void* WT; int K, N, k0, n0; float scale; int f8, gu; };
constexpr int WT_S = 257;
__device__ __forceinline__ void wtile_load(const WTile& t, int wave, int lane, f32x4 (&v)[8]) {
#pragma unroll
    for (int i = 0; i < 8; ++i) v[i] = *(const GAS f32x4*)(t.W + (size_t)(t.k0 + wave + 8 * i) * t.N + t.n0 + 4 * lane);
}
__device__ __forceinline__ void wtile_store(const WTile& t, int tid, int wave, int lane, const f32x4 (&v)[8], LAS float* scr) {
#pragma unroll
    for (int i = 0; i < 8; ++i) { const int kk = wave + 8 * i; const float sc = t.g ? t.g[t.k0 + kk] * t.scale : t.scale; const f32x4 x = v[i] * sc;
        LAS float* p = scr + kk * WT_S + 4 * lane; p[0] = x.x; p[1] = x.y; p[2] = x.z; p[3] = x.w; }
    LDS_WAIT(); __syncthreads();
    if (!t.f8) {
#pragma unroll
        for (int j = 0; j < 4; ++j) { const int p = tid + 512 * j, c = p & 7, n = p >> 3; const LAS float* s = scr + (8 * c) * WT_S + n;
            v4u o; o.x = pk2(s[0 * WT_S], s[1 * WT_S]); o.y = pk2(s[2 * WT_S], s[3 * WT_S]); o.z = pk2(s[4 * WT_S], s[5 * WT_S]); o.w = pk2(s[6 * WT_S], s[7 * WT_S]);
            const int jn = t.n0 + n, row = t.gu ? ((jn >> 7) * 256 + (jn & 127) + (t.gu == 2 ? 128 : 0)) : jn;
            *(GAS v4u*)((bf16*)t.WT + (size_t)row * t.K + t.k0 + 8 * c) = o; }
    } else {
#pragma unroll
        for (int j = 0; j < 2; ++j) { const int p = tid + 512 * j, c = p & 3, n = p >> 2; const LAS float* s = scr + (16 * c) * WT_S + n;
            int w[4];
#pragma unroll
            for (int e = 0; e < 4; ++e) { w[e] = __builtin_amdgcn_cvt_pk_fp8_f32(s[(4 * e) * WT_S], s[(4 * e + 1) * WT_S], 0, false); w[e] = __builtin_amdgcn_cvt_pk_fp8_f32(s[(4 * e + 2) * WT_S], s[(4 * e + 3) * WT_S], w[e], true); }
            v4u o; o.x = (unsigned)w[0]; o.y = (unsigned)w[1]; o.z = (unsigned)w[2]; o.w = (unsigned)w[3];
            const int jn = t.n0 + n, row = t.gu ? ((jn >> 7) * 256 + (jn & 127) + (t.gu == 2 ? 128 : 0)) : jn;
            *(GAS v4u*)((unsigned char*)t.WT + (size_t)row * t.K + t.k0 + 16 * c) = o; }
    }
    LDS_WAIT(); __syncthreads();
}
template <int NR> __device__ __forceinline__ void rms_rows_to_bf16(int lane, const float* xrow, size_t rstride, const float* gain, bf16* orow) {
    f32x4 v[NR][4];
#pragma unroll
    for (int r = 0; r < NR; ++r)
#pragma unroll
        for (int j = 0; j < 4; ++j) v[r][j] = ((const GAS f32x4*)(xrow + r * rstride) + lane)[64 * j];
    const GAS f32x4* gr = (const GAS f32x4*)gain + lane; f32x4 gg[4];
#pragma unroll
    for (int j = 0; j < 4; ++j) gg[j] = gr[64 * j];
#pragma unroll
    for (int r = 0; r < NR; ++r) { float s = 0.f;
#pragma unroll
        for (int j = 0; j < 4; ++j) s += (v[r][j].x * v[r][j].x + v[r][j].y * v[r][j].y) + (v[r][j].z * v[r][j].z + v[r][j].w * v[r][j].w);
        const float rstd = 1.f / sqrtf(wave_sum(s) * (1.f / DM) + EPS);
        GAS unsigned long long* o8 = (GAS unsigned long long*)(orow + r * rstride) + lane;
#pragma unroll
        for (int j = 0; j < 4; ++j) o8[64 * j] = (unsigned long long)pk2(v[r][j].x * rstd * gg[j].x, v[r][j].y * rstd * gg[j].y) | ((unsigned long long)pk2(v[r][j].z * rstd * gg[j].z, v[r][j].w * rstd * gg[j].w) << 32); }
}
struct P0Args { const float *x, *norm1_g, *w_in, *sgu_w, *w_out, *norm2_g, *w_gate, *w_up, *w_down; bf16 *WinT, *WoT; unsigned char *WguQ, *WdQ; bf16 *SW, *XN; };
constexpr int WT_IN = (DM / 64) * (INW / 256), WT_O = (DM / 64) * (DM / 256), WT_G = (DM / 64) * (DFF / 256), WT_D = (DFF / 64) * (DM / 256);
__device__ __forceinline__ int wset_count(int set) { return set == 0 ? WT_IN : set == 1 ? WT_O + 2 * WT_G : WT_D; }
__device__ __forceinline__ WTile wset_tile(const P0Args& a, int set, int r) {
    if (set == 0) { const int nb = INW / 256; return WTile{a.w_in, nullptr, a.WinT, DM, INW, 64 * (r / nb), 256 * (r % nb), 1.0f, 0, 0}; }
    if (set == 2) { const int nb = DM / 256; return WTile{a.w_down, nullptr, a.WdQ, DFF, DM, 64 * (r / nb), 256 * (r % nb), WD_SCALE, 1, 0}; }
    if (r < WT_O) { const int nb = DM / 256; return WTile{a.w_out, nullptr, a.WoT, DM, DM, 64 * (r / nb), 256 * (r % nb), 1.0f, 0, 0}; } r -= WT_O;
    { const bool up = r >= WT_G; if (up) r -= WT_G; const int nb = DFF / 256; return WTile{up ? a.w_up : a.w_gate, a.norm2_g, a.WguQ, DM, DFF, 64 * (r / nb), 256 * (r % nb), WGU_SCALE, 1, up ? 2 : 1}; }
}
__device__ __forceinline__ void wset_convert(Frame& F, const P0Args& a, int set, int wg, int nwg) {
    LAS float* scr = (LAS float*)(F.lds + RING_OFF);
    const int cnt = wset_count(set); int r = wg; if (r >= cnt) return;
    WTile cur = wset_tile(a, set, r); f32x4 v[8], vn[8]; wtile_load(cur, F.wave, F.lane, v);
    for (;;) {
        const int rn = r + nwg; const bool more = rn < cnt; WTile nxt = cur;
        if (more) { nxt = wset_tile(a, set, rn); wtile_load(nxt, F.wave, F.lane, vn); }
        wtile_store(cur, F.tid, F.wave, F.lane, v, scr);
        if (!more) break;
#pragma unroll
        for (int i = 0; i < 8; ++i) v[i] = vn[i];
        cur = nxt; r = rn;
    }
}
__device__ __forceinline__ void p0_prologue(Frame& F, const P0Args& a) {
    const int gw = F.vcu * NWAVES + F.wave, NGW = F.G * NWAVES;
    wset_convert(F, a, 0, F.vcu, F.G);
    for (int m = 4 * gw; m < M; m += 4 * NGW) rms_rows_to_bf16<4>(F.lane, a.x + (size_t)m * DM, DM, a.norm1_g, a.XN + (size_t)m * DM);
    for (int i = (F.vcu * NWAVES * 64 + F.tid); i < NH * CHUNK * CHUNK; i += F.G * NWAVES * 64) { const int t = (i / CHUNK) % CHUNK, s = i % CHUNK; a.SW[i] = (bf16)f2bf(s <= t ? a.sgu_w[i] : 0.0f); }
}

constexpr int SGU_V_BYTES = 16384, SGU_U_PITCH = 144, SGU_U_BYTES = 128 * SGU_U_PITCH, SGU_UOFF = 2 * SGU_V_BYTES;
struct SguArgs { const bf16* P; const bf16* SW; const float* sgu_b; const float* ona_g; bf16* Y; };
typedef float f32x16 __attribute__((ext_vector_type(16)));
typedef short s16x4 __attribute__((ext_vector_type(4)));
typedef unsigned u32x2 __attribute__((ext_vector_type(2)));
__device__ __forceinline__ int crow16(int r, int hi) { return (r & 3) + 8 * (r >> 2) + 4 * hi; }
__device__ __forceinline__ void sgu_unit(Frame& F, const SguArgs& a, int unit) {
    const int b = unit >> 6, c = (unit >> 2) & 15, hp = unit & 3;
    int tid_ = threadIdx.x; asm volatile("" : "+v"(tid_)); const int tid = tid_, lane = tid & 63, wid = F.wave, r32 = lane & 31, hi = lane >> 5;
    const size_t row0 = (size_t)b * SEQ + c * CHUNK;
#pragma unroll
    for (int k = 0; k < 4; ++k) { const int i = tid + 512 * k, hl = i >> 10, row = (i >> 3) & 127, ch = i & 7;
        const bf16* src = a.P + (row0 + row) * INW + (2 * hp + hl) * 64 + ch * 8;
        const v4u vv = *(const GAS v4u*)(src + COL_VA), uu = *(const GAS v4u*)(src + COL_U);
        *(LAS v4u*)(F.lds + RING_OFF + hl * SGU_V_BYTES + (ch >> 2) * 8192 + row * 64 + (ch & 3) * 16) = vv;
        *(LAS v4u*)(F.lds + RING_OFF + SGU_UOFF + hl * SGU_U_BYTES + row * SGU_U_PITCH + ch * 16) = uu; }
    LDS_WAIT(); __syncthreads();
    const int hl = wid >> 2, h = 2 * hp + hl, t0 = 32 * (wid & 3);
    f32x16 acc[2]; acc[0] = f32x16{}; acc[1] = f32x16{};
    const bf16* wrow = a.SW + ((size_t)h * CHUNK + t0 + r32) * CHUNK + 8 * hi;
    const LAS unsigned char* vbase = F.lds + RING_OFF + hl * SGU_V_BYTES + (8 * hi + ((lane & 15) >> 2)) * 64 + 32 * ((lane >> 4) & 1) + 8 * (lane & 3);
    for (int s0 = 0; s0 < t0 + 32; s0 += 16) {
        const bf16x8 wf = *(const GAS bf16x8*)(wrow + s0);
#pragma unroll
        for (int d0 = 0; d0 < 2; ++d0) {
            const s16x4 lo = __builtin_bit_cast(s16x4, __builtin_amdgcn_ds_read_tr16_b64_v4i16((LAS s16x4*)(vbase + d0 * 8192 + s0 * 64)));
            const s16x4 hh = __builtin_bit_cast(s16x4, __builtin_amdgcn_ds_read_tr16_b64_v4i16((LAS s16x4*)(vbase + d0 * 8192 + s0 * 64 + 256)));
            const bf16x8 vf = (bf16x8){lo[0], lo[1], lo[2], lo[3], hh[0], hh[1], hh[2], hh[3]};
            acc[d0] = __builtin_amdgcn_mfma_f32_32x32x16_bf16(vf, wf, acc[d0], 0, 0, 0);
        }
    }
    const float bias = a.sgu_b[h * CHUNK + t0 + r32];
    LAS unsigned char* urow = F.lds + RING_OFF + SGU_UOFF + hl * SGU_U_BYTES + (t0 + r32) * SGU_U_PITCH;
    float y[2][16]; float ss = 0.f;
#pragma unroll
    for (int d0 = 0; d0 < 2; ++d0)
#pragma unroll
        for (int g = 0; g < 4; ++g) { const u32x2 uw = *(const LAS u32x2*)(urow + (32 * d0 + 8 * g + 4 * hi) * 2);
            const float u0 = __builtin_bit_cast(float, uw.x << 16), u1 = __builtin_bit_cast(float, uw.x & 0xffff0000u), u2 = __builtin_bit_cast(float, uw.y << 16), u3 = __builtin_bit_cast(float, uw.y & 0xffff0000u);
            y[d0][4 * g + 0] = u0 * (acc[d0][4 * g + 0] + bias); y[d0][4 * g + 1] = u1 * (acc[d0][4 * g + 1] + bias); y[d0][4 * g + 2] = u2 * (acc[d0][4 * g + 2] + bias); y[d0][4 * g + 3] = u3 * (acc[d0][4 * g + 3] + bias);
            ss += (y[d0][4 * g] * y[d0][4 * g] + y[d0][4 * g + 1] * y[d0][4 * g + 1]) + (y[d0][4 * g + 2] * y[d0][4 * g + 2] + y[d0][4 * g + 3] * y[d0][4 * g + 3]); }
    ss += __shfl_xor(ss, 32);
    const float rs = __builtin_amdgcn_rsqf(ss * (1.0f / 64.0f) + EPS);
#pragma unroll
    for (int d0 = 0; d0 < 2; ++d0)
#pragma unroll
        for (int g = 0; g < 4; ++g) { const f32x4 gg = *(const GAS f32x4*)(a.ona_g + h * 64 + 32 * d0 + 8 * g + 4 * hi);
            u32x2 w; w.x = pk2(y[d0][4 * g] * rs * gg.x, y[d0][4 * g + 1] * rs * gg.y); w.y = pk2(y[d0][4 * g + 2] * rs * gg.z, y[d0][4 * g + 3] * rs * gg.w);
            *(LAS u32x2*)(urow + (32 * d0 + 8 * g + 4 * hi) * 2) = w; }
    LDS_WAIT(); asm volatile("" ::: "memory");
#pragma unroll
    for (int i = 0; i < 4; ++i) { const int row = t0 + i * 8 + (lane >> 3), ch = lane & 7;
        const v4u vv = *(const LAS v4u*)(F.lds + RING_OFF + SGU_UOFF + hl * SGU_U_BYTES + row * SGU_U_PITCH + ch * 16);
        *(GAS v4u*)(a.Y + (row0 + row) * DM + h * 64 + ch * 8) = vv; }
    LDS_WAIT(); __syncthreads();
}

#ifndef XPROBE
#define XPROBE 0
#endif
struct Args { const float* in[16]; float* out; unsigned char* ws; int ph_lo, ph_hi; };
__global__ void __launch_bounds__(NWAVES * 64, 2) mega_fwd(Args args) {
    extern __shared__ __attribute__((aligned(16))) unsigned char lds[];
    Frame F;
    F.lds = (LAS unsigned char*)lds;
    F.MISC = (volatile LAS unsigned*)(F.lds + MISC_OFF);
    F.tid = threadIdx.x; F.lane = F.tid & 63; F.wave = __builtin_amdgcn_readfirstlane(F.tid >> 6);
    F.G = gridDim.x; { const int bx = blockIdx.x; F.vcu = (F.G % 8 == 0) ? (bx % 8) * (F.G / 8) + bx / 8 : bx; }
    unsigned char* ws = args.ws;
    F.ctl = (gu32*)(ws + WS_CTL);
    const float* x = args.in[0]; const float* norm1_g = args.in[1]; const float* w_in = args.in[2]; const float* ln_g = args.in[3]; const float* ln_b = args.in[4];
    const float* sgu_w = args.in[5]; const float* sgu_b = args.in[6]; const float* q_g = args.in[7]; const float* k_g = args.in[8]; const float* ona_g = args.in[9]; const float* onb_g = args.in[10];
    const float* w_out = args.in[11]; const float* norm2_g = args.in[12]; const float* w_gate = args.in[13]; const float* w_up = args.in[14]; const float* w_down = args.in[15];
    float* out = args.out;
    bf16* WinT = (bf16*)(ws + WS_WIN); bf16* WoT = (bf16*)(ws + WS_WO); unsigned char* WguQ = ws + WS_WGU; unsigned char* WdQ = ws + WS_WD; unsigned char* X1Q = ws + WS_X1Q; bf16* SW = (bf16*)(ws + WS_SW);
    float* ksum = (float*)(ws + WS_KSUM); float* rowss = (float*)(ws + WS_ROWSS);
    bf16* XN = (bf16*)(ws + WS_XN); bf16* X1B = XN; bf16* Yb = (bf16*)(ws + WS_Y); bf16* PROJ = (bf16*)(ws + WS_PROJ); unsigned char* HIDQ = ws + WS_PROJ;
    const bool IN_PH1 = (args.ph_lo <= 1 && 1 < args.ph_hi);
    for (int u = F.tid; u < (PAR_OFF - LDSCTL_OFF) / 4; u += NWAVES * 64) ((LAS unsigned*)(F.lds + LDSCTL_OFF))[u] = 0u;
    if (IN_PH1) { LAS float* par = (LAS float*)(F.lds + PAR_OFF);
        for (int i = F.tid; i < 1152; i += NWAVES * 64) par[i] = (i < 512) ? ln_g[i] : (i < 1024) ? ln_b[i - 512] : (i < 1088) ? q_g[i - 1024] * C2 : k_g[i - 1088]; }
    __syncthreads();
    const bool one_launch = (args.ph_hi - args.ph_lo) > 1;
    if (one_launch) {
        gu32* start = F.ctl + CW_START; constexpr unsigned MAGIC = 0x600DF1A6u;
        if (blockIdx.x == 0) {
            for (int i = F.tid; i < XCD_BAR_WORDS; i += NWAVES * 64) F.ctl[CW_BAR + i] = 0u;
            if (F.tid < 64) F.ctl[F.tid] = 0u;
            asm volatile("s_waitcnt vmcnt(0)" ::: "memory"); __syncthreads();
            if (F.tid == 0) { __builtin_amdgcn_fence(__ATOMIC_RELEASE, "agent"); asm volatile("s_waitcnt vmcnt(0)" ::: "memory"); __hip_atomic_store(start, MAGIC, RLX_AGENT); }
        } else {
            if (F.tid == 0) { unsigned sp = 0; while (__hip_atomic_load(start, RLX_AGENT) != MAGIC) { __builtin_amdgcn_s_sleep(2); if (++sp > (1u << 22)) break; }
                __builtin_amdgcn_fence(__ATOMIC_ACQUIRE, "agent"); asm volatile("s_waitcnt vmcnt(0)" ::: "memory"); }
            __syncthreads();
        }
    }
    XcdBarrier bar; bar.bar = (unsigned*)(F.ctl + CW_BAR); bar.x = 0; bar.st = nullptr;
    if (one_launch) bar = xcd_barrier_post((unsigned*)(F.ctl + CW_BAR), F.MISC + 8);
    const int lo = args.ph_lo, hi = args.ph_hi;
#ifndef LEAK_PHASE
#define LEAK_PHASE -1
#define LEAK_MULT 4ull
#endif
#if LEAK_PHASE >= 0
    unsigned long long st_[10], sc_[10]; int ns_ = 0; const bool stamper_ = (blockIdx.x == 0 && F.tid == 0);
#define STAMP() do { st_[ns_ < 9 ? ns_ : 9] = __builtin_amdgcn_s_memrealtime(); sc_[ns_ < 9 ? ns_ : 9] = __builtin_amdgcn_s_memtime(); ++ns_; } while (0)
    STAMP();
#else
#define STAMP() do {} while (0)
#endif
#ifndef PH_MASK
#define PH_MASK 63
#endif
#define IN(k) (((PH_MASK >> (k)) & 1) && lo <= (k) && (k) < hi)
#define BOTH(k) (IN(k) && IN((k) + 1))
#define GRID_BAR() xcd_barrier(bar)
#ifndef REP_MASK
#define REP_MASK 0
#endif
#define REPS(k) for (int rep_ = 0; rep_ <= ((REP_MASK >> (k)) & 1); ++rep_)

#ifdef WARM_SPIN
    { pg8::f32x4 wacc = {0.f, 0.f, 0.f, 0.f}; pg8::bf16x8 wa = {1, 2, 3, 4, 5, 6, 7, 8}; asm volatile("" : "+v"(wa));
      for (int i = 0; i < WARM_SPIN; ++i) { wacc = __builtin_amdgcn_mfma_f32_16x16x32_bf16(wa, wa, wacc, 0, 0, 0); }
      if (wacc[0] == 123.456f) rowss[0] = wacc[1]; STAMP(); }
#endif
#ifdef TOUCH_W
    { const float* wl_[4] = {w_out, w_gate, w_up, w_down}; const size_t nb_[4] = {(size_t)DM * DM * 4, (size_t)DM * DFF * 4, (size_t)DM * DFF * 4, (size_t)DFF * DM * 4};
#pragma unroll
      for (int q = 0; q < 4; ++q) for (size_t o = ((size_t)blockIdx.x * 512 + F.tid) * 4096; o < nb_[q]; o += (size_t)F.G * 512 * 4096) { volatile const unsigned* p = (volatile const unsigned*)((const unsigned char*)wl_[q] + o); (void)*p; } }
#endif
#ifdef TOUCH_PAGES
    { const size_t lo_ = WS_Y, hi_ = WS_END; for (size_t o = lo_ + ((size_t)blockIdx.x * 512 + F.tid) * 4096; o < hi_; o += (size_t)F.G * 512 * 4096) { volatile unsigned* p = (volatile unsigned*)(ws + o); (void)*p; }
      for (size_t o = ((size_t)blockIdx.x * 512 + F.tid) * 4096; o < (size_t)M * DM * 4; o += (size_t)F.G * 512 * 4096) { volatile unsigned* p = (volatile unsigned*)((unsigned char*)out + o); (void)*p; } }
#endif
    const P0Args p0a{x, norm1_g, w_in, sgu_w, w_out, norm2_g, w_gate, w_up, w_down, WinT, WoT, WguQ, WdQ, SW, XN};
    const bool late_in_p1 = (F.G == 256) && IN(0) && IN(1) && IN(4);
    REPS(0) if (IN(0)) { p0_prologue(F, p0a); if (!late_in_p1) { wset_convert(F, p0a, 1, F.vcu, F.G); wset_convert(F, p0a, 2, F.vcu, F.G); } if (BOTH(0)) GRID_BAR(); }

    STAMP();
    REPS(1) if (IN(1)) {
#ifdef LEAK_UNIT
        struct StampOrder : pg8::StaticOrder { volatile LAS unsigned long long* ts; __device__ __forceinline__ void done(const pg8::Unit&) const { if (blockIdx.x == 0 && threadIdx.x == 0) { const int n = (int)ts[0]; ts[1 + n] = __builtin_amdgcn_s_memrealtime(); ts[0] = n + 1; } } };
        pg8::Gemm g{XN, WinT, M, INW, DM}; StampOrder S; S.init(M, INW, F.G, (int)blockIdx.x); S.ts = (volatile LAS unsigned long long*)(F.lds + MISC_OFF + 64);
        pg8::EpiInProj E{PROJ, (const LAS float*)(F.lds + PAR_OFF), ksum};
        pg8::gemm_phase<pg8::EpiInProj, StampOrder, PG8_ALIGN, PG8_SP2>(F.lds + RING_OFF, g, S, E);
#else
        pg8::Gemm g{XN, WinT, M, INW, DM}; pg8::StaticOrder S; S.init(M, INW, F.G, (int)blockIdx.x);
        pg8::EpiInProj E{PROJ, (const LAS float*)(F.lds + PAR_OFF), ksum};
        pg8::gemm_phase<pg8::EpiInProj, pg8::StaticOrder, PG8_ALIGN, PG8_SP2>(F.lds + RING_OFF, g, S, E);
#endif
        if (late_in_p1 && blockIdx.x >= 128) wset_convert(F, p0a, 1, (int)blockIdx.x - 128, 128);
        if (BOTH(1)) GRID_BAR();
    }

    STAMP();
#if XPROBE == 12
    { GRID_BAR(); STAMP(); GRID_BAR(); STAMP(); }
#endif
#if XPROBE == 11
    { GRID_BAR(); STAMP(); }
#endif
#if XPROBE == 10
    { if (blockIdx.x >= 128) { float sacc = 0.f;
        for (int r = (int)blockIdx.x - 128; r < 416; r += 128) { const float* base = (const float*)(ws + WS_PROJ) + (size_t)r * 16384 + F.wave * 2048; f32x4 v[8];
#pragma unroll
            for (int i = 0; i < 8; ++i) v[i] = *(const GAS f32x4*)(base + 256 * i + 4 * F.lane);
#pragma unroll
            for (int i = 0; i < 8; ++i) sacc += v[i].x + v[i].y + v[i].z + v[i].w; }
        if (sacc == 123.456f) rowss[1] = sacc; }
      GRID_BAR(); STAMP(); }
#endif
#if XPROBE == 9
    { if (blockIdx.x >= 128) { float sacc = 0.f;
        for (int r = (int)blockIdx.x - 128; r < 416; r += 128) { const float* base = (r < 64 ? w_out + (size_t)r * 16384 : r < 240 ? w_gate + (size_t)(r - 64) * 16384 : w_up + (size_t)(r - 240) * 16384) + F.wave * 2048; f32x4 v[8];
#pragma unroll
            for (int i = 0; i < 8; ++i) v[i] = *(const GAS f32x4*)(base + 256 * i + 4 * F.lane);
#pragma unroll
            for (int i = 0; i < 8; ++i) sacc += v[i].x + v[i].y + v[i].z + v[i].w; }
        if (sacc == 123.456f) rowss[1] = sacc; }
      GRID_BAR(); STAMP(); }
#endif
#if XPROBE == 8
    { if (blockIdx.x >= 128) { float sacc = 0.f; const int cnt = wset_count(1);
        for (int r = (int)blockIdx.x - 128; r < cnt; r += 512) {
            f32x4 v[4][8];
#pragma unroll
            for (int q = 0; q < 4; ++q) if (r + 128 * q < cnt) { const WTile t = wset_tile(p0a, 1, r + 128 * q); wtile_load(t, F.wave, F.lane, v[q]); }
#pragma unroll
            for (int q = 0; q < 4; ++q) if (r + 128 * q < cnt) {
#pragma unroll
                for (int i = 0; i < 8; ++i) sacc += v[q][i].x + v[q][i].y + v[q][i].z + v[q][i].w; } }
        if (sacc == 123.456f) rowss[1] = sacc; }
      GRID_BAR(); STAMP(); }
#endif
#if XPROBE == 7
    { if (blockIdx.x >= 128) wset_convert(F, p0a, 1, (int)blockIdx.x - 128, 128); GRID_BAR(); STAMP(); }
#endif
#if XPROBE == 6
    { pg8::Gemm g{XN, WinT, M, INW, DM}; pg8::StaticOrder S; S.init(M, INW, F.G, (int)blockIdx.x);
      pg8::EpiInProj E{PROJ, (const LAS float*)(F.lds + PAR_OFF), ksum};
      pg8::gemm_phase<pg8::EpiInProj, pg8::StaticOrder, PG8_ALIGN, PG8_SP2>(F.lds + RING_OFF, g, S, E);
      GRID_BAR(); STAMP(); }
#endif
#if XPROBE == 3
    { pg8::Gemm g{XN, WinT, M, INW, DM}; pg8::StaticOrder S; S.init(M, INW, F.G, (int)blockIdx.x);
      pg8::EpiNull E{rowss};
      pg8::gemm_phase<pg8::EpiNull, pg8::StaticOrder, PG8_ALIGN, PG8_SP2>(F.lds + RING_OFF, g, S, E);
      GRID_BAR(); STAMP(); }
#endif
    REPS(2) if (IN(2)) {
        const SguArgs sa{PROJ, SW, sgu_b, ona_g, Yb};
        for (int u = F.vcu; u < BATCH * 16 * 4; u += F.G) sgu_unit(F, sa, u);
#ifdef STAMP_SGU
        STAMP();
#endif
        static_assert(attn_body::ATTN_LDS_BYTES <= RING_BYTES && attn_body::ATTN_PITCH == INW, "attention body geometry vs frame");
        const attn_body::AttnTensors AT{(const attn_body::bf16*)(PROJ + COL_Q), (const attn_body::bf16*)(PROJ + COL_K), (const attn_body::bf16*)(PROJ + COL_V), (attn_body::bf16*)(Yb + WA), ksum, onb_g};
        const attn_body::StaticOrder S((int)F.G, (int)blockIdx.x);
        attn_body::attn_phase<attn_body::StaticOrder>((char*)lds + RING_OFF, AT, S);
        if (BOTH(2)) GRID_BAR();
    }

    STAMP();
    REPS(3) if (IN(3)) {
        pg8::Gemm g{Yb, WoT, M, DM, DM}; pg8::StaticOrder S; S.init(M, DM, F.G, (int)blockIdx.x);
        pg8::EpiOutProj E{x, X1B, X1Q, rowss};
        if (F.G == 256) pg8::gemm_phase<pg8::EpiOutProj, pg8::StaticOrder, false, PG8_SP2>(F.lds + RING_OFF, g, S, E);
        if (BOTH(3)) GRID_BAR();
    }

    STAMP();
#if XPROBE == 13
    { GRID_BAR(); STAMP(); }
#endif
    REPS(4) if (IN(4)) {
        pg8::Gemm g{(const bf16*)X1Q, (const bf16*)WguQ, M, NGU, DM / 2}; pg8::StaticOrder S; S.init(M, NGU, F.G, (int)blockIdx.x);
        pg8::EpiGateUp E{HIDQ, rowss};
        pg8::gemm_phase<pg8::EpiGateUp, pg8::StaticOrder, PG8_ALIGN, PG8_SP2, true>(F.lds + RING_OFF, g, S, E);
        if (late_in_p1 && blockIdx.x >= 128) wset_convert(F, p0a, 2, (int)blockIdx.x - 128, 128);
        if (BOTH(4)) GRID_BAR();
    }

    STAMP();
#if XPROBE == 4 || XPROBE == 5
    for (int rp_ = 0; rp_ < (XPROBE == 5 ? 2 : 1); ++rp_)
    { pg8::Gemm g{XN, WinT, M, INW, DM}; pg8::StaticOrder S; S.init(M, INW, F.G, (int)blockIdx.x);
      pg8::EpiNull E{rowss};
      pg8::gemm_phase<pg8::EpiNull, pg8::StaticOrder, PG8_ALIGN, PG8_SP2>(F.lds + RING_OFF, g, S, E);
      GRID_BAR(); STAMP(); }
#endif
#if XPROBE == 1 || XPROBE == 2
    { constexpr int KX = (XPROBE == 1) ? DM : DM / 2;
      pg8::Gemm g{X1B, (const bf16*)WguQ, M, NGU, KX}; pg8::StaticOrder S; S.init(M, NGU, F.G, (int)blockIdx.x);
      pg8::EpiNull E{rowss};
      pg8::gemm_phase<pg8::EpiNull, pg8::StaticOrder, PG8_ALIGN, PG8_SP2>(F.lds + RING_OFF, g, S, E);
      GRID_BAR(); STAMP(); }
#endif
    REPS(5) if (IN(5)) {
        pg8::Gemm g{(const bf16*)HIDQ, (const bf16*)WdQ, M, DM, DFF / 2}; pg8::StaticOrder S; S.init(M, DM, F.G, (int)blockIdx.x);
        pg8::EpiDown E{X1B, out};
        pg8::gemm_phase<pg8::EpiDown, pg8::StaticOrder, PG8_ALIGN, PG8_SP2, true>(F.lds + RING_OFF, g, S, E);
    }
    STAMP();
#if LEAK_PHASE >= 0
    if (stamper_) { const int last = ns_ - 1; unsigned long long span = (LEAK_PHASE >= 9) ? (st_[last] - st_[0]) : (st_[LEAK_PHASE + 1] - st_[LEAK_PHASE]); const unsigned long long t0 = st_[last];
#ifdef LEAK_CLOCK
        span = (sc_[LEAK_PHASE + 1] - sc_[LEAK_PHASE]) / 16 / LEAK_MULT;
#endif
#ifdef LEAK_UNIT
        { volatile LAS unsigned long long* ts = (volatile LAS unsigned long long*)(F.lds + MISC_OFF + 64); span = (LEAK_UNIT == 0) ? (ts[1] - st_[1]) : (ts[1 + LEAK_UNIT] - ts[LEAK_UNIT]); }
#endif
        while (__builtin_amdgcn_s_memrealtime() - t0 < LEAK_MULT * span) __builtin_amdgcn_s_sleep(8); }
#endif
    if (one_launch) { asm volatile("s_waitcnt vmcnt(0)" ::: "memory"); __syncthreads();
        if (F.tid == 0) { const unsigned old = __hip_atomic_fetch_add(F.ctl + CW_EXIT, 1u, RLX_AGENT); if (old == (unsigned)F.G - 1u) __hip_atomic_store(F.ctl + CW_START, 0u, RLX_AGENT); } }
#undef IN
#undef BOTH
#undef GRID_BAR
}


#ifndef NAIVE_MASK
#define NAIVE_MASK 0
#endif
#if NAIVE_MASK
namespace naive {
typedef unsigned short bf16_t;
typedef float f32x4 __attribute__((ext_vector_type(4)));
typedef unsigned u32x4 __attribute__((ext_vector_type(4)));
__device__ __forceinline__ unsigned f2bf(float f) { unsigned u = __builtin_bit_cast(unsigned, f); return (u + 0x7fffu + ((u >> 16) & 1u)) >> 16; }
__device__ __forceinline__ float bf2f(bf16_t b) { return __builtin_bit_cast(float, (unsigned)b << 16); }
__device__ __forceinline__ float wave_sum(float v) {
#pragma unroll
    for (int o = 1; o < 64; o <<= 1) v += __shfl_xor(v, o);
    return v;
}
__device__ __forceinline__ float wave_max(float v) {
#pragma unroll
    for (int o = 1; o < 64; o <<= 1) v = fmaxf(v, __shfl_xor(v, o));
    return v;
}
__device__ __forceinline__ float gelu_tanh(float x) {
    const float z = 0.7978845608028654f * (x + 0.044715f * x * x * x);
    return x / (1.0f + __expf(-2.0f * z));
}
__device__ __forceinline__ float silu(float x) { return x / (1.0f + __expf(-x)); }

__global__ void k_rmsnorm_x(const float* __restrict__ x, const float* __restrict__ g, bf16_t* __restrict__ xn) {
    const int row = blockIdx.x * 4 + (threadIdx.x >> 6), lane = threadIdx.x & 63;
    const float* xr = x + (size_t)row * DM;
    float v[16]; float s = 0.f;
#pragma unroll
    for (int j = 0; j < 16; ++j) { v[j] = xr[lane + 64 * j]; s += v[j] * v[j]; }
    const float rstd = 1.0f / sqrtf(wave_sum(s) * (1.0f / DM) + EPS);
#pragma unroll
    for (int j = 0; j < 16; ++j) xn[(size_t)row * DM + lane + 64 * j] = (bf16_t)f2bf(v[j] * rstd * g[lane + 64 * j]);
}
__global__ void k_transpose_w(const float* __restrict__ W, int K, int N, const float* __restrict__ g, bf16_t* __restrict__ WT) {
    const size_t i = (size_t)blockIdx.x * 256 + threadIdx.x; if (i >= (size_t)K * N) return;
    const int n = (int)(i / K), k = (int)(i % K);
    WT[i] = (bf16_t)f2bf(W[(size_t)k * N + n] * (g ? g[k] : 1.0f));
}
__global__ void k_transpose_gu(const float* __restrict__ Wg, const float* __restrict__ Wu, const float* __restrict__ g, bf16_t* __restrict__ WT) {
    const size_t i = (size_t)blockIdx.x * 256 + threadIdx.x; if (i >= (size_t)2 * DFF * DM) return;
    const int r = (int)(i / DM), k = (int)(i % DM);
    const int blk = r / 256, w = r % 256, j = blk * 128 + (w & 127);
    const float* W = (w < 128) ? Wg : Wu;
    WT[i] = (bf16_t)f2bf(W[(size_t)k * DFF + j] * g[k]);
}
__global__ void k_sgu_w(const float* __restrict__ w, bf16_t* __restrict__ sw) {
    const int i = blockIdx.x * 256 + threadIdx.x; if (i >= NH * CHUNK * CHUNK) return;
    const int t = (i / CHUNK) % CHUNK, s = i % CHUNK;
    sw[i] = (bf16_t)f2bf(s <= t ? w[i] : 0.0f);
}

__device__ __forceinline__ void naive_tile(const bf16_t* __restrict__ A, int lda, const bf16_t* __restrict__ B, int ldb, int K, float (&acc)[4][4], float* As, float* Bs) {
    const int tid = threadIdx.x, ty = tid >> 4, tx = tid & 15;
    const int lr = tid >> 2, lk = (tid & 3) * 8;
#pragma unroll
    for (int i = 0; i < 4; ++i)
#pragma unroll
        for (int j = 0; j < 4; ++j) acc[i][j] = 0.f;
    for (int k0 = 0; k0 < K; k0 += 32) {
        const u32x4 av = *(const u32x4*)(A + (size_t)lr * lda + k0 + lk);
        const u32x4 bv = *(const u32x4*)(B + (size_t)lr * ldb + k0 + lk);
        __syncthreads();
#pragma unroll
        for (int e = 0; e < 4; ++e) {
            As[(lk + 2 * e) * 65 + lr] = __builtin_bit_cast(float, av[e] << 16);
            As[(lk + 2 * e + 1) * 65 + lr] = __builtin_bit_cast(float, av[e] & 0xffff0000u);
            Bs[(lk + 2 * e) * 65 + lr] = __builtin_bit_cast(float, bv[e] << 16);
            Bs[(lk + 2 * e + 1) * 65 + lr] = __builtin_bit_cast(float, bv[e] & 0xffff0000u);
        }
        __syncthreads();
#pragma unroll 8
        for (int kk = 0; kk < 32; ++kk) {
            float a[4], b[4];
#pragma unroll
            for (int i = 0; i < 4; ++i) { a[i] = As[kk * 65 + ty * 4 + i]; b[i] = Bs[kk * 65 + tx * 4 + i]; }
#pragma unroll
            for (int i = 0; i < 4; ++i)
#pragma unroll
                for (int j = 0; j < 4; ++j) acc[i][j] += a[i] * b[j];
        }
    }
}

__global__ void __launch_bounds__(256) k_inproj(const bf16_t* __restrict__ XN, const bf16_t* __restrict__ WinT, bf16_t* __restrict__ PROJ,
                                               const float* __restrict__ ln_g, const float* __restrict__ ln_b, const float* __restrict__ q_g, const float* __restrict__ k_g) {
    __shared__ float As[32 * 65], Bs[32 * 65], T[64 * 65];
    const int rb = blockIdx.x, cb = blockIdx.y;
    float acc[4][4];
    naive_tile(XN + (size_t)rb * 64 * DM, DM, WinT + (size_t)cb * 64 * DM, DM, DM, acc, As, Bs);
    const int tid = threadIdx.x, ty = tid >> 4, tx = tid & 15;
#pragma unroll
    for (int i = 0; i < 4; ++i)
#pragma unroll
        for (int j = 0; j < 4; ++j) T[(ty * 4 + i) * 65 + tx * 4 + j] = acc[i][j];
    __syncthreads();
    if (tid < 64) {
        const int seg = cb >> 3, h = cb & 7; const float* t = T + tid * 65;
        bf16_t* o = PROJ + (size_t)(rb * 64 + tid) * INW + cb * 64;
        if (seg == 0) { for (int d = 0; d < 64; ++d) o[d] = (bf16_t)f2bf(gelu_tanh(t[d])); }
        else if (seg == 1) {
            float mu = 0.f; for (int d = 0; d < 64; ++d) mu += gelu_tanh(t[d]); mu *= (1.0f / 64);
            float var = 0.f; for (int d = 0; d < 64; ++d) { const float c = gelu_tanh(t[d]) - mu; var += c * c; } var *= (1.0f / 64);
            const float rs = 1.0f / sqrtf(var + EPS);
            for (int d = 0; d < 64; ++d) o[d] = (bf16_t)f2bf((gelu_tanh(t[d]) - mu) * rs * ln_g[h * 64 + d] + ln_b[h * 64 + d]);
        } else if (seg == 2 || seg == 3) {
            float ss = 0.f; for (int d = 0; d < 64; ++d) ss += t[d] * t[d];
            const float rs = 1.0f / sqrtf(ss * (1.0f / 64) + EPS);
            const float* g = (seg == 2) ? q_g : k_g; const float sc = (seg == 2) ? C2 : 1.0f;
            for (int d = 0; d < 64; ++d) o[d] = (bf16_t)f2bf(t[d] * rs * g[d] * sc);
        } else { for (int d = 0; d < 64; ++d) o[d] = (bf16_t)f2bf(t[d]); }
    }
}
__global__ void k_kmean(const bf16_t* __restrict__ PROJ, float* __restrict__ kmean) {
    const int i = blockIdx.x * 256 + threadIdx.x;
    const int d = i & 63, h = (i >> 6) & 7, n = (i >> 9) & 7, b = i >> 12;
    float s = 0.f;
    for (int r = 0; r < MBLK; ++r) s += bf2f(PROJ[(size_t)(b * SEQ + n * MBLK + r) * INW + COL_K + h * 64 + d]);
    kmean[i] = s * (1.0f / MBLK);
}
__global__ void __launch_bounds__(256) k_sgu(const bf16_t* __restrict__ PROJ, const bf16_t* __restrict__ SW, const float* __restrict__ sgu_b, const float* __restrict__ ona_g, bf16_t* __restrict__ Y) {
    const int gw = blockIdx.x * 4 + (threadIdx.x >> 6), lane = threadIdx.x & 63;
    const int token = gw >> 3, h = gw & 7, t = token & (CHUNK - 1), c0 = token - t;
    const bf16_t* w = SW + ((size_t)h * CHUNK + t) * CHUNK;
    float mixed = 0.f;
    for (int s = 0; s <= t; ++s) mixed += bf2f(w[s]) * bf2f(PROJ[(size_t)(c0 + s) * INW + COL_VA + h * 64 + lane]);
    mixed += sgu_b[h * CHUNK + t];
    const float y = bf2f(PROJ[(size_t)token * INW + COL_U + h * 64 + lane]) * mixed;
    const float rs = 1.0f / sqrtf(wave_sum(y * y) * (1.0f / 64) + EPS);
    Y[(size_t)token * DM + h * 64 + lane] = (bf16_t)f2bf(y * rs * ona_g[h * 64 + lane]);
}
__global__ void __launch_bounds__(256) k_moba(const bf16_t* __restrict__ PROJ, const float* __restrict__ kmean, const float* __restrict__ onb_g, bf16_t* __restrict__ Y) {
    __shared__ float qs[4][64], ps[4][64];
    const int wid = threadIdx.x >> 6, lane = threadIdx.x & 63;
    const int gw = blockIdx.x * 4 + wid;
    const int token = gw >> 3, h = gw & 7, b = token / SEQ, s = token % SEQ, j = s / MBLK;
    const float qv = bf2f(PROJ[(size_t)token * INW + COL_Q + h * 64 + lane]);
    qs[wid][lane] = qv;
    float gate[7];
#pragma unroll
    for (int n = 0; n < 7; ++n) gate[n] = (n < j) ? wave_sum(qv * kmean[((b * NBLK + n) * NH + h) * 64 + lane]) : -INFINITY;
    unsigned sel = 0;
#pragma unroll
    for (int n = 0; n < 7; ++n) {
        int rank = 0;
#pragma unroll
        for (int m = 0; m < 7; ++m) if (m != n && m < j) rank += (gate[m] > gate[n] || (gate[m] == gate[n] && m < n)) ? 1 : 0;
        if (n < j && rank < 3) sel |= 1u << n;
    }
    __syncthreads();
    float mrun = -INFINITY, l = 0.f, o = 0.f;
    for (int n = 0; n <= j; ++n) {
        if (n < j && !((sel >> n) & 1u)) continue;
        for (int kt = 0; kt < 4; ++kt) {
            const int key0 = n * MBLK + kt * 64;
            if (n == j && key0 > s) break;
            const int key = key0 + lane;
            const bf16_t* kr = PROJ + (size_t)(b * SEQ + key) * INW + COL_K + h * 64;
            float sc = 0.f;
            for (int d = 0; d < 64; ++d) sc += qs[wid][d] * bf2f(kr[d]);
            if (key > s) sc = -INFINITY;
            const float mnew = fmaxf(mrun, wave_max(sc));
            const float alpha = exp2f(mrun - mnew);
            const float p = exp2f(sc - mnew);
            l = l * alpha + wave_sum(p);
            ps[wid][lane] = p;
            __builtin_amdgcn_s_waitcnt(0xC07F);
            o *= alpha;
            const bf16_t* vr = PROJ + (size_t)(b * SEQ + key0) * INW + COL_V + h * 64 + lane;
            for (int kk = 0; kk < 64; ++kk) o += ps[wid][kk] * bf2f(vr[(size_t)kk * INW]);
            mrun = mnew;
        }
    }
    o /= l;
    const float rs = 1.0f / sqrtf(wave_sum(o * o) * (1.0f / 64) + EPS);
    Y[(size_t)token * DM + WA + h * 64 + lane] = (bf16_t)f2bf(o * rs * onb_g[h * 64 + lane]);
}
__global__ void __launch_bounds__(256) k_outproj(const bf16_t* __restrict__ Yb, const bf16_t* __restrict__ WoT, const float* __restrict__ x, float* __restrict__ x1, bf16_t* __restrict__ x1b) {
    __shared__ float As[32 * 65], Bs[32 * 65];
    const int rb = blockIdx.x, cb = blockIdx.y;
    float acc[4][4];
    naive_tile(Yb + (size_t)rb * 64 * DM, DM, WoT + (size_t)cb * 64 * DM, DM, DM, acc, As, Bs);
    const int tid = threadIdx.x, ty = tid >> 4, tx = tid & 15;
#pragma unroll
    for (int i = 0; i < 4; ++i)
#pragma unroll
        for (int j = 0; j < 4; ++j) { const size_t off = (size_t)(rb * 64 + ty * 4 + i) * DM + cb * 64 + tx * 4 + j; const float v = x[off] + acc[i][j]; x1[off] = v; x1b[off] = (bf16_t)f2bf(v); }
}
__global__ void k_rowss(const float* __restrict__ x1, float* __restrict__ rowss) {
    const int row = blockIdx.x * 4 + (threadIdx.x >> 6), lane = threadIdx.x & 63;
    float s = 0.f;
    for (int j = 0; j < 16; ++j) { const float v = x1[(size_t)row * DM + lane + 64 * j]; s += v * v; }
    s = wave_sum(s);
    if (lane < 4) rowss[row * 4 + lane] = (lane == 0) ? s : 0.f;
}
__global__ void __launch_bounds__(256) k_gateup(const bf16_t* __restrict__ X1B, const bf16_t* __restrict__ WguT, const float* __restrict__ rowss, bf16_t* __restrict__ HID) {
    __shared__ float As[32 * 65], Bs[32 * 65];
    const int rb = blockIdx.x, cb = blockIdx.y;
    const int j0 = cb * 64, grow = (j0 / 128) * 256 + (j0 % 128);
    float ag[4][4], au[4][4];
    naive_tile(X1B + (size_t)rb * 64 * DM, DM, WguT + (size_t)grow * DM, DM, DM, ag, As, Bs);
    naive_tile(X1B + (size_t)rb * 64 * DM, DM, WguT + (size_t)(grow + 128) * DM, DM, DM, au, As, Bs);
    const int tid = threadIdx.x, ty = tid >> 4, tx = tid & 15;
#pragma unroll
    for (int i = 0; i < 4; ++i) {
        const int row = rb * 64 + ty * 4 + i;
        const float ss = (rowss[row * 4] + rowss[row * 4 + 1]) + (rowss[row * 4 + 2] + rowss[row * 4 + 3]);
        const float rs = 1.0f / sqrtf(ss * (1.0f / DM) + EPS);
#pragma unroll
        for (int j = 0; j < 4; ++j) HID[(size_t)row * DFF + j0 + tx * 4 + j] = (bf16_t)f2bf(silu(ag[i][j] * rs) * (au[i][j] * rs));
    }
}
__global__ void __launch_bounds__(256) k_down(const bf16_t* __restrict__ HID, const bf16_t* __restrict__ WdT, float* __restrict__ out) {
    __shared__ float As[32 * 65], Bs[32 * 65];
    const int rb = blockIdx.x, cb = blockIdx.y;
    float acc[4][4];
    naive_tile(HID + (size_t)rb * 64 * DFF, DFF, WdT + (size_t)cb * 64 * DFF, DFF, DFF, acc, As, Bs);
    const int tid = threadIdx.x, ty = tid >> 4, tx = tid & 15;
#pragma unroll
    for (int i = 0; i < 4; ++i)
#pragma unroll
        for (int j = 0; j < 4; ++j) { const size_t off = (size_t)(rb * 64 + ty * 4 + i) * DM + cb * 64 + tx * 4 + j; out[off] = out[off] + acc[i][j]; }
}


}
#endif

extern "C" void kernel_launch(void* const* d_in, const int* in_sizes, int n_in, void* d_out, int out_size, void* d_ws, size_t ws_size, hipStream_t stream) {
    static int grid = 0;
    if (grid == 0) {
        if (n_in != 16 || in_sizes[0] != M * DM || out_size != M * DM || ws_size < WS_END) { fprintf(stderr, "kernel_launch: built for 16 inputs, x and out of %d floats, >= %zu bytes of workspace; got n_in %d, in0 %d, out %d, ws %zu; nothing launched\n", M * DM, (size_t)WS_END, n_in, n_in > 0 ? in_sizes[0] : -1, out_size, ws_size); grid = -1; return; }
        int dev = 0, cus = 0, per_cu = 0;
        if (hipGetDevice(&dev) != hipSuccess || hipDeviceGetAttribute(&cus, hipDeviceAttributeMultiprocessorCount, dev) != hipSuccess) { fprintf(stderr, "kernel_launch: hipGetDevice / hipDeviceGetAttribute failed; nothing launched\n"); grid = -1; return; }
        if (hipFuncSetAttribute((const void*)mega_fwd, hipFuncAttributeMaxDynamicSharedMemorySize, LDS_BYTES) != hipSuccess) { fprintf(stderr, "kernel_launch: hipFuncSetAttribute failed\n"); grid = -1; return; }
        if (hipOccupancyMaxActiveBlocksPerMultiprocessor(&per_cu, (const void*)mega_fwd, NWAVES * 64, LDS_BYTES) != hipSuccess || per_cu < 1) { fprintf(stderr, "kernel_launch: occupancy query reports %d workgroups per CU; nothing launched\n", per_cu); (void)hipGetLastError(); grid = -1; return; }
        grid = cus;
        if (grid != 256) fprintf(stderr, "kernel_launch: %d CUs; the out-proj phase needs exactly 256 workgroups\n", grid);
    }
    if (grid < 0) return;
#if MK_N_LAUNCHES != 1
    (void)hipMemsetAsync((char*)d_ws + WS_CTL, 0, 65536, stream);
#endif
    Args a{};
    for (int i = 0; i < 16; ++i) a.in[i] = (const float*)d_in[i];
    a.out = (float*)d_out; a.ws = (unsigned char*)d_ws;
    for (int li = 0; li < MK_N_LAUNCHES; ++li) {
        a.ph_lo = (MK_N_LAUNCHES == PER_PHASE) ? li : 0; a.ph_hi = (MK_N_LAUNCHES == PER_PHASE) ? li + 1 : PER_PHASE;
#if NAIVE_MASK
        if (MK_N_LAUNCHES == PER_PHASE && ((NAIVE_MASK >> li) & 1)) {
            using namespace naive; unsigned char* ws = (unsigned char*)d_ws; float* out = (float*)d_out; const float* const* in = (const float* const*)d_in;
            bf16_t* WinT = (bf16_t*)(ws + WS_WIN); bf16_t* WoT = (bf16_t*)(ws + WS_WO); bf16_t* WguT = (bf16_t*)(ws + WS_WGU); bf16_t* WdT = (bf16_t*)(ws + WS_WD); bf16_t* SW = (bf16_t*)(ws + WS_SW);
            float* kmean = (float*)(ws + WS_KSUM); float* rowss = (float*)(ws + WS_ROWSS); bf16_t* XN = (bf16_t*)(ws + WS_XN); bf16_t* Yb = (bf16_t*)(ws + WS_Y); bf16_t* PROJ = (bf16_t*)(ws + WS_PROJ); bf16_t* HID = PROJ; bf16_t* X1B = XN;
            if (li == 0) { k_rmsnorm_x<<<M / 4, 256, 0, stream>>>(in[0], in[1], XN); k_transpose_w<<<(DM * INW + 255) / 256, 256, 0, stream>>>(in[2], DM, INW, nullptr, WinT); k_transpose_w<<<(DM * DM + 255) / 256, 256, 0, stream>>>(in[11], DM, DM, nullptr, WoT);
                k_transpose_gu<<<(2 * DFF * DM + 255) / 256, 256, 0, stream>>>(in[13], in[14], in[12], WguT); k_transpose_w<<<(DFF * DM + 255) / 256, 256, 0, stream>>>(in[15], DFF, DM, nullptr, WdT); k_sgu_w<<<(NH * CHUNK * CHUNK + 255) / 256, 256, 0, stream>>>(in[5], SW); }
            if (li == 1) { k_inproj<<<dim3(M / 64, INW / 64), 256, 0, stream>>>(XN, WinT, PROJ, in[3], in[4], in[7], in[8]); k_kmean<<<BATCH * NBLK * NH * 64 / 256, 256, 0, stream>>>(PROJ, kmean); }
            if (li == 2) { k_sgu<<<M * NH / 4, 256, 0, stream>>>(PROJ, SW, in[6], in[9], Yb); k_moba<<<M * NH / 4, 256, 0, stream>>>(PROJ, kmean, in[10], Yb); }
            if (li == 3) { k_outproj<<<dim3(M / 64, DM / 64), 256, 0, stream>>>(Yb, WoT, in[0], out, X1B); k_rowss<<<M / 4, 256, 0, stream>>>(out, rowss); }
            if (li == 4) k_gateup<<<dim3(M / 64, DFF / 64), 256, 0, stream>>>(X1B, WguT, rowss, HID);
            if (li == 5) k_down<<<dim3(M / 64, DM / 64), 256, 0, stream>>>(HID, WdT, out);
            continue;
        }
#endif
        hipLaunchKernelGGL(mega_fwd, dim3(grid), dim3(NWAVES * 64), LDS_BYTES, stream, a);
        const hipError_t le = hipPeekAtLastError();
        if (le != hipSuccess) { fprintf(stderr, "kernel_launch: launch %d failed: %s (grid %d x %d threads, %d B LDS)\n", li, hipGetErrorName(le), grid, NWAVES * 64, LDS_BYTES); break; }
    }
}
```

```cpp
#include <hip/hip_runtime.h>
#include <hip/hip_bf16.h>
#include <cstdio>
#include <cstdint>
#include <cmath>

constexpr int BATCH = 8, SEQ = 2048, DM = 1024, M = BATCH * SEQ;
constexpr int NH = 8, HD = 64, WA = 512, INW = 2560, CHUNK = 128, MBLK = 256, NBLK = SEQ / MBLK, DFF = 2816, NGU = 2 * DFF;
constexpr float EPS = 1e-6f;
constexpr float WGU_SCALE = 32.0f, WD_SCALE = 64.0f;
constexpr float C2 = 0.125f * 1.4426950408889634f;
constexpr int COL_U = 0, COL_VA = 512, COL_Q = 1024, COL_K = 1536, COL_V = 2048;

constexpr size_t MiB = 1u << 20;
constexpr size_t WS_CTL = 0;
constexpr size_t WS_KSUM = 512 * 1024;
constexpr size_t WS_WIN = 1 * MiB;
constexpr size_t WS_WO = 6 * MiB;
constexpr size_t WS_WGU = 8 * MiB;
constexpr size_t WS_WD = 19 * MiB;
constexpr size_t WS_SW = 25 * MiB;
constexpr size_t WS_ROWSS = 26 * MiB;
constexpr size_t WS_RSTD1 = 27 * MiB;
constexpr size_t WS_XN = 32 * MiB;
constexpr size_t WS_X1B = 200 * MiB;
constexpr size_t WS_Y = 64 * MiB;
constexpr size_t WS_PROJ = 96 * MiB;
constexpr size_t WS_X1Q = 184 * MiB;
constexpr size_t WS_END = 232 * MiB;

namespace pg8 {
#define PG8_LAS __attribute__((address_space(3)))
typedef unsigned short bf16_t;
typedef short bf16x8 __attribute__((ext_vector_type(8)));
typedef float f32x4 __attribute__((ext_vector_type(4)));
typedef unsigned u32x4 __attribute__((ext_vector_type(4)));
typedef int v4i_t __attribute__((ext_vector_type(4)));
typedef unsigned u32x2 __attribute__((ext_vector_type(2)));
constexpr int BM = 256, BK = 64, HALF = 128, HTB = HALF * BK * 2  , STAGE_BYTES = 8 * HTB, NXCD = 8, WGM = 8;

__host__ __device__ __forceinline__ int lds_byte(int r, int c) { const int st = (r >> 4) * 2 + (c >> 5), rr = r & 15, cc = c & 31, ob = rr * 64 + cc * 2; return st * 1024 + (ob ^ (((ob >> 9) & 1) << 5)); }
__host__ __device__ __forceinline__ void stage_rc(int b, int& R, int& C) { const int st = b / 1024, sb = b % 1024, swz = sb ^ (((sb >> 9) & 1) << 5); R = (st >> 1) * 16 + swz / 64; C = (st & 1) * 32 + (swz % 64) / 2; }
__host__ __device__ __forceinline__ int perm32(int rho) { const int n = rho >> 4, i = rho & 15; return 8 * (i >> 2) + 4 * n + (i & 3); }

struct Unit { int pm, pn; };
struct Gemm { const bf16_t* A; const bf16_t* Bt; int M, N, K; };

struct StaticOrder {
    int nM, nN, nwg, G, c;
    __host__ __device__ void init(int M, int N, int G_, int c_) { nM = M / BM; nN = N / BM; nwg = nM * nN; G = G_; c = c_; }
    __host__ __device__ bool next(int i, Unit& u) const {
        const long L = (long)i * G + c; if (L >= nwg) return false;
        int wgid = (int)L; { const int q = nwg / NXCD, r = nwg % NXCD, xcd = wgid % NXCD, off = wgid / NXCD; wgid = (xcd < r ? xcd * (q + 1) : r * (q + 1) + (xcd - r) * q) + off; }
        const int nig = WGM * nN, gid = wgid / nig, fm = gid * WGM, gsz = (nM - fm) < WGM ? (nM - fm) : WGM;
        u.pm = fm + ((wgid % nig) % gsz); u.pn = (wgid % nig) / gsz; return true;
    }
    __device__ __forceinline__ void a_ready(const Unit&) const {}
    __device__ __forceinline__ void done(const Unit&) const {}
};

struct RowScalePrefetch {
    const float* src; PG8_LAS float* slots; float mul; mutable float pend = 0.f; mutable int nready = 0, ndone = 0, have = 0;
    template <int MODE> __device__ __forceinline__ void fetch(const Unit& u) const {
        int t = threadIdx.x; asm volatile("" : "+v"(t));
        if (t < 256) { const int row = u.pm * BM + t;
            if (MODE == 0) pend = src[row]; else { const f32x4 r4 = *(const f32x4*)(src + (size_t)row * 4); pend = __builtin_amdgcn_rsqf(((r4[0] + r4[1]) + (r4[2] + r4[3])) * (1.0f / 1024.0f) + 1e-6f) * mul; }
            if (nready == 0) slots[t] = pend; }
        have = (nready != 0); ++nready;
    }
    __device__ __forceinline__ void flush() const {
        if (have) { int t = threadIdx.x; asm volatile("" : "+v"(t)); if (t < 256) slots[((ndone + 1) & 1) * 256 + t] = pend; have = 0; }
    }
    __device__ __forceinline__ const PG8_LAS float* cur() const { return slots + (ndone & 1) * 256; }
};
__device__ __forceinline__ unsigned cvt_pk_bf16(float lo, float hi) { unsigned r; asm volatile("v_cvt_pk_bf16_f32 %0, %1, %2" : "=v"(r) : "v"(lo), "v"(hi)); return r; }
__device__ __forceinline__ float gelu_tanh_f(float x) {
    const float t = x * (-2.3022082f + -0.10294324f * (x * x));
    return x * __builtin_amdgcn_rcpf(1.0f + __builtin_amdgcn_exp2f(t));
}
__device__ __forceinline__ float silu_f(float x) { return x * __builtin_amdgcn_rcpf(1.0f + __builtin_amdgcn_exp2f(-1.4426950408889634f * x)); }
__device__ __forceinline__ float hsum4(const f32x4 v) { return (v[0] + v[1]) + (v[2] + v[3]); }
__device__ __forceinline__ float hsq4(const f32x4 v) { return (v[0] * v[0] + v[1] * v[1]) + (v[2] * v[2] + v[3] * v[3]); }
__device__ __forceinline__ float quad_sum(float s) {
    auto a = __builtin_amdgcn_permlane16_swap(__float_as_uint(s), __float_as_uint(s), false, false); s = __uint_as_float(a[0]) + __uint_as_float(a[1]);
    auto b = __builtin_amdgcn_permlane32_swap(__float_as_uint(s), __float_as_uint(s), false, false); return __uint_as_float(b[0]) + __uint_as_float(b[1]); }
__device__ __forceinline__ u32x2 pack8_f8(const f32x4 a, const f32x4 b) {
    int lo = __builtin_amdgcn_cvt_pk_fp8_f32(a[0], a[1], 0, false); lo = __builtin_amdgcn_cvt_pk_fp8_f32(a[2], a[3], lo, true);
    int hi = __builtin_amdgcn_cvt_pk_fp8_f32(b[0], b[1], 0, false); hi = __builtin_amdgcn_cvt_pk_fp8_f32(b[2], b[3], hi, true);
    u32x2 w; w.x = (unsigned)lo; w.y = (unsigned)hi; return w; }
__device__ __forceinline__ u32x4 pack8(const f32x4 a, const f32x4 b) { u32x4 w; w.x = cvt_pk_bf16(a[0], a[1]); w.y = cvt_pk_bf16(a[2], a[3]); w.z = cvt_pk_bf16(b[0], b[1]); w.w = cvt_pk_bf16(b[2], b[3]); return w; }

struct EpiInProj {
    static constexpr bool PERM = true, AFTER_DRAIN = false; static constexpr int BMAP = 1;
    bf16_t* P; const PG8_LAS float* par; float* ksum; RowScalePrefetch rp;
    __device__ __forceinline__ void operator()(const f32x4 (&acc)[2][2][4][2], const Unit& u, int wr, int wc, int fr, int fq) const {
        asm volatile("" : "+v"(fr), "+v"(fq));
        const int seg = u.pn >> 1, h = (u.pn & 1) * 4 + wc, dl = 8 * fq;
        bf16_t* base = P + (size_t)(u.pm * BM + wr * 64 + fr) * INW + u.pn * BM + wc * 64 + dl;
        float rs1[2][4];
#pragma unroll
        for (int ai = 0; ai < 2; ++ai)
#pragma unroll
            for (int m = 0; m < 4; ++m) rs1[ai][m] = rp.cur()[wr * 64 + fr + ai * HALF + m * 16];
        rp.flush(); ++rp.ndone;
        if (seg == 0) {
#pragma unroll
            for (int ai = 0; ai < 2; ++ai)
#pragma unroll
                for (int m = 0; m < 4; ++m)
#pragma unroll
                    for (int bj = 0; bj < 2; ++bj) { f32x4 a = acc[ai][bj][m][0] * rs1[ai][m], b = acc[ai][bj][m][1] * rs1[ai][m];
#pragma unroll
                        for (int e = 0; e < 4; ++e) { a[e] = gelu_tanh_f(a[e]); b[e] = gelu_tanh_f(b[e]); }
                        *(u32x4*)(base + (size_t)(ai * HALF + m * 16) * INW + 32 * bj) = pack8(a, b); }
        } else if (seg == 1) {
            const PG8_LAS float* lg = par + h * 64 + dl; const PG8_LAS float* lb = par + 512 + h * 64 + dl;
#pragma unroll
            for (int ai = 0; ai < 2; ++ai)
#pragma unroll
                for (int m = 0; m < 4; ++m) { f32x4 g[2][2]; float s = 0.f;
#pragma unroll
                    for (int bj = 0; bj < 2; ++bj)
#pragma unroll
                        for (int n = 0; n < 2; ++n) { const f32x4 a = acc[ai][bj][m][n] * rs1[ai][m];
#pragma unroll
                            for (int e = 0; e < 4; ++e) g[bj][n][e] = gelu_tanh_f(a[e]);
                            s += hsum4(g[bj][n]); }
                    const float mean = quad_sum(s) * (1.0f / 64.0f); float q = 0.f;
#pragma unroll
                    for (int bj = 0; bj < 2; ++bj)
#pragma unroll
                        for (int n = 0; n < 2; ++n) { g[bj][n] = g[bj][n] - mean; q += hsq4(g[bj][n]); }
                    const float rstd = __builtin_amdgcn_rsqf(quad_sum(q) * (1.0f / 64.0f) + EPS);
#pragma unroll
                    for (int bj = 0; bj < 2; ++bj) { const f32x4 G0 = *(const PG8_LAS f32x4*)(lg + 32 * bj), G1 = *(const PG8_LAS f32x4*)(lg + 32 * bj + 4), B0 = *(const PG8_LAS f32x4*)(lb + 32 * bj), B1 = *(const PG8_LAS f32x4*)(lb + 32 * bj + 4);
                        *(u32x4*)(base + (size_t)(ai * HALF + m * 16) * INW + 32 * bj) = pack8(g[bj][0] * rstd * G0 + B0, g[bj][1] * rstd * G1 + B1); }
                    asm volatile("" ::: "memory"); __builtin_amdgcn_sched_barrier(0); }
        } else if (seg == 2 || seg == 3) {
            const PG8_LAS float* gp = par + ((seg == 2) ? 1024 : 1088) + dl;
            f32x4 cs[2][2];
#pragma unroll
            for (int bj = 0; bj < 2; ++bj)
#pragma unroll
                for (int n = 0; n < 2; ++n) cs[bj][n] = (f32x4){0.f, 0.f, 0.f, 0.f};
#pragma unroll
            for (int ai = 0; ai < 2; ++ai)
#pragma unroll
                for (int m = 0; m < 4; ++m) { float q = 0.f;
#pragma unroll
                    for (int bj = 0; bj < 2; ++bj)
#pragma unroll
                        for (int n = 0; n < 2; ++n) q += hsq4(acc[ai][bj][m][n]);
                    const float rstd = rs1[ai][m] * __builtin_amdgcn_rsqf(quad_sum(q) * (1.0f / 64.0f) * (rs1[ai][m] * rs1[ai][m]) + EPS);
#pragma unroll
                    for (int bj = 0; bj < 2; ++bj) { const f32x4 o0 = acc[ai][bj][m][0] * rstd * *(const PG8_LAS f32x4*)(gp + 32 * bj), o1 = acc[ai][bj][m][1] * rstd * *(const PG8_LAS f32x4*)(gp + 32 * bj + 4);
                        cs[bj][0] += o0; cs[bj][1] += o1;
                        *(u32x4*)(base + (size_t)(ai * HALF + m * 16) * INW + 32 * bj) = pack8(o0, o1); }
                    asm volatile("" : "+v"(cs[0][0]), "+v"(cs[0][1]), "+v"(cs[1][0]), "+v"(cs[1][1]));
                    asm volatile("" ::: "memory"); __builtin_amdgcn_sched_barrier(0); }
            if (seg == 3) {
#pragma unroll
                for (int bj = 0; bj < 2; ++bj)
#pragma unroll
                    for (int n = 0; n < 2; ++n) { f32x4 v = cs[bj][n];
#pragma unroll
                        for (int e = 0; e < 4; ++e) { float t = v[e]; t += __shfl_xor(t, 1); t += __shfl_xor(t, 2); t += __shfl_xor(t, 4); t += __shfl_xor(t, 8); v[e] = t; }
                        if (fr == 0) *(f32x4*)(ksum + (((size_t)u.pm * 2 + wr) * NH + h) * 64 + 32 * bj + dl + 4 * n) = v; }
            }
        } else {
#pragma unroll
            for (int ai = 0; ai < 2; ++ai)
#pragma unroll
                for (int m = 0; m < 4; ++m)
#pragma unroll
                    for (int bj = 0; bj < 2; ++bj) *(u32x4*)(base + (size_t)(ai * HALF + m * 16) * INW + 32 * bj) = pack8(acc[ai][bj][m][0] * rs1[ai][m], acc[ai][bj][m][1] * rs1[ai][m]);
        }
    }
};

struct EpiOutProj {
    static constexpr bool PERM = true, AFTER_DRAIN = true; static constexpr int BMAP = 0;
    const bf16_t* xb; bf16_t* x1b; unsigned char* x1q; float* rowss;
    __device__ __forceinline__ void operator()(const f32x4 (&)[2][2][4][2], const Unit&, int, int, int, int) const {}
    __device__ __forceinline__ void fused(f32x4 (&acc)[2][2][4][2], const Unit& u, int wr, int wc, int fr, int fq, PG8_LAS unsigned char* lds, int wid, int lane) const {
        PG8_LAS float* Pl = (PG8_LAS float*)lds;
        const int col0 = u.pn * BM + wc * 32 + 8 * fq;
#pragma unroll
        for (int ai = 0; ai < 2; ++ai)
#pragma unroll
            for (int m = 0; m < 4; ++m) { const int rt = ai * HALF + wr * 64 + m * 16 + fr; const size_t off = (size_t)(u.pm * BM + rt) * DM + col0; float s = 0.f;
#pragma unroll
                for (int bj = 0; bj < 2; ++bj) { const u32x4 w = *(const u32x4*)(xb + off + bj * HALF);
                    const f32x4 v0 = acc[ai][bj][m][0] + (f32x4){__builtin_bit_cast(float, w.x << 16), __builtin_bit_cast(float, w.x & 0xffff0000u), __builtin_bit_cast(float, w.y << 16), __builtin_bit_cast(float, w.y & 0xffff0000u)};
                    const f32x4 v1 = acc[ai][bj][m][1] + (f32x4){__builtin_bit_cast(float, w.z << 16), __builtin_bit_cast(float, w.z & 0xffff0000u), __builtin_bit_cast(float, w.w << 16), __builtin_bit_cast(float, w.w & 0xffff0000u)};
                    *(u32x4*)(x1b + off + bj * HALF) = pack8(v0, v1); *(u32x2*)(x1q + off + bj * HALF) = pack8_f8(v0, v1); s += hsq4(v0) + hsq4(v1); }
                s = quad_sum(s); if (fq == 0) Pl[rt * 4 + wc] = s;
                if (m & 1) asm volatile("" ::: "memory"); }
        asm volatile("s_waitcnt lgkmcnt(0)" ::: "memory"); __builtin_amdgcn_s_barrier(); asm volatile("" ::: "memory");
        const int t = wid * 64 + lane;
        if (t < 256) rowss[(size_t)(u.pm * BM + t) * 4 + u.pn] = (Pl[t * 4 + 0] + Pl[t * 4 + 1]) + (Pl[t * 4 + 2] + Pl[t * 4 + 3]);
    }
};

struct EpiGateUp {
    static constexpr bool PERM = true, AFTER_DRAIN = false; static constexpr int BMAP = 0;
    unsigned char* H; RowScalePrefetch rp;
    __device__ __forceinline__ void operator()(const f32x4 (&acc)[2][2][4][2], const Unit& u, int wr, int wc, int fr, int fq) const {
        const int row0 = u.pm * BM + wr * 64 + fr, col0 = u.pn * HALF + wc * 32 + 8 * fq;
        float rs2[2][4], k1[2][4];
#pragma unroll
        for (int ai = 0; ai < 2; ++ai)
#pragma unroll
            for (int m = 0; m < 4; ++m) { const float rs = rp.cur()[wr * 64 + fr + ai * HALF + m * 16]; rs2[ai][m] = rs * rs; k1[ai][m] = -1.4426950408889634f * rs; }
        rp.flush(); ++rp.ndone;
#pragma unroll
        for (int ai = 0; ai < 2; ++ai)
#pragma unroll
            for (int m = 0; m < 4; ++m) { const int row = row0 + ai * HALF + m * 16;
                f32x4 a = acc[ai][0][m][0], b = acc[ai][0][m][1]; const f32x4 ua = acc[ai][1][m][0], ub = acc[ai][1][m][1];
#pragma unroll
                for (int e = 0; e < 4; ++e) {
                    a[e] = (a[e] * ua[e]) * rs2[ai][m] * __builtin_amdgcn_rcpf(1.0f + __builtin_amdgcn_exp2f(a[e] * k1[ai][m]));
                    b[e] = (b[e] * ub[e]) * rs2[ai][m] * __builtin_amdgcn_rcpf(1.0f + __builtin_amdgcn_exp2f(b[e] * k1[ai][m])); }
                *(u32x2*)(H + (size_t)row * DFF + col0) = pack8_f8(a, b); }
    }
};

struct EpiDown {
    static constexpr bool PERM = true, AFTER_DRAIN = false; static constexpr int BMAP = 0;
    const bf16_t* x1b; float* out;
    __device__ __forceinline__ void operator()(const f32x4 (&acc)[2][2][4][2], const Unit& u, int wr, int wc, int fr, int fq) const {
        const int row0 = u.pm * BM + wr * 64 + fr, col0 = u.pn * BM + wc * 32 + 8 * fq;
#pragma unroll
        for (int ai = 0; ai < 2; ++ai) {
            u32x4 xv[4][2];
#pragma unroll
            for (int m = 0; m < 4; ++m)
#pragma unroll
                for (int bj = 0; bj < 2; ++bj) xv[m][bj] = *(const u32x4*)(x1b + (size_t)(row0 + ai * HALF + m * 16) * DM + col0 + bj * HALF);
#pragma unroll
            for (int m = 0; m < 4; ++m) { float* rowp = out + (size_t)(row0 + ai * HALF + m * 16) * DM + col0;
#pragma unroll
                for (int bj = 0; bj < 2; ++bj) { const u32x4 w = xv[m][bj];
                    const f32x4 x0 = {__builtin_bit_cast(float, w.x << 16), __builtin_bit_cast(float, w.x & 0xffff0000u), __builtin_bit_cast(float, w.y << 16), __builtin_bit_cast(float, w.y & 0xffff0000u)};
                    const f32x4 x1 = {__builtin_bit_cast(float, w.z << 16), __builtin_bit_cast(float, w.z & 0xffff0000u), __builtin_bit_cast(float, w.w << 16), __builtin_bit_cast(float, w.w & 0xffff0000u)};
                    *(f32x4*)(rowp + bj * HALF) = x0 + acc[ai][bj][m][0] * (1.0f / WD_SCALE); *(f32x4*)(rowp + bj * HALF + 4) = x1 + acc[ai][bj][m][1] * (1.0f / WD_SCALE); } }
            asm volatile("" ::: "memory"); }
    }
};

struct EpiNull {
    static constexpr bool PERM = true, AFTER_DRAIN = false; static constexpr int BMAP = 0;
    float* sink;
    __device__ __forceinline__ void operator()(const f32x4 (&acc)[2][2][4][2], const Unit& u, int wr, int wc, int fr, int fq) const {
        float s = 0.f;
#pragma unroll
        for (int ai = 0; ai < 2; ++ai)
#pragma unroll
            for (int bj = 0; bj < 2; ++bj)
#pragma unroll
                for (int m = 0; m < 4; ++m)
#pragma unroll
                    for (int n = 0; n < 2; ++n) s += acc[ai][bj][m][n][0];
        if (s == 123.456f) sink[0] = s;
    }
};

struct P1Unit : StaticOrder, EpiInProj { __device__ __forceinline__ void a_ready(const Unit& u) const { rp.fetch<0>(u); } };
struct P4Unit : StaticOrder, EpiGateUp { __device__ __forceinline__ void a_ready(const Unit& u) const { rp.fetch<1>(u); } };

template <class Epi, class Sched, bool ALIGN_EPI = false, bool SP2 = false, bool F8 = false>
__device__ __forceinline__ void gemm_phase(PG8_LAS unsigned char* lds, const Gemm g, const Sched& S, const Epi& E) {
    int tid_ = threadIdx.x; asm volatile("" : "+v"(tid_));
    const int tid = tid_, wid = __builtin_amdgcn_readfirstlane(tid >> 6), lane = tid & 63, wr = wid >> 2, wc = wid & 3, fr = lane & 15, fq = lane >> 4;
    const int K = g.K, nt = K / BK;
    unsigned voffA[2], voffB[2];
#pragma unroll
    for (int i = 0; i < 2; ++i) { int R, C; stage_rc(tid * 16 + i * 8192, R, C); int Rb = Epi::PERM ? ((R & ~31) + perm32(R & 31)) : R;
        if (Epi::BMAP == 1) Rb = 64 * (R >> 5) + (Rb & 31);
        voffA[i] = (unsigned)(R * K + C) * 2u; voffB[i] = (unsigned)(Rb * K + C) * 2u; }
    const size_t kstep = (size_t)(BK * 2);
    const size_t hstep = (size_t)HALF * K * 2;
    const size_t hstepB = (size_t)(Epi::BMAP == 1 ? 32 : HALF) * K * 2;
    const size_t tstep = 2 * hstep;
    const unsigned ldsw = (unsigned)wid * 1024u;
    const int aoff = lds_byte(wr * 64 + fr, fq * 8), boff = lds_byte(wc * 32 + fr, fq * 8);
#define PG8_SA(b, h) (((b) * 2 + (h)) * HTB)
#define PG8_SB(b, h) ((4 + (b) * 2 + (h)) * HTB)
#define PG8_STAGE(bufoff, gbase, voff) do { _Pragma("unroll") for (int _i = 0; _i < 2; ++_i) \
        __builtin_amdgcn_global_load_lds((const unsigned*)((const char*)(gbase) + (voff)[_i]), (PG8_LAS unsigned*)(lds + (bufoff) + ldsw + _i * 8192), 16, 0, 0); } while (0)
#define PG8_LDA(dst, b, h) do { _Pragma("unroll") for (int m = 0; m < 4; ++m) _Pragma("unroll") for (int k = 0; k < 2; ++k) dst[m][k] = *(const PG8_LAS bf16x8*)(lds + PG8_SA(b, h) + aoff + m * 2048 + k * 1024); } while (0)
#define PG8_LDB(dst, b, h) do { _Pragma("unroll") for (int n = 0; n < 2; ++n) _Pragma("unroll") for (int k = 0; k < 2; ++k) dst[n][k] = *(const PG8_LAS bf16x8*)(lds + PG8_SB(b, h) + boff + n * 2048 + k * 1024); } while (0)
#define PG8_CAT(x) __builtin_shufflevector(__builtin_bit_cast(v4i_t, x[0]), __builtin_bit_cast(v4i_t, x[1]), 0, 1, 2, 3, 4, 5, 6, 7)
#define PG8_MMA(ai, bj, At, Bt) do { __builtin_amdgcn_s_setprio(1); _Pragma("unroll") for (int m = 0; m < 4; ++m) _Pragma("unroll") for (int n = 0; n < 2; ++n) { \
        if constexpr (F8) asm volatile("v_mfma_f32_16x16x128_f8f6f4 %0, %1, %2, %0" : "+v"(acc[ai][bj][m][n]) : "v"(PG8_CAT(Bt[n])), "v"(PG8_CAT(At[m])));       \
        else { _Pragma("unroll") for (int k = 0; k < 2; ++k) acc[ai][bj][m][n] = __builtin_amdgcn_mfma_f32_16x16x32_bf16(Bt[n][k], At[m][k], acc[ai][bj][m][n], 0, 0, 0); } } __builtin_amdgcn_s_setprio(0); } while (0)
#define PG8_WAIT_V(n) asm volatile("s_waitcnt vmcnt(" #n ")" ::: "memory")
#define PG8_WAIT_L(n) asm volatile("s_waitcnt lgkmcnt(" #n ")" ::: "memory")
#define PG8_BAR __builtin_amdgcn_s_barrier()
#define PG8_SCHED __builtin_amdgcn_sched_barrier(0)
#define PG8_PIN_ACC(txt) do { _Pragma("unroll") for (int a_ = 0; a_ < 2; ++a_) _Pragma("unroll") for (int b_ = 0; b_ < 2; ++b_) \
        asm volatile(txt : "+v"(acc[a_][b_][0][0]), "+v"(acc[a_][b_][0][1]), "+v"(acc[a_][b_][1][0]), "+v"(acc[a_][b_][1][1]), "+v"(acc[a_][b_][2][0]), "+v"(acc[a_][b_][2][1]), "+v"(acc[a_][b_][3][0]), "+v"(acc[a_][b_][3][1])); } while (0)
    Unit cur, nxt; int ui = 0;
    if (!S.next(0, cur)) return;
    f32x4 acc[2][2][4][2];
#pragma unroll
    for (int a = 0; a < 2; ++a)
#pragma unroll
        for (int b = 0; b < 2; ++b)
#pragma unroll
            for (int m = 0; m < 4; ++m)
#pragma unroll
                for (int n = 0; n < 2; ++n) acc[a][b][m][n] = (f32x4){0.f, 0.f, 0.f, 0.f};
    if constexpr (F8) PG8_PIN_ACC("");
    bf16x8 At[4][2], B0[2][2], B1[2][2];
    const char* cA = (const char*)g.A + (size_t)cur.pm * tstep; const char* cB = (const char*)g.Bt + (size_t)cur.pn * tstep;
    S.a_ready(cur);
    if constexpr (SP2) {
        PG8_STAGE(PG8_SB(0, 0), cB, voffB); PG8_STAGE(PG8_SB(0, 1), cB + hstepB, voffB); PG8_STAGE(PG8_SA(0, 0), cA, voffA); PG8_STAGE(PG8_SA(0, 1), cA + hstep, voffA);
        if (wr == 1) PG8_BAR;
        PG8_WAIT_V(2); PG8_BAR;
        PG8_STAGE(PG8_SB(1, 0), cB + kstep, voffB); PG8_STAGE(PG8_SA(1, 0), cA + kstep, voffA); PG8_STAGE(PG8_SB(1, 1), cB + hstepB + kstep, voffB);
        PG8_WAIT_V(6); PG8_BAR;
    } else {
        PG8_STAGE(PG8_SB(0, 0), cB, voffB); PG8_STAGE(PG8_SA(0, 0), cA, voffA); PG8_STAGE(PG8_SB(0, 1), cB + hstepB, voffB); PG8_STAGE(PG8_SA(0, 1), cA + hstep, voffA);
        if (wr == 1) PG8_BAR;
        PG8_WAIT_V(4); PG8_BAR;
        PG8_STAGE(PG8_SB(1, 0), cB + kstep, voffB); PG8_STAGE(PG8_SA(1, 0), cA + kstep, voffA); PG8_STAGE(PG8_SB(1, 1), cB + hstepB + kstep, voffB);
        PG8_WAIT_V(6); PG8_BAR;
    }
    for (;;) {
        const bool has_next = S.next(ui + 1, nxt);
        const char* nA = has_next ? (const char*)g.A + (size_t)nxt.pm * tstep : cA; const char* nB = has_next ? (const char*)g.Bt + (size_t)nxt.pn * tstep : cB;
        for (int t = 0; t < nt; t += 2) {
            const bool last = (t == nt - 2);
            const char* a1 = cA + (size_t)(t + 1) * kstep;
            const char* a2 = last ? nA : cA + (size_t)(t + 2) * kstep; const char* b2 = last ? nB : cB + (size_t)(t + 2) * kstep;
            const char* a3 = a2 + kstep; const char* b3 = b2 + kstep;
            if (last && has_next) S.a_ready(nxt);
            if constexpr (SP2) {
            PG8_LDB(B0, 0, 0); PG8_LDB(B1, 0, 1); PG8_SCHED; PG8_LDA(At, 0, 0); PG8_STAGE(PG8_SA(1, 1), a1 + hstep, voffA);
            PG8_WAIT_V(8); PG8_WAIT_L(0); PG8_BAR; PG8_MMA(0, 0, At, B0); PG8_MMA(0, 1, At, B1); PG8_BAR; PG8_SCHED;
            PG8_LDA(At, 0, 1); PG8_STAGE(PG8_SB(0, 0), b2, voffB); PG8_STAGE(PG8_SB(0, 1), b2 + hstepB, voffB); PG8_STAGE(PG8_SA(0, 0), a2, voffA);
            PG8_WAIT_V(8); PG8_WAIT_L(0); PG8_BAR; PG8_MMA(1, 0, At, B0); PG8_MMA(1, 1, At, B1); PG8_BAR; PG8_SCHED;
            PG8_LDB(B0, 1, 0); PG8_LDB(B1, 1, 1); PG8_SCHED; PG8_LDA(At, 1, 0); PG8_STAGE(PG8_SA(0, 1), a2 + hstep, voffA);
            PG8_WAIT_V(8); PG8_WAIT_L(0); PG8_BAR; PG8_MMA(0, 0, At, B0); PG8_MMA(0, 1, At, B1); PG8_BAR; PG8_SCHED;
            PG8_LDA(At, 1, 1); PG8_STAGE(PG8_SB(1, 0), b3, voffB); PG8_STAGE(PG8_SB(1, 1), b3 + hstepB, voffB); PG8_STAGE(PG8_SA(1, 0), a3, voffA);
            PG8_WAIT_V(8); PG8_WAIT_L(0); PG8_BAR; PG8_MMA(1, 0, At, B0); PG8_MMA(1, 1, At, B1); PG8_BAR; PG8_SCHED;
            } else {
            PG8_LDB(B0, 0, 0); PG8_SCHED; PG8_LDA(At, 0, 0); PG8_STAGE(PG8_SA(1, 1), a1 + hstep, voffA);
            PG8_WAIT_L(8); PG8_BAR; PG8_WAIT_L(0); PG8_MMA(0, 0, At, B0); PG8_BAR; PG8_SCHED;
            PG8_LDB(B1, 0, 1); PG8_STAGE(PG8_SB(0, 0), b2, voffB);
            PG8_BAR; PG8_WAIT_L(0); PG8_MMA(0, 1, At, B1); PG8_BAR;
            PG8_LDA(At, 0, 1); PG8_STAGE(PG8_SA(0, 0), a2, voffA);
            PG8_BAR; PG8_WAIT_L(0); PG8_MMA(1, 0, At, B0); PG8_BAR; PG8_SCHED;
            PG8_STAGE(PG8_SB(0, 1), b2 + hstepB, voffB);
            PG8_WAIT_V(6); PG8_BAR; PG8_MMA(1, 1, At, B1); PG8_BAR;
            PG8_LDB(B0, 1, 0); PG8_SCHED; PG8_LDA(At, 1, 0); PG8_STAGE(PG8_SA(0, 1), a2 + hstep, voffA);
            PG8_WAIT_L(8); PG8_BAR; PG8_WAIT_L(0); PG8_MMA(0, 0, At, B0); PG8_BAR; PG8_SCHED;
            PG8_LDB(B1, 1, 1); PG8_STAGE(PG8_SB(1, 0), b3, voffB);
            PG8_BAR; PG8_WAIT_L(0); PG8_MMA(0, 1, At, B1); PG8_BAR;
            PG8_LDA(At, 1, 1); PG8_STAGE(PG8_SA(1, 0), a3, voffA);
            PG8_BAR; PG8_WAIT_L(0); PG8_MMA(1, 0, At, B0); PG8_BAR; PG8_SCHED;
            PG8_STAGE(PG8_SB(1, 1), b3 + hstepB, voffB);
            PG8_WAIT_V(6); PG8_BAR; PG8_MMA(1, 1, At, B1); PG8_BAR;
            }
        }
        if constexpr (F8) PG8_PIN_ACC("s_nop 15");
        if constexpr (ALIGN_EPI) { if (wr == 0) PG8_BAR; }
        if constexpr (!Epi::AFTER_DRAIN) { E(acc, cur, wr, wc, fr, fq); S.done(cur); }
        if (!has_next) break;
#pragma unroll
        for (int a = 0; a < 2; ++a)
#pragma unroll
            for (int b = 0; b < 2; ++b)
#pragma unroll
                for (int m = 0; m < 4; ++m)
#pragma unroll
                    for (int n = 0; n < 2; ++n) acc[a][b][m][n] = (f32x4){0.f, 0.f, 0.f, 0.f};
        if constexpr (F8) PG8_PIN_ACC("");
        cur = nxt; cA = nA; cB = nB; ++ui;
        if constexpr (ALIGN_EPI) { if (wr == 1) PG8_BAR; }
    }
    PG8_WAIT_V(0);
    if constexpr (!ALIGN_EPI) { if (wr == 0) PG8_BAR; }
    PG8_BAR;
    if constexpr (Epi::AFTER_DRAIN) { E.fused(acc, cur, wr, wc, fr, fq, lds, wid, lane); S.done(cur); }
#undef PG8_SA
#undef PG8_SB
#undef PG8_STAGE
#undef PG8_LDA
#undef PG8_LDB
#undef PG8_MMA
#undef PG8_CAT
#undef PG8_PIN_ACC
#undef PG8_WAIT_V
#undef PG8_WAIT_L
#undef PG8_BAR
#undef PG8_SCHED
}
}

#ifndef PG8_SP2
#define PG8_SP2 true
#endif
#ifndef PG8_ALIGN
#define PG8_ALIGN true
#endif

namespace attn_body {
using bf16=__hip_bfloat16;
using bf16x8=__attribute__((ext_vector_type(8)))short;
using s16x4=__attribute__((ext_vector_type(4)))short;
using f32x16=__attribute__((ext_vector_type(16)))float;
using u32x4=__attribute__((ext_vector_type(4)))unsigned;
constexpr int BATCH=8,NHEAD=8,SEQ=2048,D=64,DM=2560,YP=1024;
constexpr int NW=8,QBLK=32,QB=QBLK*NW,KVBLK=64,NQB=SEQ/QB;
constexpr int ATTN_PITCH=DM, ATTN_UNIT_ROWS=QB;
__device__ __forceinline__ int crow(int r,int hi){return (r&3)+8*(r>>2)+4*hi;}
#define SBAR() __builtin_amdgcn_sched_barrier(0)
__device__ __forceinline__ void cmask(f32x16&p0,f32x16&p1,int jb,int qrel,int hi){
  const float NEG=-INFINITY; int kb=64*jb+4*hi;
  #pragma unroll
  for(int r=0;r<16;++r){int kv=kb+(r&3)+8*(r>>2); if(kv>qrel)p0[r]=NEG; if(kv+32>qrel)p1[r]=NEG;}
}

constexpr int NSLOT=3, SLOTB=8192;
constexpr int LDS_K=0, LDS_V=NSLOT*SLOTB, LDS_WS=2*NSLOT*SLOTB, LDS_OST=LDS_WS+NW*64*4, LDS_BYTES=LDS_OST+NW*8192;
constexpr float C2=0.125f*1.4426950408889634f;
__device__ __forceinline__ void glds16(const void*gsrc,unsigned lds_dst){unsigned keep;
  asm volatile("s_mov_b32 %0, m0\n\ts_mov_b32 m0, %2\n\ts_nop 0\n\tglobal_load_lds_dwordx4 %1, off\n\ts_mov_b32 m0, %0":"=&s"(keep):"v"(gsrc),"s"(lds_dst):"memory");}
__device__ __forceinline__ float max3f(float a,float b,float c){float r;asm("v_max3_f32 %0, %1, %2, %3":"=v"(r):"v"(a),"v"(b),"v"(c));return r;}
__device__ __forceinline__ float max2f(float a,float b){float r;asm("v_max_f32_e32 %0, %1, %2":"=v"(r):"v"(a),"v"(b));return r;}
__device__ __forceinline__ float fadd_s(float a,float b){float r;asm("v_add_f32_e32 %0, %1, %2":"=v"(r):"v"(a),"v"(b));return r;}
__device__ __forceinline__ float fsub_s(float a,float b){float r;asm("v_sub_f32_e32 %0, %1, %2":"=v"(r):"v"(a),"v"(b));return r;}
typedef float f32x2_t __attribute__((ext_vector_type(2))); typedef __bf16 bf16x2_t __attribute__((ext_vector_type(2))); typedef float f32x4_t __attribute__((ext_vector_type(4))); typedef unsigned u32x2_t __attribute__((ext_vector_type(2)));
__device__ __forceinline__ unsigned cvtpk_s(float lo,float hi){f32x2_t v={lo,hi};bf16x2_t b=__builtin_convertvector(v,bf16x2_t);return __builtin_bit_cast(unsigned,b);}
#define WAIT_BAR(N) asm volatile("s_waitcnt vmcnt(" #N ") lgkmcnt(0)\n\ts_barrier":::"memory")

__device__ __forceinline__ void qkt(f32x16&p0,f32x16&p1,const char*Kslot,const bf16x8*qr,const f32x16&negm,int r32,int hi){
  const char*kb=Kslot+hi*1024+r32*16;
  #pragma unroll
  for(int d0=0;d0<4;++d0){
    const bf16x8 b0=*reinterpret_cast<const bf16x8*>(kb+d0*2048);
    const bf16x8 b1=*reinterpret_cast<const bf16x8*>(kb+d0*2048+512);
    if(d0==0){p0=__builtin_amdgcn_mfma_f32_32x32x16_bf16(b0,qr[0],negm,0,0,0);p1=__builtin_amdgcn_mfma_f32_32x32x16_bf16(b1,qr[0],negm,0,0,0);}
    else{p0=__builtin_amdgcn_mfma_f32_32x32x16_bf16(b0,qr[d0],p0,0,0,0);p1=__builtin_amdgcn_mfma_f32_32x32x16_bf16(b1,qr[d0],p1,0,0,0);}}
}
typedef __attribute__((address_space(3))) const char* lds_cptr;
typedef short v4i16_t __attribute__((ext_vector_type(4)));
__device__ __forceinline__ void kload8(bf16x8*kf,lds_cptr kp){
  kf[0]=*(const __attribute__((address_space(3))) bf16x8*)(kp);      kf[1]=*(const __attribute__((address_space(3))) bf16x8*)(kp+512);
  kf[2]=*(const __attribute__((address_space(3))) bf16x8*)(kp+2048); kf[3]=*(const __attribute__((address_space(3))) bf16x8*)(kp+2560);
  kf[4]=*(const __attribute__((address_space(3))) bf16x8*)(kp+4096); kf[5]=*(const __attribute__((address_space(3))) bf16x8*)(kp+4608);
  kf[6]=*(const __attribute__((address_space(3))) bf16x8*)(kp+6144); kf[7]=*(const __attribute__((address_space(3))) bf16x8*)(kp+6656);
}
__device__ __forceinline__ void kload2(bf16x8*kf,lds_cptr kp,int j){ kf[2*j]=*(const __attribute__((address_space(3))) bf16x8*)(kp+j*2048); kf[2*j+1]=*(const __attribute__((address_space(3))) bf16x8*)(kp+j*2048+512); }
__device__ __forceinline__ s16x4 vtr(lds_cptr p){ return __builtin_bit_cast(s16x4,__builtin_amdgcn_ds_read_tr16_b64_v4i16((__attribute__((address_space(3))) v4i16_t*)p)); }
__device__ __forceinline__ float rowmax(const f32x16&p0,const f32x16&p1){
  float a=max3f(p0[0],p0[1],p1[0]),b=max3f(p0[2],p0[3],p1[1]);a=max3f(a,p1[2],p1[3]);
  #pragma unroll
  for(int r=4;r<16;r+=4){a=max3f(a,p0[r],p0[r+1]);b=max3f(b,p0[r+2],p0[r+3]);a=max3f(a,p1[r],p1[r+1]);b=max3f(b,p1[r+2],p1[r+3]);}
  const float m=max2f(a,b);
  auto rr=__builtin_amdgcn_permlane32_swap(__float_as_uint(m),__float_as_uint(m),false,false);
  return max2f(__uint_as_float(rr[0]),__uint_as_float(rr[1]));
}
__device__ __forceinline__ void pv(f32x16*o,int vb,bf16x8 pa0,bf16x8 pa1,bf16x8 pa2,bf16x8 pa3){
  #pragma unroll
  for(int d0=0;d0<2;++d0){s16x4 lo[4],hi[4];
    #pragma unroll
    for(int ks=0;ks<4;++ks){
      asm volatile("ds_read_b64_tr_b16 %0,%1 offset:%c2":"=&v"(lo[ks]):"v"(vb),"i"(d0*4096+ks*1024):"memory");
      asm volatile("ds_read_b64_tr_b16 %0,%1 offset:%c2":"=&v"(hi[ks]):"v"(vb),"i"(d0*4096+ks*1024+512):"memory");}
    asm volatile("s_waitcnt lgkmcnt(0)":::"memory");SBAR();
    #define PK(k) (bf16x8){lo[k][0],lo[k][1],lo[k][2],lo[k][3],hi[k][0],hi[k][1],hi[k][2],hi[k][3]}
    o[d0]=__builtin_amdgcn_mfma_f32_32x32x16_bf16(pa0,PK(0),o[d0],0,0,0);
    o[d0]=__builtin_amdgcn_mfma_f32_32x32x16_bf16(pa1,PK(1),o[d0],0,0,0);
    o[d0]=__builtin_amdgcn_mfma_f32_32x32x16_bf16(pa2,PK(2),o[d0],0,0,0);
    o[d0]=__builtin_amdgcn_mfma_f32_32x32x16_bf16(pa3,PK(3),o[d0],0,0,0);
    #undef PK
  }
}

#ifndef ATTN_STORE16
#define ATTN_STORE16(p,v) (*(u32x4*)(p)=(v))
#endif
template<int THRL> __device__ __forceinline__ void attn_unit(int b,int h,int qb,const bf16*Q,const bf16*__restrict__ K,const bf16*__restrict__ V,bf16*Y,const float*__restrict__ ksum,const float*__restrict__ onb_g,unsigned*seldump,char*shm){
  int tid_=threadIdx.x; asm volatile("":"+v"(tid_)); const int tid=tid_,lane=tid&63,r32=lane&31,hi=lane>>5; const int wid=__builtin_amdgcn_readfirstlane(tid>>6);
  const long rowbase=(long)b*SEQ; const int q0=qb*QB;
  const bf16*Qw=Q+(rowbase+q0+wid*QBLK)*DM+h*D;
  const bf16*Kh=K+rowbase*DM+h*D,*Vh=V+rowbase*DM+h*D;
  const unsigned lds0=(unsigned)(uintptr_t)shm;
  float*wsf=(float*)(shm+LDS_WS)+wid*64;
  const bf16*ksrc=Kh+(long)lane*DM+wid*8;
  const bf16*vsrc=Vh+(long)(16*(wid&3)+(lane>>2))*DM+(wid>>2)*32+(lane&3)*8;
  const unsigned kdst=lds0+LDS_K+wid*1024, vdst=lds0+LDS_V+wid*1024;
  #define DMA_K(t,slot) glds16(ksrc+(long)(t)*KVBLK*DM,(unsigned)__builtin_amdgcn_readfirstlane(kdst+(slot)))
  #define DMA_V(t,slot) glds16(vsrc+(long)(t)*KVBLK*DM,(unsigned)__builtin_amdgcn_readfirstlane(vdst+(slot)))
  const int vb0=(int)(lds0+LDS_V)+((lane>>4)&1)*32+(lane&3)*8+(4*hi+((lane&15)>>2))*64;
  const char*Kbase=shm+LDS_K; bf16x8 kf[8];
  const lds_cptr shm3=(lds_cptr)shm; const lds_cptr kp0=shm3+LDS_K+hi*1024+r32*16; const lds_cptr vp0=shm3+LDS_V+((lane>>4)&1)*32+(lane&3)*8+(4*hi+((lane&15)>>2))*64;
  const int NT=(q0+QB)/KVBLK;
  DMA_K(0,0);DMA_V(0,0);DMA_K(1,SLOTB);
  bf16x8 qr[4];
  #pragma unroll
  for(int d0=0;d0<4;++d0)qr[d0]=*reinterpret_cast<const bf16x8*>(&Qw[(long)r32*DM+d0*16+hi*8]);
  unsigned selbits;
  { f32x16 g=f32x16{};
    const float*kr=ksum+((((long)(b*(SEQ/QB)+r32)*2)*NHEAD+h)*D)+hi*8;
    #pragma unroll
    for(int d0=0;d0<4;++d0){ f32x4_t a0={0.f,0.f,0.f,0.f},a1={0.f,0.f,0.f,0.f}; if(r32<qb){a0=*reinterpret_cast<const f32x4_t*>(kr+d0*16)+*reinterpret_cast<const f32x4_t*>(kr+NHEAD*D+d0*16);a1=*reinterpret_cast<const f32x4_t*>(kr+d0*16+4)+*reinterpret_cast<const f32x4_t*>(kr+NHEAD*D+d0*16+4);}
      float hv[8],lv[8];
      #pragma unroll
      for(int e=0;e<4;++e){const float t0=a0[e],t1=a1[e];     hv[e]=__uint_as_float(__float_as_uint(t0)&0xffff0000u);lv[e]=t0-hv[e];hv[4+e]=__uint_as_float(__float_as_uint(t1)&0xffff0000u);lv[4+e]=t1-hv[4+e];}
      u32x4 wh={cvtpk_s(hv[0],hv[1]),cvtpk_s(hv[2],hv[3]),cvtpk_s(hv[4],hv[5]),cvtpk_s(hv[6],hv[7])},wl={cvtpk_s(lv[0],lv[1]),cvtpk_s(lv[2],lv[3]),cvtpk_s(lv[4],lv[5]),cvtpk_s(lv[6],lv[7])};
      g=__builtin_amdgcn_mfma_f32_32x32x16_bf16(__builtin_bit_cast(bf16x8,wh),qr[d0],g,0,0,0);
      g=__builtin_amdgcn_mfma_f32_32x32x16_bf16(__builtin_bit_cast(bf16x8,wl),qr[d0],g,0,0,0);}
    float gt[8];
    #pragma unroll
    for(int r=0;r<4;++r){auto rr=__builtin_amdgcn_permlane32_swap(__float_as_uint(g[r]),__float_as_uint(g[r]),false,false);gt[r]=__uint_as_float(rr[0]);gt[4+r]=__uint_as_float(rr[1]);}
    if(seldump&&hi==0){float*gd=(float*)(seldump+(long)BATCH*NHEAD*SEQ)+(((long)(b*NHEAD+h)*SEQ)+q0+wid*QBLK+r32)*8;
      #pragma unroll
      for(int n=0;n<7;++n)gd[n]=gt[n];}
    selbits=1u<<qb;
    #pragma unroll
    for(int n=0;n<7;++n){int rank=0;
      #pragma unroll
      for(int m=0;m<7;++m)if(m!=n)rank+=(m<qb&&(gt[m]>gt[n]||(gt[m]==gt[n]&&m<n)))?1:0;
      if(n<qb&&rank<3)selbits|=1u<<n;}
  }
  if(seldump&&hi==0)seldump[((long)(b*NHEAD+h)*SEQ)+q0+wid*QBLK+r32]=selbits;
  #define MSKF(n) ((((selbits>>(n))&1u)!=0u)?0.f:-INFINITY)
  float mhat=0.f,l_reg=0.f;f32x16 o[2];o[0]=f32x16{};o[1]=f32x16{};f32x16 negm;{const float nm0=MSKF(0);
  #pragma unroll
  for(int r=0;r<16;++r)negm[r]=nm0;}asm volatile("":"+v"(negm));
  #define NEWBLK(tt) do{ if((((tt)&3)==0)){ const float nm_=MSKF((tt)>>2)-mhat; _Pragma("unroll") for(int r=0;r<16;++r)negm[r]=nm_; asm volatile("":"+v"(negm)); } }while(0)
  const int qrel=wid*QBLK+r32;
  #define CMASK(P0,P1,t) do{int jb_=(t)-(NT-4); if(jb_>=0)cmask(P0,P1,jb_,qrel,hi);}while(0)
  bool resc=false;
  #define START(P0,P1) do{ const float rm=rowmax(P0,P1); resc=false; \
    { const float dl=(rm==-INFINITY)?0.f:rm; mhat=fadd_s(mhat,dl); \
      _Pragma("unroll") for(int r=0;r<16;++r){P0[r]=fsub_s(P0[r],dl);P1[r]=fsub_s(P1[r],dl);} \
      const float nm_=MSKF(0)-mhat; _Pragma("unroll") for(int r=0;r<16;++r)negm[r]=nm_; asm volatile("":"+v"(negm)); } \
    _Pragma("unroll") for(int r=0;r<16;++r)P0[r]=__builtin_amdgcn_exp2f(P0[r]); }while(0)
  #define RESC() do{ if(resc){ asm volatile("s_waitcnt lgkmcnt(0)":::"memory"); \
      _Pragma("unroll") for(int d_=0;d_<2;++d_) _Pragma("unroll") for(int r=0;r<16;++r)o[d_][r]*=wsf[crow(r,hi)]; } }while(0)
  f32x16 pA0,pA1,pB0,pB1;
  int sl_prev=0,sl_cur=0,sl_next=SLOTB;
  #define ROT() do{sl_prev=sl_cur;sl_cur=sl_next;sl_next=(sl_next==(NSLOT-1)*SLOTB)?0:sl_next+SLOTB;}while(0)
  DMA_K(2,2*SLOTB);
  WAIT_BAR(3);
  qkt(pA0,pA1,Kbase,qr,negm,r32,hi);asm volatile("s_nop 15\n\ts_nop 7":"+v"(pA0),"+v"(pA1));CMASK(pA0,pA1,0);
  START(pA0,pA1);
  _Pragma("unroll") for(int r=0;r<16;++r)pA1[r]=__builtin_amdgcn_exp2f(pA1[r]);
  WAIT_BAR(0);
  DMA_K(3,0);DMA_V(1,SLOTB);
  ROT();
  kload8(kf,kp0+sl_cur);
  WAIT_BAR(2);
  s16x4 vlo[8],vhi[8]; u32x4 pw0,pw1,pw2,pw3;
  #define PKW(P,B) cvtpk_s(P[B],P[B+1])
  #define PAF(k) __builtin_bit_cast(bf16x8,pw##k)
  #define VFR(i) (bf16x8){vlo[i][0],vlo[i][1],vlo[i][2],vlo[i][3],vhi[i][0],vhi[i][1],vhi[i][2],vhi[i][3]}
  #define PIN(x) asm volatile("":"+v"(x))
  #define MX3(a,b,c) __builtin_fmaxf(__builtin_fmaxf((a),(b)),(c))
  #define GAPA(MF,A0,A1,A2,A3,W0,W1,PW) do{ MF; sacc+=A0; sacc+=A1; sacc+=A2; sacc+=A3; PIN(sacc); W0; W1; PIN(PW); SBAR(); }while(0)
  #define EX(v) __builtin_amdgcn_exp2f(v)
  #define GAPB(MF,X,B) do{ MF; X[B]=EX(X[B]); X[B+1]=EX(X[B+1]); X[B+2]=EX(X[B+2]); X[B+3]=EX(X[B+3]); PIN(X); SBAR(); }while(0)
  #define VRD(i) do{ vlo[i]=vtr(vp_+(((i)>>2)*4096+((i)&3)*1024)); vhi[i]=vtr(vp_+(((i)>>2)*4096+((i)&3)*1024+512)); }while(0)
  #define KRD(G,j) do{ if(G){ kload2(kf,kp0+sl_next,j); SBAR(); } }while(0)
  #define STEP(C0,C1,P0,P1,t,GK,GV,GL) do{ SBAR(); \
    const lds_cptr vp_=vp0+sl_prev; \
    VRD(0); SBAR(); float sacc=(P0[0]+P0[1]); \
    GAPA(C0=__builtin_amdgcn_mfma_f32_32x32x16_bf16(kf[0],qr[0],negm,0,0,0), P0[2],P0[3],P0[4],P0[5],     pw0[0]=PKW(P0,0), pw0[1]=PKW(P0,2), pw0); \
    VRD(4); SBAR(); GAPA(C1=__builtin_amdgcn_mfma_f32_32x32x16_bf16(kf[1],qr[0],negm,0,0,0), P0[6],P0[7],P0[8],P0[9],     pw0[2]=PKW(P0,4), pw0[3]=PKW(P0,6), pw0); \
    VRD(1); SBAR(); GAPA(C0=__builtin_amdgcn_mfma_f32_32x32x16_bf16(kf[2],qr[1],C0,0,0,0),   P0[10],P0[11],P0[12],P0[13], pw1[0]=PKW(P0,8), pw1[1]=PKW(P0,10), pw1); \
    VRD(5); SBAR(); GAPA(C1=__builtin_amdgcn_mfma_f32_32x32x16_bf16(kf[3],qr[1],C1,0,0,0),   P0[14],P0[15],P1[0],P1[1],   pw1[2]=PKW(P0,12),pw1[3]=PKW(P0,14), pw1); \
    VRD(2); SBAR(); GAPA(C0=__builtin_amdgcn_mfma_f32_32x32x16_bf16(kf[4],qr[2],C0,0,0,0),   P1[2],P1[3],P1[4],P1[5],     pw2[0]=PKW(P1,0), pw2[1]=PKW(P1,2), pw2); \
    VRD(6); SBAR(); GAPA(C1=__builtin_amdgcn_mfma_f32_32x32x16_bf16(kf[5],qr[2],C1,0,0,0),   P1[6],P1[7],P1[8],P1[9],     pw2[2]=PKW(P1,4), pw2[3]=PKW(P1,6), pw2); \
    VRD(3); SBAR(); GAPA(C0=__builtin_amdgcn_mfma_f32_32x32x16_bf16(kf[6],qr[3],C0,0,0,0),   P1[10],P1[11],P1[12],P1[13], pw3[0]=PKW(P1,8), pw3[1]=PKW(P1,10), pw3); \
    VRD(7); SBAR(); GAPA(C1=__builtin_amdgcn_mfma_f32_32x32x16_bf16(kf[7],qr[3],C1,0,0,0),   P1[14],P1[15],0.f,0.f,       pw3[2]=PKW(P1,12),pw3[3]=PKW(P1,14), pw3); \
    l_reg+=sacc; \
    if(GK){DMA_K((t)+3,sl_cur);} if(GV){DMA_V((t)+1,sl_next);} \
    CMASK(C0,C1,t); \
    { float a=MX3(C0[0],C0[1],C1[0]),b=MX3(C0[2],C0[3],C1[1]); a=MX3(a,C1[2],C1[3]); \
      _Pragma("unroll") for(int r=4;r<16;r+=4){a=MX3(a,C0[r],C0[r+1]);b=MX3(b,C0[r+2],C0[r+3]);a=MX3(a,C1[r],C1[r+1]);b=MX3(b,C1[r+2],C1[r+3]);} \
      float rm=__builtin_fmaxf(a,b); { auto rr=__builtin_amdgcn_permlane32_swap(__float_as_uint(rm),__float_as_uint(rm),false,false); rm=__builtin_fmaxf(__uint_as_float(rr[0]),__uint_as_float(rr[1])); } \
      resc=false; \
      if(__builtin_expect(__any(rm>(float)THRL),0)){ const float dl=__builtin_fmaxf(rm,0.f); mhat+=dl; \
        _Pragma("unroll") for(int r=0;r<16;++r){C0[r]-=dl;C1[r]-=dl;} \
        const float nm_=MSKF((t)>>2)-mhat; _Pragma("unroll") for(int r=0;r<16;++r)negm[r]=nm_; asm volatile("":"+v"(negm)); \
        const float f=__builtin_amdgcn_exp2f(-dl); l_reg*=f; if(hi==0)wsf[r32]=f; resc=true; } } \
    SBAR(); \
    GAPB(o[0]=__builtin_amdgcn_mfma_f32_32x32x16_bf16(PAF(0),VFR(0),o[0],0,0,0), C0,0); \
    GAPB(o[1]=__builtin_amdgcn_mfma_f32_32x32x16_bf16(PAF(0),VFR(4),o[1],0,0,0), C0,4); \
    KRD(GL,0); GAPB(o[0]=__builtin_amdgcn_mfma_f32_32x32x16_bf16(PAF(1),VFR(1),o[0],0,0,0), C0,8); \
    KRD(GL,1); GAPB(o[1]=__builtin_amdgcn_mfma_f32_32x32x16_bf16(PAF(1),VFR(5),o[1],0,0,0), C0,12); \
    KRD(GL,2); GAPB(o[0]=__builtin_amdgcn_mfma_f32_32x32x16_bf16(PAF(2),VFR(2),o[0],0,0,0), C1,0); \
    KRD(GL,3); GAPB(o[1]=__builtin_amdgcn_mfma_f32_32x32x16_bf16(PAF(2),VFR(6),o[1],0,0,0), C1,4); \
    GAPB(o[0]=__builtin_amdgcn_mfma_f32_32x32x16_bf16(PAF(3),VFR(3),o[0],0,0,0), C1,8); \
    GAPB(o[1]=__builtin_amdgcn_mfma_f32_32x32x16_bf16(PAF(3),VFR(7),o[1],0,0,0), C1,12); \
    }while(0)
  int t=1;
  #undef CMASK
  #define CMASK(P0,P1,t) do{}while(0)
  for(;t+5<NT;t+=2){
    STEP(pB0,pB1,pA0,pA1,t,true,true,true);     WAIT_BAR(2); RESC(); ROT(); NEWBLK(t+1);
    STEP(pA0,pA1,pB0,pB1,t+1,true,true,true);   WAIT_BAR(2); RESC(); ROT();
  }
  #undef CMASK
  #define CMASK(P0,P1,t) do{int jb_=(t)-(NT-4); if(jb_>=0)cmask(P0,P1,jb_,qrel,hi);}while(0)
  #define ENDW(tt) do{ if((tt)+3<NT){WAIT_BAR(2);} else if((tt)+2<NT){WAIT_BAR(1);} else {WAIT_BAR(0);} }while(0)
  for(;t+1<NT;t+=2){
    STEP(pB0,pB1,pA0,pA1,t,(t+3<NT),(t+1<NT),(t+1<NT));       ENDW(t);   RESC(); ROT(); NEWBLK(t+1);
    STEP(pA0,pA1,pB0,pB1,t+1,(t+4<NT),(t+2<NT),(t+2<NT));     ENDW(t+1); RESC(); ROT();
  }
  STEP(pB0,pB1,pA0,pA1,NT-1,false,false,false); RESC();
  { float sacc=pB0[0]+pB0[1]; _Pragma("unroll") for(int r=2;r<16;++r)sacc+=pB0[r]; _Pragma("unroll") for(int r=0;r<16;++r)sacc+=pB1[r]; l_reg+=sacc;
    pw0=(u32x4){PKW(pB0,0),PKW(pB0,2),PKW(pB0,4),PKW(pB0,6)};pw1=(u32x4){PKW(pB0,8),PKW(pB0,10),PKW(pB0,12),PKW(pB0,14)};pw2=(u32x4){PKW(pB1,0),PKW(pB1,2),PKW(pB1,4),PKW(pB1,6)};pw3=(u32x4){PKW(pB1,8),PKW(pB1,10),PKW(pB1,12),PKW(pB1,14)};
    SBAR(); pv(o,vb0+sl_cur,PAF(0),PAF(1),PAF(2),PAF(3)); }
  #undef PKW
  #undef PAF
  #undef VFR
  #undef PIN
  #undef MX3
  #undef GAPA
  #undef GAPB
  #undef EX
  #undef VRD
  #undef KRD
  #undef STEP
  #undef ENDW
  {auto rr=__builtin_amdgcn_permlane32_swap(__float_as_uint(l_reg),__float_as_uint(l_reg),false,false);l_reg=__uint_as_float(rr[0])+__uint_as_float(rr[1]);}
  if(hi==0)wsf[32+r32]=l_reg;asm volatile("s_waitcnt lgkmcnt(0)":::"memory");
  float rli[16];
  #pragma unroll
  for(int r=0;r<16;++r)rli[r]=__builtin_amdgcn_rcpf(wsf[32+crow(r,hi)]);
  bf16*Yw=Y+(rowbase+q0+wid*QBLK)*YP+h*D;
  { float*stg=(float*)(shm+LDS_OST)+wid*2048;
    #pragma unroll
    for(int r=0;r<16;++r){const int orow=crow(r,hi);
      #pragma unroll
      for(int d0=0;d0<2;++d0)stg[orow*64+d0*32+r32]=o[d0][r]*rli[r];}
    asm volatile("s_waitcnt lgkmcnt(0)":::"memory");
    const int c4=lane&15; const f32x4_t g4=*reinterpret_cast<const f32x4_t*>(onb_g+h*D+c4*4);
    #pragma unroll
    for(int i=0;i<8;++i){const int row=i*4+(lane>>4); const f32x4_t v=*(const f32x4_t*)(stg+row*64+c4*4);
      float ss=(v[0]*v[0]+v[1]*v[1])+(v[2]*v[2]+v[3]*v[3]); ss+=__shfl_xor(ss,1); ss+=__shfl_xor(ss,2); ss+=__shfl_xor(ss,4); ss+=__shfl_xor(ss,8);
      const float rs=__builtin_amdgcn_rsqf(ss*(1.0f/64.0f)+1e-6f);
      u32x2_t w; w.x=cvtpk_s(v[0]*rs*g4[0],v[1]*rs*g4[1]); w.y=cvtpk_s(v[2]*rs*g4[2],v[3]*rs*g4[3]);
      *(u32x2_t*)(Yw+(long)row*YP+c4*4)=w;} }
  asm volatile("s_waitcnt lgkmcnt(0)\n\ts_barrier":::"memory");
  #undef DMA_K
  #undef DMA_V
  #undef MSKF
  #undef NEWBLK
  #undef CMASK
  #undef START
  #undef RESC
  #undef ROT
}
constexpr int ATTN_LDS_BYTES=LDS_BYTES;
struct AttnTensors { const bf16* Q; const bf16* K; const bf16* V; bf16* Y; const float* ksum; const float* onb_g; unsigned* seldump; };
struct AttnUnit { int bh; int qb; };
struct StaticOrder {
  int vcu,G;
  __device__ __forceinline__ explicit StaticOrder(int grid,int block):vcu((grid%8==0)?(block%8)*(grid/8)+block/8:block),G(grid){}
  __device__ __forceinline__ bool next(int i,AttnUnit&u)const{ const int p=vcu+(i>>1)*G; if(p>=BATCH*NHEAD*4)return false; const int s=p&3; u.bh=p>>2; u.qb=(i&1)?7-s:s; return true; }
  __device__ __forceinline__ void a_ready(const AttnUnit&)const{}
  __device__ __forceinline__ void done(const AttnUnit&)const{}
};
template<class Sched,int THRL=8> __device__ __forceinline__ void attn_phase(char*lds,const AttnTensors&T,const Sched&S){
  AttnUnit u;
  for(int i=0;S.next(i,u);++i){ S.a_ready(u); attn_unit<THRL>(u.bh/NHEAD,u.bh%NHEAD,u.qb,T.Q,T.K,T.V,T.Y,T.ksum,T.onb_g,T.seldump,lds); S.done(u); }
}
#undef SBAR
#undef WAIT_BAR
}
constexpr int NWAVES = 8;
#ifndef MK_N_LAUNCHES
#define MK_N_LAUNCHES 1
#endif
constexpr int PER_PHASE = 6;
constexpr int CW_TMO = 0, CW_CODE = 1, CW_EXIT = 2, CW_START = 64;
constexpr int CW_BAR = 4096;
constexpr int RING_OFF = 0, RING_BYTES = 131072;
constexpr int LDSCTL_OFF = RING_BYTES, MISC_OFF = LDSCTL_OFF + 320;
constexpr int LDS_BYTES = 147456;
constexpr int PAR_OFF = LDSCTL_OFF + 1024;
constexpr int RSL_OFF = PAR_OFF + 5120;
static_assert(MISC_OFF + 128 <= PAR_OFF && PAR_OFF + 1152 * 4 <= RSL_OFF && RSL_OFF + 2048 <= LDS_BYTES, "LDS map");

#define GAS __attribute__((address_space(1)))
#define LAS __attribute__((address_space(3)))
typedef unsigned short bf16;
typedef unsigned v4u __attribute__((ext_vector_type(4)));
typedef float f32x4 __attribute__((ext_vector_type(4)));
typedef short bf16x8 __attribute__((ext_vector_type(8)));
typedef GAS unsigned gu32;
typedef GAS unsigned long long gu64;
#define RLX_AGENT __ATOMIC_RELAXED, __HIP_MEMORY_SCOPE_AGENT
#define LDS_WAIT() asm volatile("s_waitcnt lgkmcnt(0)" ::: "memory")
#define VM_WAIT() asm volatile("s_waitcnt vmcnt(0)" ::: "memory")
__device__ __forceinline__ unsigned long long rt() { return __builtin_amdgcn_s_memrealtime(); }
__device__ __forceinline__ unsigned f2bf(float f) { unsigned u = __builtin_bit_cast(unsigned, f); return (u + 0x7fffu + ((u >> 16) & 1u)) >> 16; }
__device__ __forceinline__ unsigned pk2(float lo, float hi) { return f2bf(lo) | (f2bf(hi) << 16); }

#define XB_TMO      128
#define XB_XCNT(j)  (256  + 64 * (j))
#define XB_XSUB(j)  (1280 + 64 * (j))
#define XB_XGEN(j)  (2304 + 64 * (j))
#define XB_TOP      3328
#define XB_TOPGEN   3392
#define XCD_BAR_WORDS 3456
#define XB_SPIN_CAP (1u << 18)

__device__ __forceinline__ unsigned xb_ld(unsigned* p)              { return __hip_atomic_load(p, __ATOMIC_RELAXED, __HIP_MEMORY_SCOPE_AGENT); }
__device__ __forceinline__ unsigned xb_add(unsigned* p, unsigned v) { return __hip_atomic_fetch_add(p, v, __ATOMIC_RELAXED, __HIP_MEMORY_SCOPE_AGENT); }
__device__ __forceinline__ unsigned xb_xcc_id() { return (unsigned)__builtin_amdgcn_s_getreg((3 << 11) | 20) & 0xFu; }
#define XB_SPIN(cond, bar) do { unsigned _sp = 0; while (cond) { __builtin_amdgcn_s_sleep(1); \
    if ((++_sp & 255u) == 0u) { if (xb_ld(&(bar)[XB_TMO])) break; if (_sp > XB_SPIN_CAP) { atomicAdd(&(bar)[XB_TMO], 1u); break; } } } } while (0)

struct XcdBarrier {
    unsigned* bar; unsigned x;
    volatile LAS unsigned* st;
};

__device__ __forceinline__ XcdBarrier xcd_barrier_post(unsigned* bar, volatile LAS unsigned* st) {
    XcdBarrier b; b.bar = bar; b.x = xb_xcc_id(); b.st = st;
    if (threadIdx.x == 0) (void)xb_add(&bar[XB_XCNT(b.x)], 1u);
    return b;
}
__device__ __forceinline__ void xcd_barrier_complete(unsigned* bar, unsigned x, unsigned& nloc, unsigned& nx) {
    const unsigned G = gridDim.x * gridDim.y * gridDim.z;
    unsigned sum, cnt, mine, sp = 0u;
    for (;;) {
        sum = 0u; cnt = 0u; mine = 0u;
#pragma unroll
        for (unsigned j = 0; j < 16; ++j) { const unsigned c = xb_ld(&bar[XB_XCNT(j)]); sum += c; cnt += (c > 0u) ? 1u : 0u; mine = (j == x) ? c : mine; }
        if (sum == G) break;
        __builtin_amdgcn_s_sleep(1);
        if ((++sp & 255u) == 0u) { if (xb_ld(&bar[XB_TMO])) break; if (sp > XB_SPIN_CAP) { atomicAdd(&bar[XB_TMO], 1u); break; } }
    }
    nloc = mine > 0u ? mine : 1u; nx = cnt > 0u ? cnt : 1u;
}

__device__ __forceinline__ void xcd_barrier(const XcdBarrier& b) {
    asm volatile("s_waitcnt vmcnt(0)" ::: "memory");
    __syncthreads();
    if (threadIdx.x == 0) {
        unsigned* bar = b.bar;
        __builtin_amdgcn_s_waitcnt(0);
        unsigned nloc = b.st[0], nx = b.st[1];
        if (nloc == 0u) { xcd_barrier_complete(bar, b.x, nloc, nx); b.st[0] = nloc; b.st[1] = nx; }
        const unsigned old = xb_add(&bar[XB_XSUB(b.x)], 1u);
        const unsigned gen = old / nloc;
        if (old + 1u == (gen + 1u) * nloc) {
            __builtin_amdgcn_fence(__ATOMIC_RELEASE, "agent");
            asm volatile("s_waitcnt vmcnt(0)" ::: "memory");
            const unsigned og = xb_add(&bar[XB_TOP], 1u);
            const unsigned tg = og / nx;
            if (og + 1u == (tg + 1u) * nx) xb_add(&bar[XB_TOPGEN], 1u);
            else XB_SPIN(xb_ld(&bar[XB_TOPGEN]) == tg, bar);
            __builtin_amdgcn_fence(__ATOMIC_ACQUIRE, "agent");
            xb_add(&bar[XB_XGEN(b.x)], 1u);
            asm volatile("s_waitcnt vmcnt(0)" ::: "memory");
        } else {
            XB_SPIN(xb_ld(&bar[XB_XGEN(b.x)]) == gen, bar);
            __builtin_amdgcn_fence(__ATOMIC_ACQUIRE, "agent");
            asm volatile("s_waitcnt vmcnt(0)" ::: "memory");
        }
    }
    __syncthreads();
}

struct Frame {
    LAS unsigned char* lds;
    volatile LAS unsigned* MISC;
    gu32* ctl;
    int tid, lane, wave;
    int vcu, G;
};

__device__ __forceinline__ float wave_sum(float v) {
#pragma unroll
    for (int o = 1; o < 64; o <<= 1) v += __shfl_xor(v, o);
    return v;
}
struct WTile { const float* W; const float* g; void* WT; int K, N, k0, n0; float scale; int f8, gu; };
constexpr int WT_S = 257;
__device__ __forceinline__ void wtile_load(const WTile& t, int wave, int lane, f32x4 (&v)[8]) {
#pragma unroll
    for (int i = 0; i < 8; ++i) v[i] = *(const GAS f32x4*)(t.W + (size_t)(t.k0 + wave + 8 * i) * t.N + t.n0 + 4 * lane);
}
__device__ __forceinline__ void wtile_store(const WTile& t, int tid, int wave, int lane, const f32x4 (&v)[8], LAS float* scr) {
#pragma unroll
    for (int i = 0; i < 8; ++i) { const int kk = wave + 8 * i; const float sc = t.g ? t.g[t.k0 + kk] * t.scale : t.scale; const f32x4 x = v[i] * sc;
        LAS float* p = scr + kk * WT_S + 4 * lane; p[0] = x.x; p[1] = x.y; p[2] = x.z; p[3] = x.w; }
    LDS_WAIT(); __syncthreads();
    if (!t.f8) {
#pragma unroll
        for (int j = 0; j < 4; ++j) { const int p = tid + 512 * j, c = p & 7, n = p >> 3; const LAS float* s = scr + (8 * c) * WT_S + n;
            v4u o; o.x = pk2(s[0 * WT_S], s[1 * WT_S]); o.y = pk2(s[2 * WT_S], s[3 * WT_S]); o.z = pk2(s[4 * WT_S], s[5 * WT_S]); o.w = pk2(s[6 * WT_S], s[7 * WT_S]);
            const int jn = t.n0 + n, row = t.gu ? ((jn >> 7) * 256 + (jn & 127) + (t.gu == 2 ? 128 : 0)) : jn;
            *(GAS v4u*)((bf16*)t.WT + (size_t)row * t.K + t.k0 + 8 * c) = o; }
    } else {
#pragma unroll
        for (int j = 0; j < 2; ++j) { const int p = tid + 512 * j, c = p & 3, n = p >> 2; const LAS float* s = scr + (16 * c) * WT_S + n;
            int w[4];
#pragma unroll
            for (int e = 0; e < 4; ++e) { w[e] = __builtin_amdgcn_cvt_pk_fp8_f32(s[(4 * e) * WT_S], s[(4 * e + 1) * WT_S], 0, false); w[e] = __builtin_amdgcn_cvt_pk_fp8_f32(s[(4 * e + 2) * WT_S], s[(4 * e + 3) * WT_S], w[e], true); }
            v4u o; o.x = (unsigned)w[0]; o.y = (unsigned)w[1]; o.z = (unsigned)w[2]; o.w = (unsigned)w[3];
            const int jn = t.n0 + n, row = t.gu ? ((jn >> 7) * 256 + (jn & 127) + (t.gu == 2 ? 128 : 0)) : jn;
            *(GAS v4u*)((unsigned char*)t.WT + (size_t)row * t.K + t.k0 + 16 * c) = o; }
    }
    LDS_WAIT(); __syncthreads();
}
template <int NR> __device__ __forceinline__ void rows_to_bf16_rstd(int lane, const float* xrow, size_t rstride, bf16* orow, float* rstd) {
    f32x4 v[NR][4];
#pragma unroll
    for (int r = 0; r < NR; ++r)
#pragma unroll
        for (int j = 0; j < 4; ++j) v[r][j] = ((const GAS f32x4*)(xrow + r * rstride) + lane)[64 * j];
#pragma unroll
    for (int r = 0; r < NR; ++r) { float s = 0.f;
#pragma unroll
        for (int j = 0; j < 4; ++j) s += (v[r][j].x * v[r][j].x + v[r][j].y * v[r][j].y) + (v[r][j].z * v[r][j].z + v[r][j].w * v[r][j].w);
        const float rs = 1.f / sqrtf(wave_sum(s) * (1.f / DM) + EPS); if (lane == 0) rstd[r] = rs;
        GAS unsigned long long* o8 = (GAS unsigned long long*)(orow + r * rstride) + lane;
#pragma unroll
        for (int j = 0; j < 4; ++j) o8[64 * j] = (unsigned long long)pk2(v[r][j].x, v[r][j].y) | ((unsigned long long)pk2(v[r][j].z, v[r][j].w) << 32); }
}
struct P0Args { const float *x, *norm1_g, *w_in, *sgu_w, *w_out, *norm2_g, *w_gate, *w_up, *w_down; bf16 *WinT, *WoT; unsigned char *WguQ, *WdQ; bf16 *SW, *XN; float* rstd1; };
constexpr int WT_IN = (DM / 64) * (INW / 256), WT_O = (DM / 64) * (DM / 256), WT_G = (DM / 64) * (DFF / 256), WT_D = (DFF / 64) * (DM / 256);
__device__ __forceinline__ int wset_count(int set) { return set == 0 ? WT_IN : set == 1 ? WT_O + 2 * WT_G : WT_D; }
__device__ __forceinline__ WTile wset_tile(const P0Args& a, int set, int r) {
    if (set == 0) { const int nb = INW / 256; return WTile{a.w_in, a.norm1_g, a.WinT, DM, INW, 64 * (r / nb), 256 * (r % nb), 1.0f, 0, 0}; }
    if (set == 2) { const int nb = DM / 256; return WTile{a.w_down, nullptr, a.WdQ, DFF, DM, 64 * (r / nb), 256 * (r % nb), WD_SCALE, 1, 0}; }
    if (r < WT_O) { const int nb = DM / 256; return WTile{a.w_out, nullptr, a.WoT, DM, DM, 64 * (r / nb), 256 * (r % nb), 1.0f, 0, 0}; } r -= WT_O;
    { const bool up = r >= WT_G; if (up) r -= WT_G; const int nb = DFF / 256; return WTile{up ? a.w_up : a.w_gate, a.norm2_g, a.WguQ, DM, DFF, 64 * (r / nb), 256 * (r % nb), WGU_SCALE, 1, up ? 2 : 1}; }
}
__device__ __forceinline__ void wset_convert(Frame& F, const P0Args& a, int set, int wg, int nwg) {
    LAS float* scr = (LAS float*)(F.lds + RING_OFF);
    const int cnt = wset_count(set); int r = wg; if (r >= cnt) return;
    WTile cur = wset_tile(a, set, r); f32x4 v[8], vn[8]; wtile_load(cur, F.wave, F.lane, v);
    for (;;) {
        const int rn = r + nwg; const bool more = rn < cnt; WTile nxt = cur;
        if (more) { nxt = wset_tile(a, set, rn); wtile_load(nxt, F.wave, F.lane, vn); }
        wtile_store(cur, F.tid, F.wave, F.lane, v, scr);
        if (!more) break;
#pragma unroll
        for (int i = 0; i < 8; ++i) v[i] = vn[i];
        cur = nxt; r = rn;
    }
}
__device__ __forceinline__ void p0_prologue(Frame& F, const P0Args& a) {
    const int gw = F.vcu * NWAVES + F.wave, NGW = F.G * NWAVES;
    wset_convert(F, a, 0, F.vcu, F.G);
    for (int m = 4 * gw; m < M; m += 4 * NGW) rows_to_bf16_rstd<4>(F.lane, a.x + (size_t)m * DM, DM, a.XN + (size_t)m * DM, a.rstd1 + m);
    for (int i = (F.vcu * NWAVES * 64 + F.tid); i < NH * CHUNK * CHUNK; i += F.G * NWAVES * 64) { const int t = (i / CHUNK) % CHUNK, s = i % CHUNK; a.SW[i] = (bf16)f2bf(s <= t ? a.sgu_w[i] : 0.0f); }
}

constexpr int SGU_V_BYTES = 16384, SGU_U_PITCH = 144, SGU_U_BYTES = 128 * SGU_U_PITCH, SGU_UOFF = 2 * SGU_V_BYTES;
struct SguArgs { const bf16* P; const bf16* SW; const float* sgu_b; const float* ona_g; bf16* Y; };
typedef float f32x16 __attribute__((ext_vector_type(16)));
typedef short s16x4 __attribute__((ext_vector_type(4)));
typedef unsigned u32x2 __attribute__((ext_vector_type(2)));
__device__ __forceinline__ int crow16(int r, int hi) { return (r & 3) + 8 * (r >> 2) + 4 * hi; }
struct SguStage { v4u vv[4], uu[4]; };
__device__ __forceinline__ void sgu_load(const SguArgs& a, int unit, int tid, SguStage& s) {
    const int b = unit >> 6, c = (unit >> 2) & 15, hp = unit & 3; const size_t row0 = (size_t)b * SEQ + c * CHUNK;
#pragma unroll
    for (int k = 0; k < 4; ++k) { const int i = tid + 512 * k, hl = i >> 10, row = (i >> 3) & 127, ch = i & 7;
        const bf16* src = a.P + (row0 + row) * INW + (2 * hp + hl) * 64 + ch * 8;
        s.vv[k] = *(const GAS v4u*)(src + COL_VA); s.uu[k] = *(const GAS v4u*)(src + COL_U); }
}
__device__ __forceinline__ void sgu_unit(Frame& F, const SguArgs& a, int unit, SguStage& st, int next_unit) {
    const int b = unit >> 6, c = (unit >> 2) & 15, hp = unit & 3;
    int tid_ = threadIdx.x; asm volatile("" : "+v"(tid_)); const int tid = tid_, lane = tid & 63, wid = F.wave, r32 = lane & 31, hi = lane >> 5;
    const size_t row0 = (size_t)b * SEQ + c * CHUNK;
    const int hl = wid >> 2, h = 2 * hp + hl, t0 = 32 * (wid & 3);
    const bf16* wrow = a.SW + ((size_t)h * CHUNK + t0 + r32) * CHUNK + 8 * hi;
    bf16x8 wf[8];
#pragma unroll
    for (int q = 0; q < 8; ++q) if (16 * q < t0 + 32) wf[q] = *(const GAS bf16x8*)(wrow + 16 * q);
#pragma unroll
    for (int k = 0; k < 4; ++k) { const int i = tid + 512 * k, hl2 = i >> 10, row = (i >> 3) & 127, ch = i & 7;
        *(LAS v4u*)(F.lds + RING_OFF + hl2 * SGU_V_BYTES + (ch >> 2) * 8192 + row * 64 + (ch & 3) * 16) = st.vv[k];
        *(LAS v4u*)(F.lds + RING_OFF + SGU_UOFF + hl2 * SGU_U_BYTES + row * SGU_U_PITCH + ch * 16) = st.uu[k]; }
    LDS_WAIT(); __syncthreads();
    if (next_unit >= 0) sgu_load(a, next_unit, tid, st);
    f32x16 acc[2]; acc[0] = f32x16{}; acc[1] = f32x16{};
    const LAS unsigned char* vbase = F.lds + RING_OFF + hl * SGU_V_BYTES + (8 * hi + ((lane & 15) >> 2)) * 64 + 32 * ((lane >> 4) & 1) + 8 * (lane & 3);
#pragma unroll
    for (int q = 0; q < 8; ++q) if (16 * q < t0 + 32) {
#pragma unroll
        for (int d0 = 0; d0 < 2; ++d0) {
            const s16x4 lo = __builtin_bit_cast(s16x4, __builtin_amdgcn_ds_read_tr16_b64_v4i16((LAS s16x4*)(vbase + d0 * 8192 + q * 1024)));
            const s16x4 hh = __builtin_bit_cast(s16x4, __builtin_amdgcn_ds_read_tr16_b64_v4i16((LAS s16x4*)(vbase + d0 * 8192 + q * 1024 + 256)));
            const bf16x8 vf = (bf16x8){lo[0], lo[1], lo[2], lo[3], hh[0], hh[1], hh[2], hh[3]};
            acc[d0] = __builtin_amdgcn_mfma_f32_32x32x16_bf16(vf, wf[q], acc[d0], 0, 0, 0);
        }
    }
    const float bias = a.sgu_b[h * CHUNK + t0 + r32];
    LAS unsigned char* urow = F.lds + RING_OFF + SGU_UOFF + hl * SGU_U_BYTES + (t0 + r32) * SGU_U_PITCH;
    float y[2][16]; float ss = 0.f;
#pragma unroll
    for (int d0 = 0; d0 < 2; ++d0)
#pragma unroll
        for (int g = 0; g < 4; ++g) { const u32x2 uw = *(const LAS u32x2*)(urow + (32 * d0 + 8 * g + 4 * hi) * 2);
            const float u0 = __builtin_bit_cast(float, uw.x << 16), u1 = __builtin_bit_cast(float, uw.x & 0xffff0000u), u2 = __builtin_bit_cast(float, uw.y << 16), u3 = __builtin_bit_cast(float, uw.y & 0xffff0000u);
            y[d0][4 * g + 0] = u0 * (acc[d0][4 * g + 0] + bias); y[d0][4 * g + 1] = u1 * (acc[d0][4 * g + 1] + bias); y[d0][4 * g + 2] = u2 * (acc[d0][4 * g + 2] + bias); y[d0][4 * g + 3] = u3 * (acc[d0][4 * g + 3] + bias);
            ss += (y[d0][4 * g] * y[d0][4 * g] + y[d0][4 * g + 1] * y[d0][4 * g + 1]) + (y[d0][4 * g + 2] * y[d0][4 * g + 2] + y[d0][4 * g + 3] * y[d0][4 * g + 3]); }
    ss += __shfl_xor(ss, 32);
    const float rs = __builtin_amdgcn_rsqf(ss * (1.0f / 64.0f) + EPS);
#pragma unroll
    for (int d0 = 0; d0 < 2; ++d0)
#pragma unroll
        for (int g = 0; g < 4; ++g) { const f32x4 gg = *(const GAS f32x4*)(a.ona_g + h * 64 + 32 * d0 + 8 * g + 4 * hi);
            u32x2 w; w.x = pk2(y[d0][4 * g] * rs * gg.x, y[d0][4 * g + 1] * rs * gg.y); w.y = pk2(y[d0][4 * g + 2] * rs * gg.z, y[d0][4 * g + 3] * rs * gg.w);
            *(LAS u32x2*)(urow + (32 * d0 + 8 * g + 4 * hi) * 2) = w; }
    LDS_WAIT(); asm volatile("" ::: "memory");
#pragma unroll
    for (int i = 0; i < 4; ++i) { const int row = t0 + i * 8 + (lane >> 3), ch = lane & 7;
        const v4u vv = *(const LAS v4u*)(F.lds + RING_OFF + SGU_UOFF + hl * SGU_U_BYTES + row * SGU_U_PITCH + ch * 16);
        *(GAS v4u*)(a.Y + (row0 + row) * DM + h * 64 + ch * 8) = vv; }
    LDS_WAIT(); __syncthreads();
}

#ifndef XPROBE
#define XPROBE 0
#endif
#ifndef DIAG
#define DIAG 0
#endif
struct Args { const float* in[16]; float* out; unsigned char* ws; int ph_lo, ph_hi; };
__global__ void __launch_bounds__(NWAVES * 64, 2) mega_fwd(Args args) {
    extern __shared__ __attribute__((aligned(16))) unsigned char lds[];
#ifdef LEAK_PRE
    const unsigned long long stA_ = __builtin_amdgcn_s_memrealtime();
#endif
    Frame F;
    F.lds = (LAS unsigned char*)lds;
    F.MISC = (volatile LAS unsigned*)(F.lds + MISC_OFF);
    F.tid = threadIdx.x; F.lane = F.tid & 63; F.wave = __builtin_amdgcn_readfirstlane(F.tid >> 6);
    F.G = gridDim.x; { const int bx = blockIdx.x; F.vcu = (F.G % 8 == 0) ? (bx % 8) * (F.G / 8) + bx / 8 : bx; }
    unsigned char* ws = args.ws;
    F.ctl = (gu32*)(ws + WS_CTL);
    const float* x = args.in[0]; const float* norm1_g = args.in[1]; const float* w_in = args.in[2]; const float* ln_g = args.in[3]; const float* ln_b = args.in[4];
    const float* sgu_w = args.in[5]; const float* sgu_b = args.in[6]; const float* q_g = args.in[7]; const float* k_g = args.in[8]; const float* ona_g = args.in[9]; const float* onb_g = args.in[10];
    const float* w_out = args.in[11]; const float* norm2_g = args.in[12]; const float* w_gate = args.in[13]; const float* w_up = args.in[14]; const float* w_down = args.in[15];
    float* out = args.out;
    bf16* WinT = (bf16*)(ws + WS_WIN); bf16* WoT = (bf16*)(ws + WS_WO); unsigned char* WguQ = ws + WS_WGU; unsigned char* WdQ = ws + WS_WD; unsigned char* X1Q = ws + WS_X1Q; bf16* SW = (bf16*)(ws + WS_SW);
    float* ksum = (float*)(ws + WS_KSUM); float* rowss = (float*)(ws + WS_ROWSS);
    bf16* XN = (bf16*)(ws + WS_XN); bf16* X1B = (bf16*)(ws + WS_X1B); float* rstd1 = (float*)(ws + WS_RSTD1); bf16* Yb = (bf16*)(ws + WS_Y); bf16* PROJ = (bf16*)(ws + WS_PROJ); unsigned char* HIDQ = ws + WS_PROJ;
    const bool IN_PH1 = (args.ph_lo <= 1 && 1 < args.ph_hi);
    for (int u = F.tid; u < (PAR_OFF - LDSCTL_OFF) / 4; u += NWAVES * 64) ((LAS unsigned*)(F.lds + LDSCTL_OFF))[u] = 0u;
    if (IN_PH1) { LAS float* par = (LAS float*)(F.lds + PAR_OFF);
        for (int i = F.tid; i < 1152; i += NWAVES * 64) par[i] = (i < 512) ? ln_g[i] : (i < 1024) ? ln_b[i - 512] : (i < 1088) ? q_g[i - 1024] * C2 : k_g[i - 1088]; }
    __syncthreads();
    const bool one_launch = (args.ph_hi - args.ph_lo) > 1;
    if (one_launch) {
        gu32* start = F.ctl + CW_START; constexpr unsigned MAGIC = 0x600DF1A6u;
        if (blockIdx.x == 0) {
            for (int i = F.tid; i < XCD_BAR_WORDS; i += NWAVES * 64) F.ctl[CW_BAR + i] = 0u;
            if (F.tid < 64) F.ctl[F.tid] = 0u;
            asm volatile("s_waitcnt vmcnt(0)" ::: "memory"); __syncthreads();
            if (F.tid == 0) { __builtin_amdgcn_fence(__ATOMIC_RELEASE, "agent"); asm volatile("s_waitcnt vmcnt(0)" ::: "memory"); __hip_atomic_store(start, MAGIC, RLX_AGENT); }
        } else {
            if (F.tid == 0) { unsigned sp = 0; while (__hip_atomic_load(start, RLX_AGENT) != MAGIC) { __builtin_amdgcn_s_sleep(2); if (++sp > (1u << 22)) break; }
                __builtin_amdgcn_fence(__ATOMIC_ACQUIRE, "agent"); asm volatile("s_waitcnt vmcnt(0)" ::: "memory"); }
            __syncthreads();
        }
    }
    XcdBarrier bar; bar.bar = (unsigned*)(F.ctl + CW_BAR); bar.x = 0; bar.st = nullptr;
    if (one_launch) bar = xcd_barrier_post((unsigned*)(F.ctl + CW_BAR), F.MISC + 8);
    const int lo = args.ph_lo, hi = args.ph_hi;
#ifndef LEAK_PHASE
#define LEAK_PHASE -1
#define LEAK_MULT 4ull
#endif
#if LEAK_PHASE >= 0
    unsigned long long st_[10], sc_[10]; int ns_ = 0; const bool stamper_ = (blockIdx.x == 0 && F.tid == 0);
#define STAMP() do { st_[ns_ < 9 ? ns_ : 9] = __builtin_amdgcn_s_memrealtime(); sc_[ns_ < 9 ? ns_ : 9] = __builtin_amdgcn_s_memtime(); ++ns_; } while (0)
    STAMP();
#else
#define STAMP() do {} while (0)
#endif
#ifndef PH_MASK
#define PH_MASK 63
#endif
#define IN(k) (((PH_MASK >> (k)) & 1) && lo <= (k) && (k) < hi)
#define BOTH(k) (IN(k) && IN((k) + 1))
#define GRID_BAR() xcd_barrier(bar)
#ifndef REP_MASK
#define REP_MASK 0
#endif
#define REPS(k) for (int rep_ = 0; rep_ <= ((REP_MASK >> (k)) & 1); ++rep_)

#ifdef WARM_SPIN
    { pg8::f32x4 wacc = {0.f, 0.f, 0.f, 0.f}; pg8::bf16x8 wa = {1, 2, 3, 4, 5, 6, 7, 8}; asm volatile("" : "+v"(wa));
      for (int i = 0; i < WARM_SPIN; ++i) { wacc = __builtin_amdgcn_mfma_f32_16x16x32_bf16(wa, wa, wacc, 0, 0, 0); }
      if (wacc[0] == 123.456f) rowss[0] = wacc[1]; STAMP(); }
#endif
#ifdef TOUCH_W
    { const float* wl_[4] = {w_out, w_gate, w_up, w_down}; const size_t nb_[4] = {(size_t)DM * DM * 4, (size_t)DM * DFF * 4, (size_t)DM * DFF * 4, (size_t)DFF * DM * 4};
#pragma unroll
      for (int q = 0; q < 4; ++q) for (size_t o = ((size_t)blockIdx.x * 512 + F.tid) * 4096; o < nb_[q]; o += (size_t)F.G * 512 * 4096) { volatile const unsigned* p = (volatile const unsigned*)((const unsigned char*)wl_[q] + o); (void)*p; } }
#endif
#ifdef TOUCH_PAGES
    { const size_t lo_ = WS_Y, hi_ = WS_END; for (size_t o = lo_ + ((size_t)blockIdx.x * 512 + F.tid) * 4096; o < hi_; o += (size_t)F.G * 512 * 4096) { volatile unsigned* p = (volatile unsigned*)(ws + o); (void)*p; }
      for (size_t o = ((size_t)blockIdx.x * 512 + F.tid) * 4096; o < (size_t)M * DM * 4; o += (size_t)F.G * 512 * 4096) { volatile unsigned* p = (volatile unsigned*)((unsigned char*)out + o); (void)*p; } }
#endif
    const P0Args p0a{x, norm1_g, w_in, sgu_w, w_out, norm2_g, w_gate, w_up, w_down, WinT, WoT, WguQ, WdQ, SW, XN, rstd1};
    const bool late_in_p1 = (F.G == 256) && IN(0) && IN(1) && IN(4);
    REPS(0) if (IN(0)) { p0_prologue(F, p0a); if (!late_in_p1) { wset_convert(F, p0a, 1, F.vcu, F.G); wset_convert(F, p0a, 2, F.vcu, F.G); } if (BOTH(0)) GRID_BAR(); }

    STAMP();
    REPS(1) if (IN(1)) {
#if 0
#else
        pg8::Gemm g{XN, WinT, M, INW, DM}; pg8::P1Unit U; U.init(M, INW, F.G, (int)blockIdx.x);
        U.P = PROJ; U.par = (const LAS float*)(F.lds + PAR_OFF); U.ksum = ksum; U.rp.src = rstd1; U.rp.slots = (LAS float*)(F.lds + RSL_OFF); U.rp.mul = 1.0f;
        pg8::gemm_phase<pg8::P1Unit, pg8::P1Unit, PG8_ALIGN, PG8_SP2>(F.lds + RING_OFF, g, U, U);
#endif
        if (late_in_p1 && blockIdx.x >= 128) wset_convert(F, p0a, 1, (int)blockIdx.x - 128, 128);
        if (BOTH(1)) GRID_BAR();
    }

    STAMP();
#if XPROBE == 12
    { GRID_BAR(); STAMP(); GRID_BAR(); STAMP(); }
#endif
#if XPROBE == 11
    { GRID_BAR(); STAMP(); }
#endif
#if XPROBE == 10
    { if (blockIdx.x >= 128) { float sacc = 0.f;
        for (int r = (int)blockIdx.x - 128; r < 416; r += 128) { const float* base = (const float*)(ws + WS_PROJ) + (size_t)r * 16384 + F.wave * 2048; f32x4 v[8];
#pragma unroll
            for (int i = 0; i < 8; ++i) v[i] = *(const GAS f32x4*)(base + 256 * i + 4 * F.lane);
#pragma unroll
            for (int i = 0; i < 8; ++i) sacc += v[i].x + v[i].y + v[i].z + v[i].w; }
        if (sacc == 123.456f) rowss[1] = sacc; }
      GRID_BAR(); STAMP(); }
#endif
#if XPROBE == 9
    { if (blockIdx.x >= 128) { float sacc = 0.f;
        for (int r = (int)blockIdx.x - 128; r < 416; r += 128) { const float* base = (r < 64 ? w_out + (size_t)r * 16384 : r < 240 ? w_gate + (size_t)(r - 64) * 16384 : w_up + (size_t)(r - 240) * 16384) + F.wave * 2048; f32x4 v[8];
#pragma unroll
            for (int i = 0; i < 8; ++i) v[i] = *(const GAS f32x4*)(base + 256 * i + 4 * F.lane);
#pragma unroll
            for (int i = 0; i < 8; ++i) sacc += v[i].x + v[i].y + v[i].z + v[i].w; }
        if (sacc == 123.456f) rowss[1] = sacc; }
      GRID_BAR(); STAMP(); }
#endif
#if XPROBE == 8
    { if (blockIdx.x >= 128) { float sacc = 0.f; const int cnt = wset_count(1);
        for (int r = (int)blockIdx.x - 128; r < cnt; r += 512) {
            f32x4 v[4][8];
#pragma unroll
            for (int q = 0; q < 4; ++q) if (r + 128 * q < cnt) { const WTile t = wset_tile(p0a, 1, r + 128 * q); wtile_load(t, F.wave, F.lane, v[q]); }
#pragma unroll
            for (int q = 0; q < 4; ++q) if (r + 128 * q < cnt) {
#pragma unroll
                for (int i = 0; i < 8; ++i) sacc += v[q][i].x + v[q][i].y + v[q][i].z + v[q][i].w; } }
        if (sacc == 123.456f) rowss[1] = sacc; }
      GRID_BAR(); STAMP(); }
#endif
#if XPROBE == 7
    { if (blockIdx.x >= 128) wset_convert(F, p0a, 1, (int)blockIdx.x - 128, 128); GRID_BAR(); STAMP(); }
#endif
#if XPROBE == 6
    { pg8::Gemm g{XN, WinT, M, INW, DM}; pg8::StaticOrder S; S.init(M, INW, F.G, (int)blockIdx.x);
      pg8::P1Unit U; U.init(M, INW, F.G, (int)blockIdx.x); U.P = PROJ; U.par = (const LAS float*)(F.lds + PAR_OFF); U.ksum = ksum; U.rp.src = rstd1; U.rp.slots = (LAS float*)(F.lds + RSL_OFF); U.rp.mul = 1.0f;
      pg8::gemm_phase<pg8::P1Unit, pg8::P1Unit, PG8_ALIGN, PG8_SP2>(F.lds + RING_OFF, g, U, U);
      GRID_BAR(); STAMP(); }
#endif
#if XPROBE == 3
    { pg8::Gemm g{XN, WinT, M, INW, DM}; pg8::StaticOrder S; S.init(M, INW, F.G, (int)blockIdx.x);
      pg8::EpiNull E{rowss};
      pg8::gemm_phase<pg8::EpiNull, pg8::StaticOrder, PG8_ALIGN, PG8_SP2>(F.lds + RING_OFF, g, S, E);
      GRID_BAR(); STAMP(); }
#endif
    REPS(2) if (IN(2)) {
        const SguArgs sa{PROJ, SW, sgu_b, ona_g, Yb};
        { SguStage sst; int u = F.vcu; if (u < BATCH * 16 * 4) sgu_load(sa, u, F.tid, sst);
          for (; u < BATCH * 16 * 4; u += F.G) { const int un = u + F.G; sgu_unit(F, sa, u, sst, un < BATCH * 16 * 4 ? un : -1); } }
#ifdef STAMP_SGU
        STAMP();
#endif
        static_assert(attn_body::ATTN_LDS_BYTES <= RING_BYTES && attn_body::ATTN_PITCH == INW, "attention body geometry vs frame");
        const attn_body::AttnTensors AT{(const attn_body::bf16*)(PROJ + COL_Q), (const attn_body::bf16*)(PROJ + COL_K), (const attn_body::bf16*)(PROJ + COL_V), (attn_body::bf16*)(Yb + WA), ksum, onb_g, DIAG ? (unsigned*)(ws + 234 * MiB) : nullptr};
        const attn_body::StaticOrder S((int)F.G, (int)blockIdx.x);
        attn_body::attn_phase<attn_body::StaticOrder>((char*)lds + RING_OFF, AT, S);
        if (BOTH(2)) GRID_BAR();
    }

    STAMP();
    REPS(3) if (IN(3)) {
        pg8::Gemm g{Yb, WoT, M, DM, DM}; pg8::StaticOrder S; S.init(M, DM, F.G, (int)blockIdx.x);
        pg8::EpiOutProj E{XN, X1B, X1Q, rowss};
        if (F.G == 256) pg8::gemm_phase<pg8::EpiOutProj, pg8::StaticOrder, false, PG8_SP2>(F.lds + RING_OFF, g, S, E);
        if (BOTH(3)) GRID_BAR();
    }

    STAMP();
#if XPROBE == 13
    { GRID_BAR(); STAMP(); }
#endif
    REPS(4) if (IN(4)) {
        pg8::Gemm g{(const bf16*)X1Q, (const bf16*)WguQ, M, NGU, DM / 2}; pg8::P4Unit U; U.init(M, NGU, F.G, (int)blockIdx.x);
        U.H = HIDQ; U.rp.src = rowss; U.rp.slots = (LAS float*)(F.lds + RSL_OFF); U.rp.mul = 1.0f / WGU_SCALE;
        pg8::gemm_phase<pg8::P4Unit, pg8::P4Unit, PG8_ALIGN, PG8_SP2, true>(F.lds + RING_OFF, g, U, U);
        if (late_in_p1 && blockIdx.x >= 128) wset_convert(F, p0a, 2, (int)blockIdx.x - 128, 128);
        if (BOTH(4)) GRID_BAR();
    }

    STAMP();
#if XPROBE == 4 || XPROBE == 5
    for (int rp_ = 0; rp_ < (XPROBE == 5 ? 2 : 1); ++rp_)
    { pg8::Gemm g{XN, WinT, M, INW, DM}; pg8::StaticOrder S; S.init(M, INW, F.G, (int)blockIdx.x);
      pg8::EpiNull E{rowss};
      pg8::gemm_phase<pg8::EpiNull, pg8::StaticOrder, PG8_ALIGN, PG8_SP2>(F.lds + RING_OFF, g, S, E);
      GRID_BAR(); STAMP(); }
#endif
#if XPROBE == 1 || XPROBE == 2
    { constexpr int KX = (XPROBE == 1) ? DM : DM / 2;
      pg8::Gemm g{X1B, (const bf16*)WguQ, M, NGU, KX}; pg8::StaticOrder S; S.init(M, NGU, F.G, (int)blockIdx.x);
      pg8::EpiNull E{rowss};
      pg8::gemm_phase<pg8::EpiNull, pg8::StaticOrder, PG8_ALIGN, PG8_SP2>(F.lds + RING_OFF, g, S, E);
      GRID_BAR(); STAMP(); }
#endif
    REPS(5) if (IN(5)) {
        pg8::Gemm g{(const bf16*)HIDQ, (const bf16*)WdQ, M, DM, DFF / 2}; pg8::StaticOrder S; S.init(M, DM, F.G, (int)blockIdx.x);
        pg8::EpiDown E{X1B, out};
        pg8::gemm_phase<pg8::EpiDown, pg8::StaticOrder, PG8_ALIGN, PG8_SP2, true>(F.lds + RING_OFF, g, S, E);
    }
    STAMP();
#if LEAK_PHASE >= 0
    if (stamper_) { const int last = ns_ - 1; unsigned long long span = (LEAK_PHASE >= 9) ? (st_[last] - st_[0]) : (st_[LEAK_PHASE + 1] - st_[LEAK_PHASE]); const unsigned long long t0 = st_[last];
#ifdef LEAK_PRE
        span = st_[0] - stA_;
#endif
#ifdef LEAK_CLOCK
        span = (sc_[LEAK_PHASE + 1] - sc_[LEAK_PHASE]) / 16 / LEAK_MULT;
#endif
#ifdef LEAK_UNIT
        { volatile LAS unsigned long long* ts = (volatile LAS unsigned long long*)(F.lds + MISC_OFF + 64); span = (LEAK_UNIT == 0) ? (ts[1] - st_[1]) : (ts[1 + LEAK_UNIT] - ts[LEAK_UNIT]); }
#endif
        while (__builtin_amdgcn_s_memrealtime() - t0 < LEAK_MULT * span) __builtin_amdgcn_s_sleep(8); }
#endif
    if (one_launch) { asm volatile("s_waitcnt vmcnt(0)" ::: "memory"); __syncthreads();
        if (F.tid == 0) { const unsigned old = __hip_atomic_fetch_add(F.ctl + CW_EXIT, 1u, RLX_AGENT); if (old == (unsigned)F.G - 1u) __hip_atomic_store(F.ctl + CW_START, 0u, RLX_AGENT); } }
#undef IN
#undef BOTH
#undef GRID_BAR
}


#ifndef NAIVE_MASK
#define NAIVE_MASK 0
#endif
#ifndef DIAG
#define DIAG 0
#endif
#ifndef DIAG_TOL
#define DIAG_TOL 0.04f
#endif
#ifndef DIAG_TRUNC
#define DIAG_TRUNC 0
#endif
#if NAIVE_MASK || DIAG
namespace naive {
typedef unsigned short bf16_t;
typedef float f32x4 __attribute__((ext_vector_type(4)));
typedef unsigned u32x4 __attribute__((ext_vector_type(4)));
__device__ __forceinline__ unsigned f2bf(float f) { unsigned u = __builtin_bit_cast(unsigned, f); return (u + 0x7fffu + ((u >> 16) & 1u)) >> 16; }
__device__ __forceinline__ float bf2f(bf16_t b) { return __builtin_bit_cast(float, (unsigned)b << 16); }
__device__ __forceinline__ float wave_sum(float v) {
#pragma unroll
    for (int o = 1; o < 64; o <<= 1) v += __shfl_xor(v, o);
    return v;
}
__device__ __forceinline__ float wave_max(float v) {
#pragma unroll
    for (int o = 1; o < 64; o <<= 1) v = fmaxf(v, __shfl_xor(v, o));
    return v;
}
__device__ __forceinline__ float gelu_tanh(float x) {
    const float z = 0.7978845608028654f * (x + 0.044715f * x * x * x);
    return x / (1.0f + __expf(-2.0f * z));
}
__device__ __forceinline__ float silu(float x) { return x / (1.0f + __expf(-x)); }

__global__ void k_rmsnorm_x(const float* __restrict__ x, const float* __restrict__ g, bf16_t* __restrict__ xn) {
    const int row = blockIdx.x * 4 + (threadIdx.x >> 6), lane = threadIdx.x & 63;
    const float* xr = x + (size_t)row * DM;
    float v[16]; float s = 0.f;
#pragma unroll
    for (int j = 0; j < 16; ++j) { v[j] = xr[lane + 64 * j]; s += v[j] * v[j]; }
    const float rstd = 1.0f / sqrtf(wave_sum(s) * (1.0f / DM) + EPS);
#pragma unroll
    for (int j = 0; j < 16; ++j) xn[(size_t)row * DM + lane + 64 * j] = (bf16_t)f2bf(v[j] * rstd * g[lane + 64 * j]);
}
__global__ void k_transpose_w(const float* __restrict__ W, int K, int N, const float* __restrict__ g, bf16_t* __restrict__ WT) {
    const size_t i = (size_t)blockIdx.x * 256 + threadIdx.x; if (i >= (size_t)K * N) return;
    const int n = (int)(i / K), k = (int)(i % K);
    WT[i] = (bf16_t)f2bf(W[(size_t)k * N + n] * (g ? g[k] : 1.0f));
}
__global__ void k_transpose_gu(const float* __restrict__ Wg, const float* __restrict__ Wu, const float* __restrict__ g, bf16_t* __restrict__ WT) {
    const size_t i = (size_t)blockIdx.x * 256 + threadIdx.x; if (i >= (size_t)2 * DFF * DM) return;
    const int r = (int)(i / DM), k = (int)(i % DM);
    const int blk = r / 256, w = r % 256, j = blk * 128 + (w & 127);
    const float* W = (w < 128) ? Wg : Wu;
    WT[i] = (bf16_t)f2bf(W[(size_t)k * DFF + j] * g[k]);
}
__global__ void k_sgu_w(const float* __restrict__ w, bf16_t* __restrict__ sw) {
    const int i = blockIdx.x * 256 + threadIdx.x; if (i >= NH * CHUNK * CHUNK) return;
    const int t = (i / CHUNK) % CHUNK, s = i % CHUNK;
    sw[i] = (bf16_t)f2bf(s <= t ? w[i] : 0.0f);
}

__device__ __forceinline__ void naive_tile(const bf16_t* __restrict__ A, int lda, const bf16_t* __restrict__ B, int ldb, int K, float (&acc)[4][4], float* As, float* Bs) {
    const int tid = threadIdx.x, ty = tid >> 4, tx = tid & 15;
    const int lr = tid >> 2, lk = (tid & 3) * 8;
#pragma unroll
    for (int i = 0; i < 4; ++i)
#pragma unroll
        for (int j = 0; j < 4; ++j) acc[i][j] = 0.f;
    for (int k0 = 0; k0 < K; k0 += 32) {
        const u32x4 av = *(const u32x4*)(A + (size_t)lr * lda + k0 + lk);
        const u32x4 bv = *(const u32x4*)(B + (size_t)lr * ldb + k0 + lk);
        __syncthreads();
#pragma unroll
        for (int e = 0; e < 4; ++e) {
            As[(lk + 2 * e) * 65 + lr] = __builtin_bit_cast(float, av[e] << 16);
            As[(lk + 2 * e + 1) * 65 + lr] = __builtin_bit_cast(float, av[e] & 0xffff0000u);
            Bs[(lk + 2 * e) * 65 + lr] = __builtin_bit_cast(float, bv[e] << 16);
            Bs[(lk + 2 * e + 1) * 65 + lr] = __builtin_bit_cast(float, bv[e] & 0xffff0000u);
        }
        __syncthreads();
#pragma unroll 8
        for (int kk = 0; kk < 32; ++kk) {
            float a[4], b[4];
#pragma unroll
            for (int i = 0; i < 4; ++i) { a[i] = As[kk * 65 + ty * 4 + i]; b[i] = Bs[kk * 65 + tx * 4 + i]; }
#pragma unroll
            for (int i = 0; i < 4; ++i)
#pragma unroll
                for (int j = 0; j < 4; ++j) acc[i][j] += a[i] * b[j];
        }
    }
}

__global__ void __launch_bounds__(256) k_inproj(const bf16_t* __restrict__ XN, const bf16_t* __restrict__ WinT, bf16_t* __restrict__ PROJ,
                                               const float* __restrict__ ln_g, const float* __restrict__ ln_b, const float* __restrict__ q_g, const float* __restrict__ k_g) {
    __shared__ float As[32 * 65], Bs[32 * 65], T[64 * 65];
    const int rb = blockIdx.x, cb = blockIdx.y;
    float acc[4][4];
    naive_tile(XN + (size_t)rb * 64 * DM, DM, WinT + (size_t)cb * 64 * DM, DM, DM, acc, As, Bs);
    const int tid = threadIdx.x, ty = tid >> 4, tx = tid & 15;
#pragma unroll
    for (int i = 0; i < 4; ++i)
#pragma unroll
        for (int j = 0; j < 4; ++j) T[(ty * 4 + i) * 65 + tx * 4 + j] = acc[i][j];
    __syncthreads();
    if (tid < 64) {
        const int seg = cb >> 3, h = cb & 7; const float* t = T + tid * 65;
        bf16_t* o = PROJ + (size_t)(rb * 64 + tid) * INW + cb * 64;
        if (seg == 0) { for (int d = 0; d < 64; ++d) o[d] = (bf16_t)f2bf(gelu_tanh(t[d])); }
        else if (seg == 1) {
            float mu = 0.f; for (int d = 0; d < 64; ++d) mu += gelu_tanh(t[d]); mu *= (1.0f / 64);
            float var = 0.f; for (int d = 0; d < 64; ++d) { const float c = gelu_tanh(t[d]) - mu; var += c * c; } var *= (1.0f / 64);
            const float rs = 1.0f / sqrtf(var + EPS);
            for (int d = 0; d < 64; ++d) o[d] = (bf16_t)f2bf((gelu_tanh(t[d]) - mu) * rs * ln_g[h * 64 + d] + ln_b[h * 64 + d]);
        } else if (seg == 2 || seg == 3) {
            float ss = 0.f; for (int d = 0; d < 64; ++d) ss += t[d] * t[d];
            const float rs = 1.0f / sqrtf(ss * (1.0f / 64) + EPS);
            const float* g = (seg == 2) ? q_g : k_g; const float sc = (seg == 2) ? C2 : 1.0f;
            for (int d = 0; d < 64; ++d) o[d] = (bf16_t)f2bf(t[d] * rs * g[d] * sc);
        } else { for (int d = 0; d < 64; ++d) o[d] = (bf16_t)f2bf(t[d]); }
    }
}
__global__ void k_kmean(const bf16_t* __restrict__ PROJ, float* __restrict__ kmean) {
    const int i = blockIdx.x * 256 + threadIdx.x;
    const int d = i & 63, h = (i >> 6) & 7, n = (i >> 9) & 7, b = i >> 12;
    float s = 0.f;
    for (int r = 0; r < MBLK; ++r) s += bf2f(PROJ[(size_t)(b * SEQ + n * MBLK + r) * INW + COL_K + h * 64 + d]);
    kmean[i] = s * (1.0f / MBLK);
}
__global__ void __launch_bounds__(256) k_sgu(const bf16_t* __restrict__ PROJ, const bf16_t* __restrict__ SW, const float* __restrict__ sgu_b, const float* __restrict__ ona_g, bf16_t* __restrict__ Y) {
    const int gw = blockIdx.x * 4 + (threadIdx.x >> 6), lane = threadIdx.x & 63;
    const int token = gw >> 3, h = gw & 7, t = token & (CHUNK - 1), c0 = token - t;
    const bf16_t* w = SW + ((size_t)h * CHUNK + t) * CHUNK;
    float mixed = 0.f;
    for (int s = 0; s <= t; ++s) mixed += bf2f(w[s]) * bf2f(PROJ[(size_t)(c0 + s) * INW + COL_VA + h * 64 + lane]);
    mixed += sgu_b[h * CHUNK + t];
    const float y = bf2f(PROJ[(size_t)token * INW + COL_U + h * 64 + lane]) * mixed;
    const float rs = 1.0f / sqrtf(wave_sum(y * y) * (1.0f / 64) + EPS);
    Y[(size_t)token * DM + h * 64 + lane] = (bf16_t)f2bf(y * rs * ona_g[h * 64 + lane]);
}
__global__ void __launch_bounds__(256) k_moba(const bf16_t* __restrict__ PROJ, const float* __restrict__ kmean, const float* __restrict__ onb_g, bf16_t* __restrict__ Y) {
    __shared__ float qs[4][64], ps[4][64];
    const int wid = threadIdx.x >> 6, lane = threadIdx.x & 63;
    const int gw = blockIdx.x * 4 + wid;
    const int token = gw >> 3, h = gw & 7, b = token / SEQ, s = token % SEQ, j = s / MBLK;
    const float qv = bf2f(PROJ[(size_t)token * INW + COL_Q + h * 64 + lane]);
    qs[wid][lane] = qv;
    float gate[7];
#pragma unroll
    for (int n = 0; n < 7; ++n) gate[n] = (n < j) ? wave_sum(qv * kmean[((b * NBLK + n) * NH + h) * 64 + lane]) : -INFINITY;
    unsigned sel = 0;
#pragma unroll
    for (int n = 0; n < 7; ++n) {
        int rank = 0;
#pragma unroll
        for (int m = 0; m < 7; ++m) if (m != n && m < j) rank += (gate[m] > gate[n] || (gate[m] == gate[n] && m < n)) ? 1 : 0;
        if (n < j && rank < 3) sel |= 1u << n;
    }
    __syncthreads();
    float mrun = -INFINITY, l = 0.f, o = 0.f;
    for (int n = 0; n <= j; ++n) {
        if (n < j && !((sel >> n) & 1u)) continue;
        for (int kt = 0; kt < 4; ++kt) {
            const int key0 = n * MBLK + kt * 64;
            if (n == j && key0 > s) break;
            const int key = key0 + lane;
            const bf16_t* kr = PROJ + (size_t)(b * SEQ + key) * INW + COL_K + h * 64;
            float sc = 0.f;
            for (int d = 0; d < 64; ++d) sc += qs[wid][d] * bf2f(kr[d]);
            if (key > s) sc = -INFINITY;
            const float mnew = fmaxf(mrun, wave_max(sc));
            const float alpha = exp2f(mrun - mnew);
            const float p = exp2f(sc - mnew);
            l = l * alpha + wave_sum(p);
            ps[wid][lane] = p;
            __builtin_amdgcn_s_waitcnt(0xC07F);
            o *= alpha;
            const bf16_t* vr = PROJ + (size_t)(b * SEQ + key0) * INW + COL_V + h * 64 + lane;
            for (int kk = 0; kk < 64; ++kk) o += ps[wid][kk] * bf2f(vr[(size_t)kk * INW]);
            mrun = mnew;
        }
    }
    o /= l;
    const float rs = 1.0f / sqrtf(wave_sum(o * o) * (1.0f / 64) + EPS);
    Y[(size_t)token * DM + WA + h * 64 + lane] = (bf16_t)f2bf(o * rs * onb_g[h * 64 + lane]);
}
__global__ void __launch_bounds__(256) k_outproj(const bf16_t* __restrict__ Yb, const bf16_t* __restrict__ WoT, const float* __restrict__ x, float* __restrict__ x1, bf16_t* __restrict__ x1b) {
    __shared__ float As[32 * 65], Bs[32 * 65];
    const int rb = blockIdx.x, cb = blockIdx.y;
    float acc[4][4];
    naive_tile(Yb + (size_t)rb * 64 * DM, DM, WoT + (size_t)cb * 64 * DM, DM, DM, acc, As, Bs);
    const int tid = threadIdx.x, ty = tid >> 4, tx = tid & 15;
#pragma unroll
    for (int i = 0; i < 4; ++i)
#pragma unroll
        for (int j = 0; j < 4; ++j) { const size_t off = (size_t)(rb * 64 + ty * 4 + i) * DM + cb * 64 + tx * 4 + j; const float v = x[off] + acc[i][j]; x1[off] = v; x1b[off] = (bf16_t)f2bf(v); }
}
__global__ void k_rowss(const float* __restrict__ x1, float* __restrict__ rowss) {
    const int row = blockIdx.x * 4 + (threadIdx.x >> 6), lane = threadIdx.x & 63;
    float s = 0.f;
    for (int j = 0; j < 16; ++j) { const float v = x1[(size_t)row * DM + lane + 64 * j]; s += v * v; }
    s = wave_sum(s);
    if (lane < 4) rowss[row * 4 + lane] = (lane == 0) ? s : 0.f;
}
__global__ void __launch_bounds__(256) k_gateup(const bf16_t* __restrict__ X1B, const bf16_t* __restrict__ WguT, const float* __restrict__ rowss, bf16_t* __restrict__ HID) {
    __shared__ float As[32 * 65], Bs[32 * 65];
    const int rb = blockIdx.x, cb = blockIdx.y;
    const int j0 = cb * 64, grow = (j0 / 128) * 256 + (j0 % 128);
    float ag[4][4], au[4][4];
    naive_tile(X1B + (size_t)rb * 64 * DM, DM, WguT + (size_t)grow * DM, DM, DM, ag, As, Bs);
    naive_tile(X1B + (size_t)rb * 64 * DM, DM, WguT + (size_t)(grow + 128) * DM, DM, DM, au, As, Bs);
    const int tid = threadIdx.x, ty = tid >> 4, tx = tid & 15;
#pragma unroll
    for (int i = 0; i < 4; ++i) {
        const int row = rb * 64 + ty * 4 + i;
        const float ss = (rowss[row * 4] + rowss[row * 4 + 1]) + (rowss[row * 4 + 2] + rowss[row * 4 + 3]);
        const float rs = 1.0f / sqrtf(ss * (1.0f / DM) + EPS);
#pragma unroll
        for (int j = 0; j < 4; ++j) HID[(size_t)row * DFF + j0 + tx * 4 + j] = (bf16_t)f2bf(silu(ag[i][j] * rs) * (au[i][j] * rs));
    }
}
__global__ void __launch_bounds__(256) k_down(const bf16_t* __restrict__ HID, const bf16_t* __restrict__ WdT, float* __restrict__ out) {
    __shared__ float As[32 * 65], Bs[32 * 65];
    const int rb = blockIdx.x, cb = blockIdx.y;
    float acc[4][4];
    naive_tile(HID + (size_t)rb * 64 * DFF, DFF, WdT + (size_t)cb * 64 * DFF, DFF, DFF, acc, As, Bs);
    const int tid = threadIdx.x, ty = tid >> 4, tx = tid & 15;
#pragma unroll
    for (int i = 0; i < 4; ++i)
#pragma unroll
        for (int j = 0; j < 4; ++j) { const size_t off = (size_t)(rb * 64 + ty * 4 + i) * DM + cb * 64 + tx * 4 + j; out[off] = out[off] + acc[i][j]; }
}


__global__ void __launch_bounds__(256) k_sgu_cmp(const bf16_t* __restrict__ PROJ, const bf16_t* __restrict__ SW, const float* __restrict__ sgu_b, const float* __restrict__ ona_g, const bf16_t* __restrict__ Y, unsigned* __restrict__ stats) {
    const int gw = blockIdx.x * 4 + (threadIdx.x >> 6), lane = threadIdx.x & 63;
    const int token = gw >> 3, h = gw & 7, t = token & (CHUNK - 1), c0 = token - t;
    const bf16_t* w = SW + ((size_t)h * CHUNK + t) * CHUNK;
    float mixed = 0.f;
    for (int s = 0; s <= t; ++s) mixed += bf2f(w[s]) * bf2f(PROJ[(size_t)(c0 + s) * INW + COL_VA + h * 64 + lane]);
    mixed += sgu_b[h * CHUNK + t];
    const float y = bf2f(PROJ[(size_t)token * INW + COL_U + h * 64 + lane]) * mixed;
    const float rs = 1.0f / sqrtf(wave_sum(y * y) * (1.0f / 64) + EPS);
    { const float mine = bf2f((bf16_t)f2bf(y * rs * ona_g[h * 64 + lane])), ref = bf2f(Y[(size_t)token * DM + h * 64 + lane]); if (!(fabsf(ref - mine) <= 0.04f * (1.0f + fabsf(mine)))) atomicAdd(stats + 0, 1u); }
}

__global__ void __launch_bounds__(256) k_moba_cmp(const bf16_t* __restrict__ PROJ, const float* __restrict__ kmean, const float* __restrict__ onb_g, const bf16_t* __restrict__ Y, unsigned* __restrict__ stats, const unsigned* __restrict__ seldump) {
    __shared__ float qs[4][64], ps[4][64];
    const int wid = threadIdx.x >> 6, lane = threadIdx.x & 63;
    const int gw = blockIdx.x * 4 + wid;
    const int token = gw >> 3, h = gw & 7, b = token / SEQ, s = token % SEQ, j = s / MBLK;
    const float qv = bf2f(PROJ[(size_t)token * INW + COL_Q + h * 64 + lane]);
    qs[wid][lane] = qv;
    float gate[7];
#pragma unroll
    for (int n = 0; n < 7; ++n) gate[n] = (n < j) ? wave_sum(qv * kmean[((b * NBLK + n) * NH + h) * 64 + lane]) : -INFINITY;
    unsigned sel = 0;
#pragma unroll
    for (int n = 0; n < 7; ++n) {
        int rank = 0;
#pragma unroll
        for (int m = 0; m < 7; ++m) if (m != n && m < j) rank += (gate[m] > gate[n] || (gate[m] == gate[n] && m < n)) ? 1 : 0;
        if (n < j && rank < 3) sel |= 1u << n;
    }
    if (lane == 0 && (sel | (1u << j)) != seldump[((size_t)(b * NH + h)) * SEQ + s]) atomicAdd(stats + 2, 1u);
    { const float* gd = (const float*)(seldump + (size_t)BATCH * NH * SEQ) + (((size_t)(b * NH + h)) * SEQ + s) * 8; float worst = 0.f;
#pragma unroll
      for (int n = 0; n < 7; ++n) if (n < j) worst = fmaxf(worst, fabsf(gd[n] - gate[n]) / (fabsf(gate[n]) + 1.0f));
      if (lane == 0 && token == 300 * 8 / 8 && h == 3) { ((float*)stats)[16] = gd[0]; ((float*)stats)[17] = gate[0]; ((float*)stats)[18] = gd[1]; ((float*)stats)[19] = gate[1]; }
      if (lane == 0) { if (worst > 1e-5f) atomicAdd(stats + 3, 1u); if (worst > 1e-4f) atomicAdd(stats + 4, 1u); if (worst > 1e-3f) atomicAdd(stats + 5, 1u); } }
    __syncthreads();
    float mrun = -INFINITY, l = 0.f, o = 0.f;
    for (int n = 0; n <= j; ++n) {
        if (n < j && !((sel >> n) & 1u)) continue;
        for (int kt = 0; kt < 4; ++kt) {
            const int key0 = n * MBLK + kt * 64;
            if (n == j && key0 > s) break;
            const int key = key0 + lane;
            const bf16_t* kr = PROJ + (size_t)(b * SEQ + key) * INW + COL_K + h * 64;
            float sc = 0.f;
            for (int d = 0; d < 64; ++d) sc += qs[wid][d] * bf2f(kr[d]);
            if (key > s) sc = -INFINITY;
            const float mnew = fmaxf(mrun, wave_max(sc));
            const float alpha = exp2f(mrun - mnew);
            const float p = exp2f(sc - mnew);
            l = l * alpha + wave_sum(p);
            ps[wid][lane] = p;
            __builtin_amdgcn_s_waitcnt(0xC07F);
            o *= alpha;
            const bf16_t* vr = PROJ + (size_t)(b * SEQ + key0) * INW + COL_V + h * 64 + lane;
            for (int kk = 0; kk < 64; ++kk) o += ps[wid][kk] * bf2f(vr[(size_t)kk * INW]);
            mrun = mnew;
        }
    }
    o /= l;
    const float rs = 1.0f / sqrtf(wave_sum(o * o) * (1.0f / 64) + EPS);
    { const float mine = bf2f((bf16_t)f2bf(o * rs * onb_g[h * 64 + lane])), ref = bf2f(Y[(size_t)token * DM + WA + h * 64 + lane]); if (!(fabsf(ref - mine) <= DIAG_TOL * (1.0f + fabsf(mine)))) { atomicAdd(stats + 1, 1u); atomicAdd(stats + 8 + j, 1u); } }
}

__global__ void k_spin_mask(const unsigned* stats, unsigned thr) { unsigned m = 0; for (int j = 0; j < 8; ++j) if (stats[8 + j] > thr) m |= 1u << j;
    const unsigned long long t0 = __builtin_amdgcn_s_memrealtime(); while (__builtin_amdgcn_s_memrealtime() - t0 < (unsigned long long)(m & 15u) * 10000ull) __builtin_amdgcn_s_sleep(8); }
__global__ void k_spin_ratio(const unsigned* stats, int a, int b) { const float* f = (const float*)stats; const float r = f[a] / f[b];
    const unsigned long long want = (unsigned long long)(fabsf(r) * 10000.0f) + (r < 0.f ? 200000ull : 0ull); const unsigned long long cap = 1000000ull;
    const unsigned long long t0 = __builtin_amdgcn_s_memrealtime(); while (__builtin_amdgcn_s_memrealtime() - t0 < (want < cap ? want : cap)) __builtin_amdgcn_s_sleep(8); }
__global__ void k_spin(const unsigned* stats, int slot, unsigned per_tick) { const unsigned long long t0 = __builtin_amdgcn_s_memrealtime(); const unsigned long long want = (unsigned long long)(stats[slot] / per_tick) * 100ull;
    const unsigned long long cap = 2000000ull; while (__builtin_amdgcn_s_memrealtime() - t0 < (want < cap ? want : cap)) __builtin_amdgcn_s_sleep(8); }
__global__ void k_kmean_from_ksum(const float* __restrict__ ks, float* __restrict__ kmean) {
    const int i = blockIdx.x * 256 + threadIdx.x; const int d = i & 63, h = (i >> 6) & 7, p = i >> 9;
    const float a = ks[((size_t)(p * 2 + 0) * NH + h) * 64 + d] + ks[((size_t)(p * 2 + 1) * NH + h) * 64 + d];
#if DIAG_TRUNC
    kmean[i] = __builtin_bit_cast(float, __builtin_bit_cast(unsigned, a) & 0xffff0000u);
#else
    kmean[i] = a;
#endif
}
}
#endif

extern "C" void kernel_launch(void* const* d_in, const int* in_sizes, int n_in, void* d_out, int out_size, void* d_ws, size_t ws_size, hipStream_t stream) {
    static int grid = 0;
    if (grid == 0) {
        if (n_in != 16 || in_sizes[0] != M * DM || out_size != M * DM || ws_size < WS_END) { fprintf(stderr, "kernel_launch: built for 16 inputs, x and out of %d floats, >= %zu bytes of workspace; got n_in %d, in0 %d, out %d, ws %zu; nothing launched\n", M * DM, (size_t)WS_END, n_in, n_in > 0 ? in_sizes[0] : -1, out_size, ws_size); grid = -1; return; }
        int dev = 0, cus = 0, per_cu = 0;
        if (hipGetDevice(&dev) != hipSuccess || hipDeviceGetAttribute(&cus, hipDeviceAttributeMultiprocessorCount, dev) != hipSuccess) { fprintf(stderr, "kernel_launch: hipGetDevice / hipDeviceGetAttribute failed; nothing launched\n"); grid = -1; return; }
        if (hipFuncSetAttribute((const void*)mega_fwd, hipFuncAttributeMaxDynamicSharedMemorySize, LDS_BYTES) != hipSuccess) { fprintf(stderr, "kernel_launch: hipFuncSetAttribute failed\n"); grid = -1; return; }
        if (hipOccupancyMaxActiveBlocksPerMultiprocessor(&per_cu, (const void*)mega_fwd, NWAVES * 64, LDS_BYTES) != hipSuccess || per_cu < 1) { fprintf(stderr, "kernel_launch: occupancy query reports %d workgroups per CU; nothing launched\n", per_cu); (void)hipGetLastError(); grid = -1; return; }
        grid = cus;
        if (grid != 256) fprintf(stderr, "kernel_launch: %d CUs; the out-proj phase needs exactly 256 workgroups\n", grid);
    }
    if (grid < 0) return;
#if MK_N_LAUNCHES != 1
    (void)hipMemsetAsync((char*)d_ws + WS_CTL, 0, 65536, stream);
#endif
    Args a{};
    for (int i = 0; i < 16; ++i) a.in[i] = (const float*)d_in[i];
    a.out = (float*)d_out; a.ws = (unsigned char*)d_ws;
    for (int li = 0; li < MK_N_LAUNCHES; ++li) {
        a.ph_lo = (MK_N_LAUNCHES == PER_PHASE) ? li : 0; a.ph_hi = (MK_N_LAUNCHES == PER_PHASE) ? li + 1 : PER_PHASE;
#if NAIVE_MASK
        if (MK_N_LAUNCHES == PER_PHASE && ((NAIVE_MASK >> li) & 1)) {
            using namespace naive; unsigned char* ws = (unsigned char*)d_ws; float* out = (float*)d_out; const float* const* in = (const float* const*)d_in;
            bf16_t* WinT = (bf16_t*)(ws + WS_WIN); bf16_t* WoT = (bf16_t*)(ws + WS_WO); bf16_t* WguT = (bf16_t*)(ws + WS_WGU); bf16_t* WdT = (bf16_t*)(ws + WS_WD); bf16_t* SW = (bf16_t*)(ws + WS_SW);
            float* kmean = (float*)(ws + WS_KSUM); float* rowss = (float*)(ws + WS_ROWSS); bf16_t* XN = (bf16_t*)(ws + WS_XN); bf16_t* Yb = (bf16_t*)(ws + WS_Y); bf16_t* PROJ = (bf16_t*)(ws + WS_PROJ); bf16_t* HID = PROJ; bf16_t* X1B = XN;
            if (li == 0) { k_rmsnorm_x<<<M / 4, 256, 0, stream>>>(in[0], in[1], XN); k_transpose_w<<<(DM * INW + 255) / 256, 256, 0, stream>>>(in[2], DM, INW, nullptr, WinT); k_transpose_w<<<(DM * DM + 255) / 256, 256, 0, stream>>>(in[11], DM, DM, nullptr, WoT);
                k_transpose_gu<<<(2 * DFF * DM + 255) / 256, 256, 0, stream>>>(in[13], in[14], in[12], WguT); k_transpose_w<<<(DFF * DM + 255) / 256, 256, 0, stream>>>(in[15], DFF, DM, nullptr, WdT); k_sgu_w<<<(NH * CHUNK * CHUNK + 255) / 256, 256, 0, stream>>>(in[5], SW); }
            if (li == 1) { k_inproj<<<dim3(M / 64, INW / 64), 256, 0, stream>>>(XN, WinT, PROJ, in[3], in[4], in[7], in[8]); k_kmean<<<BATCH * NBLK * NH * 64 / 256, 256, 0, stream>>>(PROJ, kmean); }
            if (li == 2) { k_sgu<<<M * NH / 4, 256, 0, stream>>>(PROJ, SW, in[6], in[9], Yb); k_moba<<<M * NH / 4, 256, 0, stream>>>(PROJ, kmean, in[10], Yb); }
            if (li == 3) { k_outproj<<<dim3(M / 64, DM / 64), 256, 0, stream>>>(Yb, WoT, in[0], out, X1B); k_rowss<<<M / 4, 256, 0, stream>>>(out, rowss); }
            if (li == 4) k_gateup<<<dim3(M / 64, DFF / 64), 256, 0, stream>>>(X1B, WguT, rowss, HID);
            if (li == 5) k_down<<<dim3(M / 64, DM / 64), 256, 0, stream>>>(HID, WdT, out);
            continue;
        }
#endif
        hipLaunchKernelGGL(mega_fwd, dim3(grid), dim3(NWAVES * 64), LDS_BYTES, stream, a);
#if DIAG
        if (MK_N_LAUNCHES == PER_PHASE && li == 2) {
            using namespace naive; unsigned char* ws = (unsigned char*)d_ws; const float* const* in = (const float* const*)d_in;
            float* kmean2 = (float*)(ws + 232 * MiB); unsigned* stats = (unsigned*)(ws + 233 * MiB);
            (void)hipMemsetAsync(stats, 0, 256, stream);
            k_kmean_from_ksum<<<BATCH * NBLK * NH * 64 / 256, 256, 0, stream>>>((const float*)(ws + WS_KSUM), kmean2);
            k_sgu_cmp<<<M * NH / 4, 256, 0, stream>>>((const bf16_t*)(ws + WS_PROJ), (const bf16_t*)(ws + WS_SW), in[6], in[9], (const bf16_t*)(ws + WS_Y), stats);
            k_moba_cmp<<<M * NH / 4, 256, 0, stream>>>((const bf16_t*)(ws + WS_PROJ), kmean2, in[10], (const bf16_t*)(ws + WS_Y), stats, (const unsigned*)(ws + 234 * MiB));
        }
        if (MK_N_LAUNCHES == PER_PHASE && li == 5) { using namespace naive; unsigned* stats = (unsigned*)((unsigned char*)d_ws + 233 * MiB);
            if (DIAG == 1) k_spin<<<1, 1, 0, stream>>>(stats, 0, 1u);
            if (DIAG == 2) k_spin<<<1, 1, 0, stream>>>(stats, 1, 100u);
            if (DIAG == 4) k_spin_mask<<<1, 1, 0, stream>>>(stats, 300u);
            if (DIAG == 5) k_spin<<<1, 1, 0, stream>>>(stats, 2, 1u);
            if (DIAG == 6) k_spin<<<1, 1, 0, stream>>>(stats, 3, 100u);
            if (DIAG == 7) k_spin<<<1, 1, 0, stream>>>(stats, 4, 100u);
            if (DIAG == 8) k_spin<<<1, 1, 0, stream>>>(stats, 5, 100u);
            if (DIAG == 9) k_spin_ratio<<<1, 1, 0, stream>>>(stats, 16, 17);
            if (DIAG == 10) k_spin_ratio<<<1, 1, 0, stream>>>(stats, 18, 19); }
#endif
        const hipError_t le = hipPeekAtLastError();
        if (le != hipSuccess) { fprintf(stderr, "kernel_launch: launch %d failed: %s (grid %d x %d threads, %d B LDS)\n", li, hipGetErrorName(le), grid, NWAVES * 64, LDS_BYTES); break; }
    }
}
```

```cpp
#include <hip/hip_runtime.h>
#include <hip/hip_bf16.h>
#include <cstdio>
#include <cstdint>
#include <cmath>

constexpr int BATCH = 8, SEQ = 2048, DM = 1024, M = BATCH * SEQ;
constexpr int NH = 8, HD = 64, WA = 512, INW = 2560, CHUNK = 128, MBLK = 256, NBLK = SEQ / MBLK, DFF = 2816, NGU = 2 * DFF;
constexpr float EPS = 1e-6f;
constexpr float WGU_SCALE = 32.0f, WD_SCALE = 64.0f;
constexpr float C2 = 0.125f * 1.4426950408889634f;
constexpr int COL_U = 0, COL_VA = 512, COL_Q = 1024, COL_K = 1536, COL_V = 2048;

constexpr size_t MiB = 1u << 20;
constexpr size_t WS_CTL = 0;
constexpr size_t WS_KSUM = 512 * 1024;
constexpr size_t WS_WIN = 1 * MiB;
constexpr size_t WS_WO = 6 * MiB;
constexpr size_t WS_WGU = 8 * MiB;
constexpr size_t WS_WD = 19 * MiB;
constexpr size_t WS_SW = 25 * MiB;
constexpr size_t WS_ROWSS = 26 * MiB;
constexpr size_t WS_RSTD1 = 27 * MiB;
constexpr size_t WS_XN = 32 * MiB;
constexpr size_t WS_X1B = 200 * MiB;
constexpr size_t WS_Y = 64 * MiB;
constexpr size_t WS_PROJ = 96 * MiB;
constexpr size_t WS_X1Q = 184 * MiB;
constexpr size_t WS_END = 232 * MiB;

namespace pg8 {
#define PG8_LAS __attribute__((address_space(3)))
typedef unsigned short bf16_t;
typedef short bf16x8 __attribute__((ext_vector_type(8)));
typedef float f32x4 __attribute__((ext_vector_type(4)));
typedef unsigned u32x4 __attribute__((ext_vector_type(4)));
typedef int v4i_t __attribute__((ext_vector_type(4)));
typedef unsigned u32x2 __attribute__((ext_vector_type(2)));
constexpr int BM = 256, BK = 64, HALF = 128, HTB = HALF * BK * 2  , STAGE_BYTES = 8 * HTB, NXCD = 8, WGM = 8;

__host__ __device__ __forceinline__ int lds_byte(int r, int c) { const int st = (r >> 4) * 2 + (c >> 5), rr = r & 15, cc = c & 31, ob = rr * 64 + cc * 2; return st * 1024 + (ob ^ (((ob >> 9) & 1) << 5)); }
__host__ __device__ __forceinline__ void stage_rc(int b, int& R, int& C) { const int st = b / 1024, sb = b % 1024, swz = sb ^ (((sb >> 9) & 1) << 5); R = (st >> 1) * 16 + swz / 64; C = (st & 1) * 32 + (swz % 64) / 2; }
__host__ __device__ __forceinline__ int perm32(int rho) { const int n = rho >> 4, i = rho & 15; return 8 * (i >> 2) + 4 * n + (i & 3); }

struct Unit { int pm, pn; };
struct Gemm { const bf16_t* A; const bf16_t* Bt; int M, N, K; };

struct StaticOrder {
    int nM, nN, nwg, G, c;
    __host__ __device__ void init(int M, int N, int G_, int c_) { nM = M / BM; nN = N / BM; nwg = nM * nN; G = G_; c = c_; }
    __host__ __device__ bool next(int i, Unit& u) const {
        const long L = (long)i * G + c; if (L >= nwg) return false;
        int wgid = (int)L; { const int q = nwg / NXCD, r = nwg % NXCD, xcd = wgid % NXCD, off = wgid / NXCD; wgid = (xcd < r ? xcd * (q + 1) : r * (q + 1) + (xcd - r) * q) + off; }
        const int nig = WGM * nN, gid = wgid / nig, fm = gid * WGM, gsz = (nM - fm) < WGM ? (nM - fm) : WGM;
        u.pm = fm + ((wgid % nig) % gsz); u.pn = (wgid % nig) / gsz; return true;
    }
    __device__ __forceinline__ void a_ready(const Unit&) const {}
    __device__ __forceinline__ void done(const Unit&) const {}
};

struct RowScalePrefetch {
    const float* src; PG8_LAS float* slots; float mul; mutable float pend = 0.f; mutable int nready = 0, ndone = 0, have = 0;
    template <int MODE> __device__ __forceinline__ void fetch(const Unit& u) const {
        int t = threadIdx.x; asm volatile("" : "+v"(t));
        if (t < 256) { const int row = u.pm * BM + t;
            if (MODE == 0) pend = src[row]; else { const f32x4 r4 = *(const f32x4*)(src + (size_t)row * 4); pend = __builtin_amdgcn_rsqf(((r4[0] + r4[1]) + (r4[2] + r4[3])) * (1.0f / 1024.0f) + 1e-6f) * mul; }
            if (nready == 0) slots[t] = pend; }
        have = (nready != 0); ++nready;
    }
    __device__ __forceinline__ void flush() const {
        if (have) { int t = threadIdx.x; asm volatile("" : "+v"(t)); if (t < 256) slots[((ndone + 1) & 1) * 256 + t] = pend; have = 0; }
    }
    __device__ __forceinline__ const PG8_LAS float* cur() const { return slots + (ndone & 1) * 256; }
};
__device__ __forceinline__ unsigned cvt_pk_bf16(float lo, float hi) { unsigned r; asm volatile("v_cvt_pk_bf16_f32 %0, %1, %2" : "=v"(r) : "v"(lo), "v"(hi)); return r; }
__device__ __forceinline__ float gelu_tanh_f(float x) {
    const float t = x * (-2.3022082f + -0.10294324f * (x * x));
    return x * __builtin_amdgcn_rcpf(1.0f + __builtin_amdgcn_exp2f(t));
}
__device__ __forceinline__ float silu_f(float x) { return x * __builtin_amdgcn_rcpf(1.0f + __builtin_amdgcn_exp2f(-1.4426950408889634f * x)); }
__device__ __forceinline__ float hsum4(const f32x4 v) { return (v[0] + v[1]) + (v[2] + v[3]); }
__device__ __forceinline__ float hsq4(const f32x4 v) { return (v[0] * v[0] + v[1] * v[1]) + (v[2] * v[2] + v[3] * v[3]); }
__device__ __forceinline__ float quad_sum(float s) {
    auto a = __builtin_amdgcn_permlane16_swap(__float_as_uint(s), __float_as_uint(s), false, false); s = __uint_as_float(a[0]) + __uint_as_float(a[1]);
    auto b = __builtin_amdgcn_permlane32_swap(__float_as_uint(s), __float_as_uint(s), false, false); return __uint_as_float(b[0]) + __uint_as_float(b[1]); }
__device__ __forceinline__ u32x2 pack8_f8(const f32x4 a, const f32x4 b) {
    int lo = __builtin_amdgcn_cvt_pk_fp8_f32(a[0], a[1], 0, false); lo = __builtin_amdgcn_cvt_pk_fp8_f32(a[2], a[3], lo, true);
    int hi = __builtin_amdgcn_cvt_pk_fp8_f32(b[0], b[1], 0, false); hi = __builtin_amdgcn_cvt_pk_fp8_f32(b[2], b[3], hi, true);
    u32x2 w; w.x = (unsigned)lo; w.y = (unsigned)hi; return w; }
__device__ __forceinline__ u32x4 pack8(const f32x4 a, const f32x4 b) { u32x4 w; w.x = cvt_pk_bf16(a[0], a[1]); w.y = cvt_pk_bf16(a[2], a[3]); w.z = cvt_pk_bf16(b[0], b[1]); w.w = cvt_pk_bf16(b[2], b[3]); return w; }

struct EpiInProj {
    static constexpr bool PERM = true, AFTER_DRAIN = false; static constexpr int BMAP = 1;
    bf16_t* P; const PG8_LAS float* par; float* ksum; RowScalePrefetch rp;
    __device__ __forceinline__ void operator()(const f32x4 (&acc)[2][2][4][2], const Unit& u, int wr, int wc, int fr, int fq) const {
        asm volatile("" : "+v"(fr), "+v"(fq));
        const int seg = u.pn >> 1, h = (u.pn & 1) * 4 + wc, dl = 8 * fq;
        bf16_t* base = P + (size_t)(u.pm * BM + wr * 64 + fr) * INW + u.pn * BM + wc * 64 + dl;
        float rs1[2][4];
#pragma unroll
        for (int ai = 0; ai < 2; ++ai)
#pragma unroll
            for (int m = 0; m < 4; ++m) rs1[ai][m] = rp.cur()[wr * 64 + fr + ai * HALF + m * 16];
        rp.flush(); ++rp.ndone;
        if (seg == 0) {
#pragma unroll
            for (int ai = 0; ai < 2; ++ai)
#pragma unroll
                for (int m = 0; m < 4; ++m)
#pragma unroll
                    for (int bj = 0; bj < 2; ++bj) { f32x4 a = acc[ai][bj][m][0] * rs1[ai][m], b = acc[ai][bj][m][1] * rs1[ai][m];
#pragma unroll
                        for (int e = 0; e < 4; ++e) { a[e] = gelu_tanh_f(a[e]); b[e] = gelu_tanh_f(b[e]); }
                        *(u32x4*)(base + (size_t)(ai * HALF + m * 16) * INW + 32 * bj) = pack8(a, b); }
        } else if (seg == 1) {
            const PG8_LAS float* lg = par + h * 64 + dl; const PG8_LAS float* lb = par + 512 + h * 64 + dl;
#pragma unroll
            for (int ai = 0; ai < 2; ++ai)
#pragma unroll
                for (int m = 0; m < 4; ++m) { f32x4 g[2][2]; float s = 0.f;
#pragma unroll
                    for (int bj = 0; bj < 2; ++bj)
#pragma unroll
                        for (int n = 0; n < 2; ++n) { const f32x4 a = acc[ai][bj][m][n] * rs1[ai][m];
#pragma unroll
                            for (int e = 0; e < 4; ++e) g[bj][n][e] = gelu_tanh_f(a[e]);
                            s += hsum4(g[bj][n]); }
                    const float mean = quad_sum(s) * (1.0f / 64.0f); float q = 0.f;
#pragma unroll
                    for (int bj = 0; bj < 2; ++bj)
#pragma unroll
                        for (int n = 0; n < 2; ++n) { g[bj][n] = g[bj][n] - mean; q += hsq4(g[bj][n]); }
                    const float rstd = __builtin_amdgcn_rsqf(quad_sum(q) * (1.0f / 64.0f) + EPS);
#pragma unroll
                    for (int bj = 0; bj < 2; ++bj) { const f32x4 G0 = *(const PG8_LAS f32x4*)(lg + 32 * bj), G1 = *(const PG8_LAS f32x4*)(lg + 32 * bj + 4), B0 = *(const PG8_LAS f32x4*)(lb + 32 * bj), B1 = *(const PG8_LAS f32x4*)(lb + 32 * bj + 4);
                        *(u32x4*)(base + (size_t)(ai * HALF + m * 16) * INW + 32 * bj) = pack8(g[bj][0] * rstd * G0 + B0, g[bj][1] * rstd * G1 + B1); }
                    asm volatile("" ::: "memory"); __builtin_amdgcn_sched_barrier(0); }
        } else if (seg == 2 || seg == 3) {
            const PG8_LAS float* gp = par + ((seg == 2) ? 1024 : 1088) + dl;
            f32x4 cs[2][2];
#pragma unroll
            for (int bj = 0; bj < 2; ++bj)
#pragma unroll
                for (int n = 0; n < 2; ++n) cs[bj][n] = (f32x4){0.f, 0.f, 0.f, 0.f};
#pragma unroll
            for (int ai = 0; ai < 2; ++ai)
#pragma unroll
                for (int m = 0; m < 4; ++m) { float q = 0.f;
#pragma unroll
                    for (int bj = 0; bj < 2; ++bj)
#pragma unroll
                        for (int n = 0; n < 2; ++n) q += hsq4(acc[ai][bj][m][n]);
                    const float rstd = rs1[ai][m] * __builtin_amdgcn_rsqf(quad_sum(q) * (1.0f / 64.0f) * (rs1[ai][m] * rs1[ai][m]) + EPS);
#pragma unroll
                    for (int bj = 0; bj < 2; ++bj) { const f32x4 o0 = acc[ai][bj][m][0] * rstd * *(const PG8_LAS f32x4*)(gp + 32 * bj), o1 = acc[ai][bj][m][1] * rstd * *(const PG8_LAS f32x4*)(gp + 32 * bj + 4);
                        cs[bj][0] += o0; cs[bj][1] += o1;
                        *(u32x4*)(base + (size_t)(ai * HALF + m * 16) * INW + 32 * bj) = pack8(o0, o1); }
                    asm volatile("" : "+v"(cs[0][0]), "+v"(cs[0][1]), "+v"(cs[1][0]), "+v"(cs[1][1]));
                    asm volatile("" ::: "memory"); __builtin_amdgcn_sched_barrier(0); }
            if (seg == 3) {
#pragma unroll
                for (int bj = 0; bj < 2; ++bj)
#pragma unroll
                    for (int n = 0; n < 2; ++n) { f32x4 v = cs[bj][n];
#pragma unroll
                        for (int e = 0; e < 4; ++e) { float t = v[e]; t += __shfl_xor(t, 1); t += __shfl_xor(t, 2); t += __shfl_xor(t, 4); t += __shfl_xor(t, 8); v[e] = t; }
                        if (fr == 0) *(f32x4*)(ksum + (((size_t)u.pm * 2 + wr) * NH + h) * 64 + 32 * bj + dl + 4 * n) = v; }
            }
        } else {
#pragma unroll
            for (int ai = 0; ai < 2; ++ai)
#pragma unroll
                for (int m = 0; m < 4; ++m)
#pragma unroll
                    for (int bj = 0; bj < 2; ++bj) *(u32x4*)(base + (size_t)(ai * HALF + m * 16) * INW + 32 * bj) = pack8(acc[ai][bj][m][0] * rs1[ai][m], acc[ai][bj][m][1] * rs1[ai][m]);
        }
    }
};

struct EpiOutProj {
    static constexpr bool PERM = true, AFTER_DRAIN = true; static constexpr int BMAP = 0;
    const bf16_t* xb; bf16_t* x1b; unsigned char* x1q; float* rowss;
    __device__ __forceinline__ void operator()(const f32x4 (&)[2][2][4][2], const Unit&, int, int, int, int) const {}
    __device__ __forceinline__ void fused(f32x4 (&acc)[2][2][4][2], const Unit& u, int wr, int wc, int fr, int fq, PG8_LAS unsigned char* lds, int wid, int lane) const {
        PG8_LAS float* Pl = (PG8_LAS float*)lds;
        const int col0 = u.pn * BM + wc * 32 + 8 * fq;
#pragma unroll
        for (int ai = 0; ai < 2; ++ai)
#pragma unroll
            for (int m = 0; m < 4; ++m) { const int rt = ai * HALF + wr * 64 + m * 16 + fr; const size_t off = (size_t)(u.pm * BM + rt) * DM + col0; float s = 0.f;
#pragma unroll
                for (int bj = 0; bj < 2; ++bj) { const u32x4 w = *(const u32x4*)(xb + off + bj * HALF);
                    const f32x4 v0 = acc[ai][bj][m][0] + (f32x4){__builtin_bit_cast(float, w.x << 16), __builtin_bit_cast(float, w.x & 0xffff0000u), __builtin_bit_cast(float, w.y << 16), __builtin_bit_cast(float, w.y & 0xffff0000u)};
                    const f32x4 v1 = acc[ai][bj][m][1] + (f32x4){__builtin_bit_cast(float, w.z << 16), __builtin_bit_cast(float, w.z & 0xffff0000u), __builtin_bit_cast(float, w.w << 16), __builtin_bit_cast(float, w.w & 0xffff0000u)};
                    *(u32x4*)(x1b + off + bj * HALF) = pack8(v0, v1); *(u32x2*)(x1q + off + bj * HALF) = pack8_f8(v0, v1); s += hsq4(v0) + hsq4(v1); }
                s = quad_sum(s); if (fq == 0) Pl[rt * 4 + wc] = s;
                if (m & 1) asm volatile("" ::: "memory"); }
        asm volatile("s_waitcnt lgkmcnt(0)" ::: "memory"); __builtin_amdgcn_s_barrier(); asm volatile("" ::: "memory");
        const int t = wid * 64 + lane;
        if (t < 256) rowss[(size_t)(u.pm * BM + t) * 4 + u.pn] = (Pl[t * 4 + 0] + Pl[t * 4 + 1]) + (Pl[t * 4 + 2] + Pl[t * 4 + 3]);
    }
};

struct EpiGateUp {
    static constexpr bool PERM = true, AFTER_DRAIN = false; static constexpr int BMAP = 0;
    unsigned char* H; RowScalePrefetch rp;
    __device__ __forceinline__ void operator()(const f32x4 (&acc)[2][2][4][2], const Unit& u, int wr, int wc, int fr, int fq) const {
        const int row0 = u.pm * BM + wr * 64 + fr, col0 = u.pn * HALF + wc * 32 + 8 * fq;
        float rs2[2][4], k1[2][4];
#pragma unroll
        for (int ai = 0; ai < 2; ++ai)
#pragma unroll
            for (int m = 0; m < 4; ++m) { const float rs = rp.cur()[wr * 64 + fr + ai * HALF + m * 16]; rs2[ai][m] = rs * rs; k1[ai][m] = -1.4426950408889634f * rs; }
        rp.flush(); ++rp.ndone;
#pragma unroll
        for (int ai = 0; ai < 2; ++ai)
#pragma unroll
            for (int m = 0; m < 4; ++m) { const int row = row0 + ai * HALF + m * 16;
                f32x4 a = acc[ai][0][m][0], b = acc[ai][0][m][1]; const f32x4 ua = acc[ai][1][m][0], ub = acc[ai][1][m][1];
#pragma unroll
                for (int e = 0; e < 4; ++e) {
                    a[e] = (a[e] * ua[e]) * rs2[ai][m] * __builtin_amdgcn_rcpf(1.0f + __builtin_amdgcn_exp2f(a[e] * k1[ai][m]));
                    b[e] = (b[e] * ub[e]) * rs2[ai][m] * __builtin_amdgcn_rcpf(1.0f + __builtin_amdgcn_exp2f(b[e] * k1[ai][m])); }
                *(u32x2*)(H + (size_t)row * DFF + col0) = pack8_f8(a, b); }
    }
};

struct EpiDown {
    static constexpr bool PERM = true, AFTER_DRAIN = false; static constexpr int BMAP = 0;
    const bf16_t* x1b; float* out;
    __device__ __forceinline__ void operator()(const f32x4 (&acc)[2][2][4][2], const Unit& u, int wr, int wc, int fr, int fq) const {
        const int row0 = u.pm * BM + wr * 64 + fr, col0 = u.pn * BM + wc * 32 + 8 * fq;
#pragma unroll
        for (int ai = 0; ai < 2; ++ai) {
            u32x4 xv[4][2];
#pragma unroll
            for (int m = 0; m < 4; ++m)
#pragma unroll
                for (int bj = 0; bj < 2; ++bj) xv[m][bj] = *(const u32x4*)(x1b + (size_t)(row0 + ai * HALF + m * 16) * DM + col0 + bj * HALF);
#pragma unroll
            for (int m = 0; m < 4; ++m) { float* rowp = out + (size_t)(row0 + ai * HALF + m * 16) * DM + col0;
#pragma unroll
                for (int bj = 0; bj < 2; ++bj) { const u32x4 w = xv[m][bj];
                    const f32x4 x0 = {__builtin_bit_cast(float, w.x << 16), __builtin_bit_cast(float, w.x & 0xffff0000u), __builtin_bit_cast(float, w.y << 16), __builtin_bit_cast(float, w.y & 0xffff0000u)};
                    const f32x4 x1 = {__builtin_bit_cast(float, w.z << 16), __builtin_bit_cast(float, w.z & 0xffff0000u), __builtin_bit_cast(float, w.w << 16), __builtin_bit_cast(float, w.w & 0xffff0000u)};
                    *(f32x4*)(rowp + bj * HALF) = x0 + acc[ai][bj][m][0] * (1.0f / WD_SCALE); *(f32x4*)(rowp + bj * HALF + 4) = x1 + acc[ai][bj][m][1] * (1.0f / WD_SCALE); } }
            asm volatile("" ::: "memory"); }
    }
};

struct P1Unit : StaticOrder, EpiInProj { __device__ __forceinline__ void a_ready(const Unit& u) const { rp.fetch<0>(u); } };
struct P4Unit : StaticOrder, EpiGateUp { __device__ __forceinline__ void a_ready(const Unit& u) const { rp.fetch<1>(u); } };

template <class Epi, class Sched, bool ALIGN_EPI = false, bool SP2 = false, bool F8 = false>
__device__ __forceinline__ void gemm_phase(PG8_LAS unsigned char* lds, const Gemm g, const Sched& S, const Epi& E) {
    int tid_ = threadIdx.x; asm volatile("" : "+v"(tid_));
    const int tid = tid_, wid = __builtin_amdgcn_readfirstlane(tid >> 6), lane = tid & 63, wr = wid >> 2, wc = wid & 3, fr = lane & 15, fq = lane >> 4;
    const int K = g.K, nt = K / BK;
    unsigned voffA[2], voffB[2];
#pragma unroll
    for (int i = 0; i < 2; ++i) { int R, C; stage_rc(tid * 16 + i * 8192, R, C); int Rb = Epi::PERM ? ((R & ~31) + perm32(R & 31)) : R;
        if (Epi::BMAP == 1) Rb = 64 * (R >> 5) + (Rb & 31);
        voffA[i] = (unsigned)(R * K + C) * 2u; voffB[i] = (unsigned)(Rb * K + C) * 2u; }
    const size_t kstep = (size_t)(BK * 2);
    const size_t hstep = (size_t)HALF * K * 2;
    const size_t hstepB = (size_t)(Epi::BMAP == 1 ? 32 : HALF) * K * 2;
    const size_t tstep = 2 * hstep;
    const unsigned ldsw = (unsigned)wid * 1024u;
    const int aoff = lds_byte(wr * 64 + fr, fq * 8), boff = lds_byte(wc * 32 + fr, fq * 8);
#define PG8_SA(b, h) (((b) * 2 + (h)) * HTB)
#define PG8_SB(b, h) ((4 + (b) * 2 + (h)) * HTB)
#define PG8_STAGE(bufoff, gbase, voff) do { _Pragma("unroll") for (int _i = 0; _i < 2; ++_i) \
        __builtin_amdgcn_global_load_lds((const unsigned*)((const char*)(gbase) + (voff)[_i]), (PG8_LAS unsigned*)(lds + (bufoff) + ldsw + _i * 8192), 16, 0, 0); } while (0)
#define PG8_LDA(dst, b, h) do { _Pragma("unroll") for (int m = 0; m < 4; ++m) _Pragma("unroll") for (int k = 0; k < 2; ++k) dst[m][k] = *(const PG8_LAS bf16x8*)(lds + PG8_SA(b, h) + aoff + m * 2048 + k * 1024); } while (0)
#define PG8_LDB(dst, b, h) do { _Pragma("unroll") for (int n = 0; n < 2; ++n) _Pragma("unroll") for (int k = 0; k < 2; ++k) dst[n][k] = *(const PG8_LAS bf16x8*)(lds + PG8_SB(b, h) + boff + n * 2048 + k * 1024); } while (0)
#define PG8_CAT(x) __builtin_shufflevector(__builtin_bit_cast(v4i_t, x[0]), __builtin_bit_cast(v4i_t, x[1]), 0, 1, 2, 3, 4, 5, 6, 7)
#define PG8_MMA(ai, bj, At, Bt) do { __builtin_amdgcn_s_setprio(1); _Pragma("unroll") for (int m = 0; m < 4; ++m) _Pragma("unroll") for (int n = 0; n < 2; ++n) { \
        if constexpr (F8) asm volatile("v_mfma_f32_16x16x128_f8f6f4 %0, %1, %2, %0" : "+v"(acc[ai][bj][m][n]) : "v"(PG8_CAT(Bt[n])), "v"(PG8_CAT(At[m])));       \
        else { _Pragma("unroll") for (int k = 0; k < 2; ++k) acc[ai][bj][m][n] = __builtin_amdgcn_mfma_f32_16x16x32_bf16(Bt[n][k], At[m][k], acc[ai][bj][m][n], 0, 0, 0); } } __builtin_amdgcn_s_setprio(0); } while (0)
#define PG8_WAIT_V(n) asm volatile("s_waitcnt vmcnt(" #n ")" ::: "memory")
#define PG8_WAIT_L(n) asm volatile("s_waitcnt lgkmcnt(" #n ")" ::: "memory")
#define PG8_BAR __builtin_amdgcn_s_barrier()
#define PG8_SCHED __builtin_amdgcn_sched_barrier(0)
#define PG8_PIN_ACC(txt) do { _Pragma("unroll") for (int a_ = 0; a_ < 2; ++a_) _Pragma("unroll") for (int b_ = 0; b_ < 2; ++b_) \
        asm volatile(txt : "+v"(acc[a_][b_][0][0]), "+v"(acc[a_][b_][0][1]), "+v"(acc[a_][b_][1][0]), "+v"(acc[a_][b_][1][1]), "+v"(acc[a_][b_][2][0]), "+v"(acc[a_][b_][2][1]), "+v"(acc[a_][b_][3][0]), "+v"(acc[a_][b_][3][1])); } while (0)
    Unit cur, nxt; int ui = 0;
    if (!S.next(0, cur)) return;
    f32x4 acc[2][2][4][2];
#pragma unroll
    for (int a = 0; a < 2; ++a)
#pragma unroll
        for (int b = 0; b < 2; ++b)
#pragma unroll
            for (int m = 0; m < 4; ++m)
#pragma unroll
                for (int n = 0; n < 2; ++n) acc[a][b][m][n] = (f32x4){0.f, 0.f, 0.f, 0.f};
    if constexpr (F8) PG8_PIN_ACC("");
    bf16x8 At[4][2], B0[2][2], B1[2][2];
    const char* cA = (const char*)g.A + (size_t)cur.pm * tstep; const char* cB = (const char*)g.Bt + (size_t)cur.pn * tstep;
    S.a_ready(cur);
    if constexpr (SP2) {
        PG8_STAGE(PG8_SB(0, 0), cB, voffB); PG8_STAGE(PG8_SB(0, 1), cB + hstepB, voffB); PG8_STAGE(PG8_SA(0, 0), cA, voffA); PG8_STAGE(PG8_SA(0, 1), cA + hstep, voffA);
        if (wr == 1) PG8_BAR;
        PG8_WAIT_V(2); PG8_BAR;
        PG8_STAGE(PG8_SB(1, 0), cB + kstep, voffB); PG8_STAGE(PG8_SA(1, 0), cA + kstep, voffA); PG8_STAGE(PG8_SB(1, 1), cB + hstepB + kstep, voffB);
        PG8_WAIT_V(6); PG8_BAR;
    } else {
        PG8_STAGE(PG8_SB(0, 0), cB, voffB); PG8_STAGE(PG8_SA(0, 0), cA, voffA); PG8_STAGE(PG8_SB(0, 1), cB + hstepB, voffB); PG8_STAGE(PG8_SA(0, 1), cA + hstep, voffA);
        if (wr == 1) PG8_BAR;
        PG8_WAIT_V(4); PG8_BAR;
        PG8_STAGE(PG8_SB(1, 0), cB + kstep, voffB); PG8_STAGE(PG8_SA(1, 0), cA + kstep, voffA); PG8_STAGE(PG8_SB(1, 1), cB + hstepB + kstep, voffB);
        PG8_WAIT_V(6); PG8_BAR;
    }
    for (;;) {
        const bool has_next = S.next(ui + 1, nxt);
        const char* nA = has_next ? (const char*)g.A + (size_t)nxt.pm * tstep : cA; const char* nB = has_next ? (const char*)g.Bt + (size_t)nxt.pn * tstep : cB;
        for (int t = 0; t < nt; t += 2) {
            const bool last = (t == nt - 2);
            const char* a1 = cA + (size_t)(t + 1) * kstep;
            const char* a2 = last ? nA : cA + (size_t)(t + 2) * kstep; const char* b2 = last ? nB : cB + (size_t)(t + 2) * kstep;
            const char* a3 = a2 + kstep; const char* b3 = b2 + kstep;
            if (last && has_next) S.a_ready(nxt);
            if constexpr (SP2) {
            PG8_LDB(B0, 0, 0); PG8_LDB(B1, 0, 1); PG8_SCHED; PG8_LDA(At, 0, 0); PG8_STAGE(PG8_SA(1, 1), a1 + hstep, voffA);
            PG8_WAIT_V(8); PG8_WAIT_L(0); PG8_BAR; PG8_MMA(0, 0, At, B0); PG8_MMA(0, 1, At, B1); PG8_BAR; PG8_SCHED;
            PG8_LDA(At, 0, 1); PG8_STAGE(PG8_SB(0, 0), b2, voffB); PG8_STAGE(PG8_SB(0, 1), b2 + hstepB, voffB); PG8_STAGE(PG8_SA(0, 0), a2, voffA);
            PG8_WAIT_V(8); PG8_WAIT_L(0); PG8_BAR; PG8_MMA(1, 0, At, B0); PG8_MMA(1, 1, At, B1); PG8_BAR; PG8_SCHED;
            PG8_LDB(B0, 1, 0); PG8_LDB(B1, 1, 1); PG8_SCHED; PG8_LDA(At, 1, 0); PG8_STAGE(PG8_SA(0, 1), a2 + hstep, voffA);
            PG8_WAIT_V(8); PG8_WAIT_L(0); PG8_BAR; PG8_MMA(0, 0, At, B0); PG8_MMA(0, 1, At, B1); PG8_BAR; PG8_SCHED;
            PG8_LDA(At, 1, 1); PG8_STAGE(PG8_SB(1, 0), b3, voffB); PG8_STAGE(PG8_SB(1, 1), b3 + hstepB, voffB); PG8_STAGE(PG8_SA(1, 0), a3, voffA);
            PG8_WAIT_V(8); PG8_WAIT_L(0); PG8_BAR; PG8_MMA(1, 0, At, B0); PG8_MMA(1, 1, At, B1); PG8_BAR; PG8_SCHED;
            } else {
            PG8_LDB(B0, 0, 0); PG8_SCHED; PG8_LDA(At, 0, 0); PG8_STAGE(PG8_SA(1, 1), a1 + hstep, voffA);
            PG8_WAIT_L(8); PG8_BAR; PG8_WAIT_L(0); PG8_MMA(0, 0, At, B0); PG8_BAR; PG8_SCHED;
            PG8_LDB(B1, 0, 1); PG8_STAGE(PG8_SB(0, 0), b2, voffB);
            PG8_BAR; PG8_WAIT_L(0); PG8_MMA(0, 1, At, B1); PG8_BAR;
            PG8_LDA(At, 0, 1); PG8_STAGE(PG8_SA(0, 0), a2, voffA);
            PG8_BAR; PG8_WAIT_L(0); PG8_MMA(1, 0, At, B0); PG8_BAR; PG8_SCHED;
            PG8_STAGE(PG8_SB(0, 1), b2 + hstepB, voffB);
            PG8_WAIT_V(6); PG8_BAR; PG8_MMA(1, 1, At, B1); PG8_BAR;
            PG8_LDB(B0, 1, 0); PG8_SCHED; PG8_LDA(At, 1, 0); PG8_STAGE(PG8_SA(0, 1), a2 + hstep, voffA);
            PG8_WAIT_L(8); PG8_BAR; PG8_WAIT_L(0); PG8_MMA(0, 0, At, B0); PG8_BAR; PG8_SCHED;
            PG8_LDB(B1, 1, 1); PG8_STAGE(PG8_SB(1, 0), b3, voffB);
            PG8_BAR; PG8_WAIT_L(0); PG8_MMA(0, 1, At, B1); PG8_BAR;
            PG8_LDA(At, 1, 1); PG8_STAGE(PG8_SA(1, 0), a3, voffA);
            PG8_BAR; PG8_WAIT_L(0); PG8_MMA(1, 0, At, B0); PG8_BAR; PG8_SCHED;
            PG8_STAGE(PG8_SB(1, 1), b3 + hstepB, voffB);
            PG8_WAIT_V(6); PG8_BAR; PG8_MMA(1, 1, At, B1); PG8_BAR;
            }
        }
        if constexpr (F8) PG8_PIN_ACC("s_nop 15");
        if constexpr (ALIGN_EPI) { if (wr == 0) PG8_BAR; }
        if constexpr (!Epi::AFTER_DRAIN) { E(acc, cur, wr, wc, fr, fq); S.done(cur); }
        if (!has_next) break;
#pragma unroll
        for (int a = 0; a < 2; ++a)
#pragma unroll
            for (int b = 0; b < 2; ++b)
#pragma unroll
                for (int m = 0; m < 4; ++m)
#pragma unroll
                    for (int n = 0; n < 2; ++n) acc[a][b][m][n] = (f32x4){0.f, 0.f, 0.f, 0.f};
        if constexpr (F8) PG8_PIN_ACC("");
        cur = nxt; cA = nA; cB = nB; ++ui;
        if constexpr (ALIGN_EPI) { if (wr == 1) PG8_BAR; }
    }
    PG8_WAIT_V(0);
    if constexpr (!ALIGN_EPI) { if (wr == 0) PG8_BAR; }
    PG8_BAR;
    if constexpr (Epi::AFTER_DRAIN) { E.fused(acc, cur, wr, wc, fr, fq, lds, wid, lane); S.done(cur); }
#undef PG8_SA
#undef PG8_SB
#undef PG8_STAGE
#undef PG8_LDA
#undef PG8_LDB
#undef PG8_MMA
#undef PG8_CAT
#undef PG8_PIN_ACC
#undef PG8_WAIT_V
#undef PG8_WAIT_L
#undef PG8_BAR
#undef PG8_SCHED
}
}

#ifndef PG8_SP2
#define PG8_SP2 true
#endif
#ifndef PG8_ALIGN
#define PG8_ALIGN true
#endif

namespace attn_body {
using bf16=__hip_bfloat16;
using bf16x8=__attribute__((ext_vector_type(8)))short;
using s16x4=__attribute__((ext_vector_type(4)))short;
using f32x16=__attribute__((ext_vector_type(16)))float;
using u32x4=__attribute__((ext_vector_type(4)))unsigned;
constexpr int BATCH=8,NHEAD=8,SEQ=2048,D=64,DM=2560,YP=1024;
constexpr int NW=8,QBLK=32,QB=QBLK*NW,KVBLK=64,NQB=SEQ/QB;
constexpr int ATTN_PITCH=DM, ATTN_UNIT_ROWS=QB;
__device__ __forceinline__ int crow(int r,int hi){return (r&3)+8*(r>>2)+4*hi;}
#define SBAR() __builtin_amdgcn_sched_barrier(0)
__device__ __forceinline__ void cmask(f32x16&p0,f32x16&p1,int jb,int qrel,int hi){
  const float NEG=-INFINITY; int kb=64*jb+4*hi;
  #pragma unroll
  for(int r=0;r<16;++r){int kv=kb+(r&3)+8*(r>>2); if(kv>qrel)p0[r]=NEG; if(kv+32>qrel)p1[r]=NEG;}
}

constexpr int NSLOT=3, SLOTB=8192;
constexpr int LDS_K=0, LDS_V=NSLOT*SLOTB, LDS_WS=2*NSLOT*SLOTB, LDS_OST=LDS_WS+NW*64*4, LDS_BYTES=LDS_OST+NW*8192;
constexpr float C2=0.125f*1.4426950408889634f;
__device__ __forceinline__ void glds16(const void*gsrc,unsigned lds_dst){unsigned keep;
  asm volatile("s_mov_b32 %0, m0\n\ts_mov_b32 m0, %2\n\ts_nop 0\n\tglobal_load_lds_dwordx4 %1, off\n\ts_mov_b32 m0, %0":"=&s"(keep):"v"(gsrc),"s"(lds_dst):"memory");}
__device__ __forceinline__ float max3f(float a,float b,float c){float r;asm("v_max3_f32 %0, %1, %2, %3":"=v"(r):"v"(a),"v"(b),"v"(c));return r;}
__device__ __forceinline__ float max2f(float a,float b){float r;asm("v_max_f32_e32 %0, %1, %2":"=v"(r):"v"(a),"v"(b));return r;}
__device__ __forceinline__ float fadd_s(float a,float b){float r;asm("v_add_f32_e32 %0, %1, %2":"=v"(r):"v"(a),"v"(b));return r;}
__device__ __forceinline__ float fsub_s(float a,float b){float r;asm("v_sub_f32_e32 %0, %1, %2":"=v"(r):"v"(a),"v"(b));return r;}
typedef float f32x2_t __attribute__((ext_vector_type(2))); typedef __bf16 bf16x2_t __attribute__((ext_vector_type(2))); typedef float f32x4_t __attribute__((ext_vector_type(4))); typedef unsigned u32x2_t __attribute__((ext_vector_type(2)));
__device__ __forceinline__ unsigned cvtpk_s(float lo,float hi){f32x2_t v={lo,hi};bf16x2_t b=__builtin_convertvector(v,bf16x2_t);return __builtin_bit_cast(unsigned,b);}
#define WAIT_BAR(N) asm volatile("s_waitcnt vmcnt(" #N ") lgkmcnt(0)\n\ts_barrier":::"memory")

__device__ __forceinline__ void qkt(f32x16&p0,f32x16&p1,const char*Kslot,const bf16x8*qr,const f32x16&negm,int r32,int hi){
  const char*kb=Kslot+hi*1024+r32*16;
  #pragma unroll
  for(int d0=0;d0<4;++d0){
    const bf16x8 b0=*reinterpret_cast<const bf16x8*>(kb+d0*2048);
    const bf16x8 b1=*reinterpret_cast<const bf16x8*>(kb+d0*2048+512);
    if(d0==0){p0=__builtin_amdgcn_mfma_f32_32x32x16_bf16(b0,qr[0],negm,0,0,0);p1=__builtin_amdgcn_mfma_f32_32x32x16_bf16(b1,qr[0],negm,0,0,0);}
    else{p0=__builtin_amdgcn_mfma_f32_32x32x16_bf16(b0,qr[d0],p0,0,0,0);p1=__builtin_amdgcn_mfma_f32_32x32x16_bf16(b1,qr[d0],p1,0,0,0);}}
}
typedef __attribute__((address_space(3))) const char* lds_cptr;
typedef short v4i16_t __attribute__((ext_vector_type(4)));
__device__ __forceinline__ void kload8(bf16x8*kf,lds_cptr kp){
  kf[0]=*(const __attribute__((address_space(3))) bf16x8*)(kp);      kf[1]=*(const __attribute__((address_space(3))) bf16x8*)(kp+512);
  kf[2]=*(const __attribute__((address_space(3))) bf16x8*)(kp+2048); kf[3]=*(const __attribute__((address_space(3))) bf16x8*)(kp+2560);
  kf[4]=*(const __attribute__((address_space(3))) bf16x8*)(kp+4096); kf[5]=*(const __attribute__((address_space(3))) bf16x8*)(kp+4608);
  kf[6]=*(const __attribute__((address_space(3))) bf16x8*)(kp+6144); kf[7]=*(const __attribute__((address_space(3))) bf16x8*)(kp+6656);
}
__device__ __forceinline__ void kload2(bf16x8*kf,lds_cptr kp,int j){ kf[2*j]=*(const __attribute__((address_space(3))) bf16x8*)(kp+j*2048); kf[2*j+1]=*(const __attribute__((address_space(3))) bf16x8*)(kp+j*2048+512); }
__device__ __forceinline__ s16x4 vtr(lds_cptr p){ return __builtin_bit_cast(s16x4,__builtin_amdgcn_ds_read_tr16_b64_v4i16((__attribute__((address_space(3))) v4i16_t*)p)); }
__device__ __forceinline__ float rowmax(const f32x16&p0,const f32x16&p1){
  float a=max3f(p0[0],p0[1],p1[0]),b=max3f(p0[2],p0[3],p1[1]);a=max3f(a,p1[2],p1[3]);
  #pragma unroll
  for(int r=4;r<16;r+=4){a=max3f(a,p0[r],p0[r+1]);b=max3f(b,p0[r+2],p0[r+3]);a=max3f(a,p1[r],p1[r+1]);b=max3f(b,p1[r+2],p1[r+3]);}
  const float m=max2f(a,b);
  auto rr=__builtin_amdgcn_permlane32_swap(__float_as_uint(m),__float_as_uint(m),false,false);
  return max2f(__uint_as_float(rr[0]),__uint_as_float(rr[1]));
}
__device__ __forceinline__ void pv(f32x16*o,int vb,bf16x8 pa0,bf16x8 pa1,bf16x8 pa2,bf16x8 pa3){
  #pragma unroll
  for(int d0=0;d0<2;++d0){s16x4 lo[4],hi[4];
    #pragma unroll
    for(int ks=0;ks<4;++ks){
      asm volatile("ds_read_b64_tr_b16 %0,%1 offset:%c2":"=&v"(lo[ks]):"v"(vb),"i"(d0*4096+ks*1024):"memory");
      asm volatile("ds_read_b64_tr_b16 %0,%1 offset:%c2":"=&v"(hi[ks]):"v"(vb),"i"(d0*4096+ks*1024+512):"memory");}
    asm volatile("s_waitcnt lgkmcnt(0)":::"memory");SBAR();
    #define PK(k) (bf16x8){lo[k][0],lo[k][1],lo[k][2],lo[k][3],hi[k][0],hi[k][1],hi[k][2],hi[k][3]}
    o[d0]=__builtin_amdgcn_mfma_f32_32x32x16_bf16(pa0,PK(0),o[d0],0,0,0);
    o[d0]=__builtin_amdgcn_mfma_f32_32x32x16_bf16(pa1,PK(1),o[d0],0,0,0);
    o[d0]=__builtin_amdgcn_mfma_f32_32x32x16_bf16(pa2,PK(2),o[d0],0,0,0);
    o[d0]=__builtin_amdgcn_mfma_f32_32x32x16_bf16(pa3,PK(3),o[d0],0,0,0);
    #undef PK
  }
}

#ifndef ATTN_STORE16
#define ATTN_STORE16(p,v) (*(u32x4*)(p)=(v))
#endif
template<int THRL> __device__ __forceinline__ void attn_unit(int b,int h,int qb,const bf16*Q,const bf16*__restrict__ K,const bf16*__restrict__ V,bf16*Y,const float*__restrict__ ksum,const float*__restrict__ onb_g,char*shm){
  int tid_=threadIdx.x; asm volatile("":"+v"(tid_)); const int tid=tid_,lane=tid&63,r32=lane&31,hi=lane>>5; const int wid=__builtin_amdgcn_readfirstlane(tid>>6);
  const long rowbase=(long)b*SEQ; const int q0=qb*QB;
  const bf16*Qw=Q+(rowbase+q0+wid*QBLK)*DM+h*D;
  const bf16*Kh=K+rowbase*DM+h*D,*Vh=V+rowbase*DM+h*D;
  const unsigned lds0=(unsigned)(uintptr_t)shm;
  float*wsf=(float*)(shm+LDS_WS)+wid*64;
  const bf16*ksrc=Kh+(long)lane*DM+wid*8;
  const bf16*vsrc=Vh+(long)(16*(wid&3)+(lane>>2))*DM+(wid>>2)*32+(lane&3)*8;
  const unsigned kdst=lds0+LDS_K+wid*1024, vdst=lds0+LDS_V+wid*1024;
  #define DMA_K(t,slot) glds16(ksrc+(long)(t)*KVBLK*DM,(unsigned)__builtin_amdgcn_readfirstlane(kdst+(slot)))
  #define DMA_V(t,slot) glds16(vsrc+(long)(t)*KVBLK*DM,(unsigned)__builtin_amdgcn_readfirstlane(vdst+(slot)))
  const int vb0=(int)(lds0+LDS_V)+((lane>>4)&1)*32+(lane&3)*8+(4*hi+((lane&15)>>2))*64;
  const char*Kbase=shm+LDS_K; bf16x8 kf[8];
  const lds_cptr shm3=(lds_cptr)shm; const lds_cptr kp0=shm3+LDS_K+hi*1024+r32*16; const lds_cptr vp0=shm3+LDS_V+((lane>>4)&1)*32+(lane&3)*8+(4*hi+((lane&15)>>2))*64;
  const int NT=(q0+QB)/KVBLK;
  DMA_K(0,0);DMA_V(0,0);DMA_K(1,SLOTB);
  bf16x8 qr[4];
  #pragma unroll
  for(int d0=0;d0<4;++d0)qr[d0]=*reinterpret_cast<const bf16x8*>(&Qw[(long)r32*DM+d0*16+hi*8]);
  unsigned selbits;
  { f32x16 g=f32x16{};
    const float*kr=ksum+((((long)(b*(SEQ/QB)+r32)*2)*NHEAD+h)*D)+hi*8;
    #pragma unroll
    for(int d0=0;d0<4;++d0){ f32x4_t a0={0.f,0.f,0.f,0.f},a1={0.f,0.f,0.f,0.f}; if(r32<qb){a0=*reinterpret_cast<const f32x4_t*>(kr+d0*16)+*reinterpret_cast<const f32x4_t*>(kr+NHEAD*D+d0*16);a1=*reinterpret_cast<const f32x4_t*>(kr+d0*16+4)+*reinterpret_cast<const f32x4_t*>(kr+NHEAD*D+d0*16+4);}
      float hv[8],lv[8];
      #pragma unroll
      for(int e=0;e<4;++e){const float t0=a0[e],t1=a1[e];     hv[e]=__uint_as_float(__float_as_uint(t0)&0xffff0000u);lv[e]=t0-hv[e];hv[4+e]=__uint_as_float(__float_as_uint(t1)&0xffff0000u);lv[4+e]=t1-hv[4+e];}
      u32x4 wh={cvtpk_s(hv[0],hv[1]),cvtpk_s(hv[2],hv[3]),cvtpk_s(hv[4],hv[5]),cvtpk_s(hv[6],hv[7])},wl={cvtpk_s(lv[0],lv[1]),cvtpk_s(lv[2],lv[3]),cvtpk_s(lv[4],lv[5]),cvtpk_s(lv[6],lv[7])};
      g=__builtin_amdgcn_mfma_f32_32x32x16_bf16(__builtin_bit_cast(bf16x8,wh),qr[d0],g,0,0,0);
      g=__builtin_amdgcn_mfma_f32_32x32x16_bf16(__builtin_bit_cast(bf16x8,wl),qr[d0],g,0,0,0);}
    float gt[8];
    #pragma unroll
    for(int r=0;r<4;++r){auto rr=__builtin_amdgcn_permlane32_swap(__float_as_uint(g[r]),__float_as_uint(g[r]),false,false);gt[r]=__uint_as_float(rr[0]);gt[4+r]=__uint_as_float(rr[1]);}
    selbits=1u<<qb;
    #pragma unroll
    for(int n=0;n<7;++n){int rank=0;
      #pragma unroll
      for(int m=0;m<7;++m)if(m!=n)rank+=(m<qb&&(gt[m]>gt[n]||(gt[m]==gt[n]&&m<n)))?1:0;
      if(n<qb&&rank<3)selbits|=1u<<n;}
  }
  #define MSKF(n) ((((selbits>>(n))&1u)!=0u)?0.f:-INFINITY)
  float mhat=0.f,l_reg=0.f;f32x16 o[2];o[0]=f32x16{};o[1]=f32x16{};f32x16 negm;{const float nm0=MSKF(0);
  #pragma unroll
  for(int r=0;r<16;++r)negm[r]=nm0;}asm volatile("":"+v"(negm));
  #define NEWBLK(tt) do{ if((((tt)&3)==0)){ const float nm_=MSKF((tt)>>2)-mhat; _Pragma("unroll") for(int r=0;r<16;++r)negm[r]=nm_; asm volatile("":"+v"(negm)); } }while(0)
  const int qrel=wid*QBLK+r32;
  #define CMASK(P0,P1,t) do{int jb_=(t)-(NT-4); if(jb_>=0)cmask(P0,P1,jb_,qrel,hi);}while(0)
  bool resc=false;
  #define START(P0,P1) do{ const float rm=rowmax(P0,P1); resc=false; \
    { const float dl=(rm==-INFINITY)?0.f:rm; mhat=fadd_s(mhat,dl); \
      _Pragma("unroll") for(int r=0;r<16;++r){P0[r]=fsub_s(P0[r],dl);P1[r]=fsub_s(P1[r],dl);} \
      const float nm_=MSKF(0)-mhat; _Pragma("unroll") for(int r=0;r<16;++r)negm[r]=nm_; asm volatile("":"+v"(negm)); } \
    _Pragma("unroll") for(int r=0;r<16;++r)P0[r]=__builtin_amdgcn_exp2f(P0[r]); }while(0)
  #define RESC() do{ if(resc){ asm volatile("s_waitcnt lgkmcnt(0)":::"memory"); \
      _Pragma("unroll") for(int d_=0;d_<2;++d_) _Pragma("unroll") for(int r=0;r<16;++r)o[d_][r]*=wsf[crow(r,hi)]; } }while(0)
  f32x16 pA0,pA1,pB0,pB1;
  int sl_prev=0,sl_cur=0,sl_next=SLOTB;
  #define ROT() do{sl_prev=sl_cur;sl_cur=sl_next;sl_next=(sl_next==(NSLOT-1)*SLOTB)?0:sl_next+SLOTB;}while(0)
  DMA_K(2,2*SLOTB);
  WAIT_BAR(3);
  qkt(pA0,pA1,Kbase,qr,negm,r32,hi);asm volatile("s_nop 15\n\ts_nop 7":"+v"(pA0),"+v"(pA1));CMASK(pA0,pA1,0);
  START(pA0,pA1);
  _Pragma("unroll") for(int r=0;r<16;++r)pA1[r]=__builtin_amdgcn_exp2f(pA1[r]);
  WAIT_BAR(0);
  DMA_K(3,0);DMA_V(1,SLOTB);
  ROT();
  kload8(kf,kp0+sl_cur);
  WAIT_BAR(2);
  s16x4 vlo[8],vhi[8]; u32x4 pw0,pw1,pw2,pw3;
  #define PKW(P,B) cvtpk_s(P[B],P[B+1])
  #define PAF(k) __builtin_bit_cast(bf16x8,pw##k)
  #define VFR(i) (bf16x8){vlo[i][0],vlo[i][1],vlo[i][2],vlo[i][3],vhi[i][0],vhi[i][1],vhi[i][2],vhi[i][3]}
  #define PIN(x) asm volatile("":"+v"(x))
  #define MX3(a,b,c) __builtin_fmaxf(__builtin_fmaxf((a),(b)),(c))
  #define GAPA(MF,A0,A1,A2,A3,W0,W1,PW) do{ MF; sacc+=A0; sacc+=A1; sacc+=A2; sacc+=A3; PIN(sacc); W0; W1; PIN(PW); SBAR(); }while(0)
  #define EX(v) __builtin_amdgcn_exp2f(v)
  #define GAPB(MF,X,B) do{ MF; X[B]=EX(X[B]); X[B+1]=EX(X[B+1]); X[B+2]=EX(X[B+2]); X[B+3]=EX(X[B+3]); PIN(X); SBAR(); }while(0)
  #define VRD(i) do{ vlo[i]=vtr(vp_+(((i)>>2)*4096+((i)&3)*1024)); vhi[i]=vtr(vp_+(((i)>>2)*4096+((i)&3)*1024+512)); }while(0)
  #define KRD(G,j) do{ if(G){ kload2(kf,kp0+sl_next,j); SBAR(); } }while(0)
  #define STEP(C0,C1,P0,P1,t,GK,GV,GL) do{ SBAR(); \
    const lds_cptr vp_=vp0+sl_prev; \
    VRD(0); SBAR(); float sacc=(P0[0]+P0[1]); \
    GAPA(C0=__builtin_amdgcn_mfma_f32_32x32x16_bf16(kf[0],qr[0],negm,0,0,0), P0[2],P0[3],P0[4],P0[5],     pw0[0]=PKW(P0,0), pw0[1]=PKW(P0,2), pw0); \
    VRD(4); SBAR(); GAPA(C1=__builtin_amdgcn_mfma_f32_32x32x16_bf16(kf[1],qr[0],negm,0,0,0), P0[6],P0[7],P0[8],P0[9],     pw0[2]=PKW(P0,4), pw0[3]=PKW(P0,6), pw0); \
    VRD(1); SBAR(); GAPA(C0=__builtin_amdgcn_mfma_f32_32x32x16_bf16(kf[2],qr[1],C0,0,0,0),   P0[10],P0[11],P0[12],P0[13], pw1[0]=PKW(P0,8), pw1[1]=PKW(P0,10), pw1); \
    VRD(5); SBAR(); GAPA(C1=__builtin_amdgcn_mfma_f32_32x32x16_bf16(kf[3],qr[1],C1,0,0,0),   P0[14],P0[15],P1[0],P1[1],   pw1[2]=PKW(P0,12),pw1[3]=PKW(P0,14), pw1); \
    VRD(2); SBAR(); GAPA(C0=__builtin_amdgcn_mfma_f32_32x32x16_bf16(kf[4],qr[2],C0,0,0,0),   P1[2],P1[3],P1[4],P1[5],     pw2[0]=PKW(P1,0), pw2[1]=PKW(P1,2), pw2); \
    VRD(6); SBAR(); GAPA(C1=__builtin_amdgcn_mfma_f32_32x32x16_bf16(kf[5],qr[2],C1,0,0,0),   P1[6],P1[7],P1[8],P1[9],     pw2[2]=PKW(P1,4), pw2[3]=PKW(P1,6), pw2); \
    VRD(3); SBAR(); GAPA(C0=__builtin_amdgcn_mfma_f32_32x32x16_bf16(kf[6],qr[3],C0,0,0,0),   P1[10],P1[11],P1[12],P1[13], pw3[0]=PKW(P1,8), pw3[1]=PKW(P1,10), pw3); \
    VRD(7); SBAR(); GAPA(C1=__builtin_amdgcn_mfma_f32_32x32x16_bf16(kf[7],qr[3],C1,0,0,0),   P1[14],P1[15],0.f,0.f,       pw3[2]=PKW(P1,12),pw3[3]=PKW(P1,14), pw3); \
    l_reg+=sacc; \
    if(GK){DMA_K((t)+3,sl_cur);} if(GV){DMA_V((t)+1,sl_next);} \
    CMASK(C0,C1,t); \
    { float a=MX3(C0[0],C0[1],C1[0]),b=MX3(C0[2],C0[3],C1[1]); a=MX3(a,C1[2],C1[3]); \
      _Pragma("unroll") for(int r=4;r<16;r+=4){a=MX3(a,C0[r],C0[r+1]);b=MX3(b,C0[r+2],C0[r+3]);a=MX3(a,C1[r],C1[r+1]);b=MX3(b,C1[r+2],C1[r+3]);} \
      float rm=__builtin_fmaxf(a,b); { auto rr=__builtin_amdgcn_permlane32_swap(__float_as_uint(rm),__float_as_uint(rm),false,false); rm=__builtin_fmaxf(__uint_as_float(rr[0]),__uint_as_float(rr[1])); } \
      resc=false; \
      if(__builtin_expect(__any(rm>(float)THRL),0)){ const float dl=__builtin_fmaxf(rm,0.f); mhat+=dl; \
        _Pragma("unroll") for(int r=0;r<16;++r){C0[r]-=dl;C1[r]-=dl;} \
        const float nm_=MSKF((t)>>2)-mhat; _Pragma("unroll") for(int r=0;r<16;++r)negm[r]=nm_; asm volatile("":"+v"(negm)); \
        const float f=__builtin_amdgcn_exp2f(-dl); l_reg*=f; if(hi==0)wsf[r32]=f; resc=true; } } \
    SBAR(); \
    GAPB(o[0]=__builtin_amdgcn_mfma_f32_32x32x16_bf16(PAF(0),VFR(0),o[0],0,0,0), C0,0); \
    GAPB(o[1]=__builtin_amdgcn_mfma_f32_32x32x16_bf16(PAF(0),VFR(4),o[1],0,0,0), C0,4); \
    KRD(GL,0); GAPB(o[0]=__builtin_amdgcn_mfma_f32_32x32x16_bf16(PAF(1),VFR(1),o[0],0,0,0), C0,8); \
    KRD(GL,1); GAPB(o[1]=__builtin_amdgcn_mfma_f32_32x32x16_bf16(PAF(1),VFR(5),o[1],0,0,0), C0,12); \
    KRD(GL,2); GAPB(o[0]=__builtin_amdgcn_mfma_f32_32x32x16_bf16(PAF(2),VFR(2),o[0],0,0,0), C1,0); \
    KRD(GL,3); GAPB(o[1]=__builtin_amdgcn_mfma_f32_32x32x16_bf16(PAF(2),VFR(6),o[1],0,0,0), C1,4); \
    GAPB(o[0]=__builtin_amdgcn_mfma_f32_32x32x16_bf16(PAF(3),VFR(3),o[0],0,0,0), C1,8); \
    GAPB(o[1]=__builtin_amdgcn_mfma_f32_32x32x16_bf16(PAF(3),VFR(7),o[1],0,0,0), C1,12); \
    }while(0)
  int t=1;
  #undef CMASK
  #define CMASK(P0,P1,t) do{}while(0)
  for(;t+5<NT;t+=2){
    STEP(pB0,pB1,pA0,pA1,t,true,true,true);     WAIT_BAR(2); RESC(); ROT(); NEWBLK(t+1);
    STEP(pA0,pA1,pB0,pB1,t+1,true,true,true);   WAIT_BAR(2); RESC(); ROT();
  }
  #undef CMASK
  #define CMASK(P0,P1,t) do{int jb_=(t)-(NT-4); if(jb_>=0)cmask(P0,P1,jb_,qrel,hi);}while(0)
  #define ENDW(tt) do{ if((tt)+3<NT){WAIT_BAR(2);} else if((tt)+2<NT){WAIT_BAR(1);} else {WAIT_BAR(0);} }while(0)
  for(;t+1<NT;t+=2){
    STEP(pB0,pB1,pA0,pA1,t,(t+3<NT),(t+1<NT),(t+1<NT));       ENDW(t);   RESC(); ROT(); NEWBLK(t+1);
    STEP(pA0,pA1,pB0,pB1,t+1,(t+4<NT),(t+2<NT),(t+2<NT));     ENDW(t+1); RESC(); ROT();
  }
  STEP(pB0,pB1,pA0,pA1,NT-1,false,false,false); RESC();
  { float sacc=pB0[0]+pB0[1]; _Pragma("unroll") for(int r=2;r<16;++r)sacc+=pB0[r]; _Pragma("unroll") for(int r=0;r<16;++r)sacc+=pB1[r]; l_reg+=sacc;
    pw0=(u32x4){PKW(pB0,0),PKW(pB0,2),PKW(pB0,4),PKW(pB0,6)};pw1=(u32x4){PKW(pB0,8),PKW(pB0,10),PKW(pB0,12),PKW(pB0,14)};pw2=(u32x4){PKW(pB1,0),PKW(pB1,2),PKW(pB1,4),PKW(pB1,6)};pw3=(u32x4){PKW(pB1,8),PKW(pB1,10),PKW(pB1,12),PKW(pB1,14)};
    SBAR(); pv(o,vb0+sl_cur,PAF(0),PAF(1),PAF(2),PAF(3)); }
  #undef PKW
  #undef PAF
  #undef VFR
  #undef PIN
  #undef MX3
  #undef GAPA
  #undef GAPB
  #undef EX
  #undef VRD
  #undef KRD
  #undef STEP
  #undef ENDW
  {auto rr=__builtin_amdgcn_permlane32_swap(__float_as_uint(l_reg),__float_as_uint(l_reg),false,false);l_reg=__uint_as_float(rr[0])+__uint_as_float(rr[1]);}
  if(hi==0)wsf[32+r32]=l_reg;asm volatile("s_waitcnt lgkmcnt(0)":::"memory");
  float rli[16];
  #pragma unroll
  for(int r=0;r<16;++r)rli[r]=__builtin_amdgcn_rcpf(wsf[32+crow(r,hi)]);
  bf16*Yw=Y+(rowbase+q0+wid*QBLK)*YP+h*D;
  { float*stg=(float*)(shm+LDS_OST)+wid*2048;
    #pragma unroll
    for(int r=0;r<16;++r){const int orow=crow(r,hi);
      #pragma unroll
      for(int d0=0;d0<2;++d0)stg[orow*64+d0*32+r32]=o[d0][r]*rli[r];}
    asm volatile("s_waitcnt lgkmcnt(0)":::"memory");
    const int c4=lane&15; const f32x4_t g4=*reinterpret_cast<const f32x4_t*>(onb_g+h*D+c4*4);
    #pragma unroll
    for(int i=0;i<8;++i){const int row=i*4+(lane>>4); const f32x4_t v=*(const f32x4_t*)(stg+row*64+c4*4);
      float ss=(v[0]*v[0]+v[1]*v[1])+(v[2]*v[2]+v[3]*v[3]); ss+=__shfl_xor(ss,1); ss+=__shfl_xor(ss,2); ss+=__shfl_xor(ss,4); ss+=__shfl_xor(ss,8);
      const float rs=__builtin_amdgcn_rsqf(ss*(1.0f/64.0f)+1e-6f);
      u32x2_t w; w.x=cvtpk_s(v[0]*rs*g4[0],v[1]*rs*g4[1]); w.y=cvtpk_s(v[2]*rs*g4[2],v[3]*rs*g4[3]);
      *(u32x2_t*)(Yw+(long)row*YP+c4*4)=w;} }
  asm volatile("s_waitcnt lgkmcnt(0)\n\ts_barrier":::"memory");
  #undef DMA_K
  #undef DMA_V
  #undef MSKF
  #undef NEWBLK
  #undef CMASK
  #undef START
  #undef RESC
  #undef ROT
}
constexpr int ATTN_LDS_BYTES=LDS_BYTES;
struct AttnTensors { const bf16* Q; const bf16* K; const bf16* V; bf16* Y; const float* ksum; const float* onb_g; };
struct AttnUnit { int bh; int qb; };
struct StaticOrder {
  int vcu,G;
  __device__ __forceinline__ explicit StaticOrder(int grid,int block):vcu((grid%8==0)?(block%8)*(grid/8)+block/8:block),G(grid){}
  __device__ __forceinline__ bool next(int i,AttnUnit&u)const{ const int p=vcu+(i>>1)*G; if(p>=BATCH*NHEAD*4)return false; const int s=p&3; u.bh=p>>2; u.qb=(i&1)?7-s:s; return true; }
  __device__ __forceinline__ void a_ready(const AttnUnit&)const{}
  __device__ __forceinline__ void done(const AttnUnit&)const{}
};
template<class Sched,int THRL=8> __device__ __forceinline__ void attn_phase(char*lds,const AttnTensors&T,const Sched&S){
  AttnUnit u;
  for(int i=0;S.next(i,u);++i){ S.a_ready(u); attn_unit<THRL>(u.bh/NHEAD,u.bh%NHEAD,u.qb,T.Q,T.K,T.V,T.Y,T.ksum,T.onb_g,lds); S.done(u); }
}
#undef SBAR
#undef WAIT_BAR
}
constexpr int NWAVES = 8;
constexpr int CW_TMO = 0, CW_CODE = 1, CW_EXIT = 2, CW_START = 64;
constexpr int CW_BAR = 4096;
constexpr int RING_OFF = 0, RING_BYTES = 131072;
constexpr int LDSCTL_OFF = RING_BYTES, MISC_OFF = LDSCTL_OFF + 320;
constexpr int LDS_BYTES = 147456;
constexpr int PAR_OFF = LDSCTL_OFF + 1024;
constexpr int RSL_OFF = PAR_OFF + 5120;
static_assert(MISC_OFF + 128 <= PAR_OFF && PAR_OFF + 1152 * 4 <= RSL_OFF && RSL_OFF + 2048 <= LDS_BYTES, "LDS map");

#define GAS __attribute__((address_space(1)))
#define LAS __attribute__((address_space(3)))
typedef unsigned short bf16;
typedef unsigned v4u __attribute__((ext_vector_type(4)));
typedef float f32x4 __attribute__((ext_vector_type(4)));
typedef short bf16x8 __attribute__((ext_vector_type(8)));
typedef GAS unsigned gu32;
typedef GAS unsigned long long gu64;
#define RLX_AGENT __ATOMIC_RELAXED, __HIP_MEMORY_SCOPE_AGENT
#define LDS_WAIT() asm volatile("s_waitcnt lgkmcnt(0)" ::: "memory")
#define VM_WAIT() asm volatile("s_waitcnt vmcnt(0)" ::: "memory")
__device__ __forceinline__ unsigned long long rt() { return __builtin_amdgcn_s_memrealtime(); }
__device__ __forceinline__ unsigned f2bf(float f) { unsigned u = __builtin_bit_cast(unsigned, f); return (u + 0x7fffu + ((u >> 16) & 1u)) >> 16; }
__device__ __forceinline__ unsigned pk2(float lo, float hi) { return f2bf(lo) | (f2bf(hi) << 16); }

#define XB_TMO      128
#define XB_XCNT(j)  (256  + 64 * (j))
#define XB_XSUB(j)  (1280 + 64 * (j))
#define XB_XGEN(j)  (2304 + 64 * (j))
#define XB_TOP      3328
#define XB_TOPGEN   3392
#define XCD_BAR_WORDS 3456
#define XB_SPIN_CAP (1u << 18)

__device__ __forceinline__ unsigned xb_ld(unsigned* p)              { return __hip_atomic_load(p, __ATOMIC_RELAXED, __HIP_MEMORY_SCOPE_AGENT); }
__device__ __forceinline__ unsigned xb_add(unsigned* p, unsigned v) { return __hip_atomic_fetch_add(p, v, __ATOMIC_RELAXED, __HIP_MEMORY_SCOPE_AGENT); }
__device__ __forceinline__ unsigned xb_xcc_id() { return (unsigned)__builtin_amdgcn_s_getreg((3 << 11) | 20) & 0xFu; }
#define XB_SPIN(cond, bar) do { unsigned _sp = 0; while (cond) { __builtin_amdgcn_s_sleep(1); \
    if ((++_sp & 255u) == 0u) { if (xb_ld(&(bar)[XB_TMO])) break; if (_sp > XB_SPIN_CAP) { atomicAdd(&(bar)[XB_TMO], 1u); break; } } } } while (0)

struct XcdBarrier {
    unsigned* bar; unsigned x;
    volatile LAS unsigned* st;
};

__device__ __forceinline__ XcdBarrier xcd_barrier_post(unsigned* bar, volatile LAS unsigned* st) {
    XcdBarrier b; b.bar = bar; b.x = xb_xcc_id(); b.st = st;
    if (threadIdx.x == 0) (void)xb_add(&bar[XB_XCNT(b.x)], 1u);
    return b;
}
__device__ __forceinline__ void xcd_barrier_complete(unsigned* bar, unsigned x, unsigned& nloc, unsigned& nx) {
    const unsigned G = gridDim.x * gridDim.y * gridDim.z;
    unsigned sum, cnt, mine, sp = 0u;
    for (;;) {
        sum = 0u; cnt = 0u; mine = 0u;
#pragma unroll
        for (unsigned j = 0; j < 16; ++j) { const unsigned c = xb_ld(&bar[XB_XCNT(j)]); sum += c; cnt += (c > 0u) ? 1u : 0u; mine = (j == x) ? c : mine; }
        if (sum == G) break;
        __builtin_amdgcn_s_sleep(1);
        if ((++sp & 255u) == 0u) { if (xb_ld(&bar[XB_TMO])) break; if (sp > XB_SPIN_CAP) { atomicAdd(&bar[XB_TMO], 1u); break; } }
    }
    nloc = mine > 0u ? mine : 1u; nx = cnt > 0u ? cnt : 1u;
}

__device__ __forceinline__ void xcd_barrier(const XcdBarrier& b) {
    asm volatile("s_waitcnt vmcnt(0)" ::: "memory");
    __syncthreads();
    if (threadIdx.x == 0) {
        unsigned* bar = b.bar;
        __builtin_amdgcn_s_waitcnt(0);
        unsigned nloc = b.st[0], nx = b.st[1];
        if (nloc == 0u) { xcd_barrier_complete(bar, b.x, nloc, nx); b.st[0] = nloc; b.st[1] = nx; }
        const unsigned old = xb_add(&bar[XB_XSUB(b.x)], 1u);
        const unsigned gen = old / nloc;
        if (old + 1u == (gen + 1u) * nloc) {
            __builtin_amdgcn_fence(__ATOMIC_RELEASE, "agent");
            asm volatile("s_waitcnt vmcnt(0)" ::: "memory");
            const unsigned og = xb_add(&bar[XB_TOP], 1u);
            const unsigned tg = og / nx;
            if (og + 1u == (tg + 1u) * nx) xb_add(&bar[XB_TOPGEN], 1u);
            else XB_SPIN(xb_ld(&bar[XB_TOPGEN]) == tg, bar);
            __builtin_amdgcn_fence(__ATOMIC_ACQUIRE, "agent");
            xb_add(&bar[XB_XGEN(b.x)], 1u);
            asm volatile("s_waitcnt vmcnt(0)" ::: "memory");
        } else {
            XB_SPIN(xb_ld(&bar[XB_XGEN(b.x)]) == gen, bar);
            __builtin_amdgcn_fence(__ATOMIC_ACQUIRE, "agent");
            asm volatile("s_waitcnt vmcnt(0)" ::: "memory");
        }
    }
    __syncthreads();
}

struct Frame {
    LAS unsigned char* lds;
    volatile LAS unsigned* MISC;
    gu32* ctl;
    int tid, lane, wave;
    int vcu, G;
};

__device__ __forceinline__ float wave_sum(float v) {
#pragma unroll
    for (int o = 1; o < 64; o <<= 1) v += __shfl_xor(v, o);
    return v;
}
struct WTile { const float* W; const float* g; void* WT; int K, N, k0, n0; float scale; int f8, gu; };
constexpr int WT_S = 257;
__device__ __forceinline__ void wtile_load(const WTile& t, int wave, int lane, f32x4 (&v)[8]) {
#pragma unroll
    for (int i = 0; i < 8; ++i) v[i] = *(const GAS f32x4*)(t.W + (size_t)(t.k0 + wave + 8 * i) * t.N + t.n0 + 4 * lane);
}
__device__ __forceinline__ void wtile_store(const WTile& t, int tid, int wave, int lane, const f32x4 (&v)[8], LAS float* scr) {
#pragma unroll
    for (int i = 0; i < 8; ++i) { const int kk = wave + 8 * i; const float sc = t.g ? t.g[t.k0 + kk] * t.scale : t.scale; const f32x4 x = v[i] * sc;
        LAS float* p = scr + kk * WT_S + 4 * lane; p[0] = x.x; p[1] = x.y; p[2] = x.z; p[3] = x.w; }
    LDS_WAIT(); __syncthreads();
    if (!t.f8) {
#pragma unroll
        for (int j = 0; j < 4; ++j) { const int p = tid + 512 * j, c = p & 7, n = p >> 3; const LAS float* s = scr + (8 * c) * WT_S + n;
            v4u o; o.x = pk2(s[0 * WT_S], s[1 * WT_S]); o.y = pk2(s[2 * WT_S], s[3 * WT_S]); o.z = pk2(s[4 * WT_S], s[5 * WT_S]); o.w = pk2(s[6 * WT_S], s[7 * WT_S]);
            const int jn = t.n0 + n, row = t.gu ? ((jn >> 7) * 256 + (jn & 127) + (t.gu == 2 ? 128 : 0)) : jn;
            *(GAS v4u*)((bf16*)t.WT + (size_t)row * t.K + t.k0 + 8 * c) = o; }
    } else {
#pragma unroll
        for (int j = 0; j < 2; ++j) { const int p = tid + 512 * j, c = p & 3, n = p >> 2; const LAS float* s = scr + (16 * c) * WT_S + n;
            int w[4];
#pragma unroll
            for (int e = 0; e < 4; ++e) { w[e] = __builtin_amdgcn_cvt_pk_fp8_f32(s[(4 * e) * WT_S], s[(4 * e + 1) * WT_S], 0, false); w[e] = __builtin_amdgcn_cvt_pk_fp8_f32(s[(4 * e + 2) * WT_S], s[(4 * e + 3) * WT_S], w[e], true); }
            v4u o; o.x = (unsigned)w[0]; o.y = (unsigned)w[1]; o.z = (unsigned)w[2]; o.w = (unsigned)w[3];
            const int jn = t.n0 + n, row = t.gu ? ((jn >> 7) * 256 + (jn & 127) + (t.gu == 2 ? 128 : 0)) : jn;
            *(GAS v4u*)((unsigned char*)t.WT + (size_t)row * t.K + t.k0 + 16 * c) = o; }
    }
    LDS_WAIT(); __syncthreads();
}
template <int NR> __device__ __forceinline__ void rows_to_bf16_rstd(int lane, const float* xrow, size_t rstride, bf16* orow, float* rstd) {
    f32x4 v[NR][4];
#pragma unroll
    for (int r = 0; r < NR; ++r)
#pragma unroll
        for (int j = 0; j < 4; ++j) v[r][j] = ((const GAS f32x4*)(xrow + r * rstride) + lane)[64 * j];
#pragma unroll
    for (int r = 0; r < NR; ++r) { float s = 0.f;
#pragma unroll
        for (int j = 0; j < 4; ++j) s += (v[r][j].x * v[r][j].x + v[r][j].y * v[r][j].y) + (v[r][j].z * v[r][j].z + v[r][j].w * v[r][j].w);
        const float rs = 1.f / sqrtf(wave_sum(s) * (1.f / DM) + EPS); if (lane == 0) rstd[r] = rs;
        GAS unsigned long long* o8 = (GAS unsigned long long*)(orow + r * rstride) + lane;
#pragma unroll
        for (int j = 0; j < 4; ++j) o8[64 * j] = (unsigned long long)pk2(v[r][j].x, v[r][j].y) | ((unsigned long long)pk2(v[r][j].z, v[r][j].w) << 32); }
}
struct P0Args { const float *x, *norm1_g, *w_in, *sgu_w, *w_out, *norm2_g, *w_gate, *w_up, *w_down; bf16 *WinT, *WoT; unsigned char *WguQ, *WdQ; bf16 *SW, *XN; float* rstd1; };
constexpr int WT_IN = (DM / 64) * (INW / 256), WT_O = (DM / 64) * (DM / 256), WT_G = (DM / 64) * (DFF / 256), WT_D = (DFF / 64) * (DM / 256);
__device__ __forceinline__ int wset_count(int set) { return set == 0 ? WT_IN : set == 1 ? WT_O + 2 * WT_G : WT_D; }
__device__ __forceinline__ WTile wset_tile(const P0Args& a, int set, int r) {
    if (set == 0) { const int nb = INW / 256; return WTile{a.w_in, a.norm1_g, a.WinT, DM, INW, 64 * (r / nb), 256 * (r % nb), 1.0f, 0, 0}; }
    if (set == 2) { const int nb = DM / 256; return WTile{a.w_down, nullptr, a.WdQ, DFF, DM, 64 * (r / nb), 256 * (r % nb), WD_SCALE, 1, 0}; }
    if (r < WT_O) { const int nb = DM / 256; return WTile{a.w_out, nullptr, a.WoT, DM, DM, 64 * (r / nb), 256 * (r % nb), 1.0f, 0, 0}; } r -= WT_O;
    { const bool up = r >= WT_G; if (up) r -= WT_G; const int nb = DFF / 256; return WTile{up ? a.w_up : a.w_gate, a.norm2_g, a.WguQ, DM, DFF, 64 * (r / nb), 256 * (r % nb), WGU_SCALE, 1, up ? 2 : 1}; }
}
__device__ __forceinline__ void wset_convert(Frame& F, const P0Args& a, int set, int wg, int nwg) {
    LAS float* scr = (LAS float*)(F.lds + RING_OFF);
    const int cnt = wset_count(set); int r = wg; if (r >= cnt) return;
    WTile cur = wset_tile(a, set, r); f32x4 v[8], vn[8]; wtile_load(cur, F.wave, F.lane, v);
    for (;;) {
        const int rn = r + nwg; const bool more = rn < cnt; WTile nxt = cur;
        if (more) { nxt = wset_tile(a, set, rn); wtile_load(nxt, F.wave, F.lane, vn); }
        wtile_store(cur, F.tid, F.wave, F.lane, v, scr);
        if (!more) break;
#pragma unroll
        for (int i = 0; i < 8; ++i) v[i] = vn[i];
        cur = nxt; r = rn;
    }
}
__device__ __forceinline__ void p0_prologue(Frame& F, const P0Args& a) {
    const int gw = F.vcu * NWAVES + F.wave, NGW = F.G * NWAVES;
    wset_convert(F, a, 0, F.vcu, F.G);
    for (int m = 4 * gw; m < M; m += 4 * NGW) rows_to_bf16_rstd<4>(F.lane, a.x + (size_t)m * DM, DM, a.XN + (size_t)m * DM, a.rstd1 + m);
    for (int i = (F.vcu * NWAVES * 64 + F.tid); i < NH * CHUNK * CHUNK; i += F.G * NWAVES * 64) { const int t = (i / CHUNK) % CHUNK, s = i % CHUNK; a.SW[i] = (bf16)f2bf(s <= t ? a.sgu_w[i] : 0.0f); }
}

constexpr int SGU_V_BYTES = 16384, SGU_U_PITCH = 144, SGU_U_BYTES = 128 * SGU_U_PITCH, SGU_UOFF = 2 * SGU_V_BYTES;
struct SguArgs { const bf16* P; const bf16* SW; const float* sgu_b; const float* ona_g; bf16* Y; };
typedef float f32x16 __attribute__((ext_vector_type(16)));
typedef short s16x4 __attribute__((ext_vector_type(4)));
typedef unsigned u32x2 __attribute__((ext_vector_type(2)));
__device__ __forceinline__ int crow16(int r, int hi) { return (r & 3) + 8 * (r >> 2) + 4 * hi; }
struct SguStage { v4u vv[4], uu[4]; };
__device__ __forceinline__ void sgu_load(const SguArgs& a, int unit, int tid, SguStage& s) {
    const int b = unit >> 6, c = (unit >> 2) & 15, hp = unit & 3; const size_t row0 = (size_t)b * SEQ + c * CHUNK;
#pragma unroll
    for (int k = 0; k < 4; ++k) { const int i = tid + 512 * k, hl = i >> 10, row = (i >> 3) & 127, ch = i & 7;
        const bf16* src = a.P + (row0 + row) * INW + (2 * hp + hl) * 64 + ch * 8;
        s.vv[k] = *(const GAS v4u*)(src + COL_VA); s.uu[k] = *(const GAS v4u*)(src + COL_U); }
}
__device__ __forceinline__ void sgu_unit(Frame& F, const SguArgs& a, int unit, SguStage& st, int next_unit) {
    const int b = unit >> 6, c = (unit >> 2) & 15, hp = unit & 3;
    int tid_ = threadIdx.x; asm volatile("" : "+v"(tid_)); const int tid = tid_, lane = tid & 63, wid = F.wave, r32 = lane & 31, hi = lane >> 5;
    const size_t row0 = (size_t)b * SEQ + c * CHUNK;
    const int hl = wid >> 2, h = 2 * hp + hl, t0 = 32 * (wid & 3);
    const bf16* wrow = a.SW + ((size_t)h * CHUNK + t0 + r32) * CHUNK + 8 * hi;
    bf16x8 wf[8];
#pragma unroll
    for (int q = 0; q < 8; ++q) if (16 * q < t0 + 32) wf[q] = *(const GAS bf16x8*)(wrow + 16 * q);
#pragma unroll
    for (int k = 0; k < 4; ++k) { const int i = tid + 512 * k, hl2 = i >> 10, row = (i >> 3) & 127, ch = i & 7;
        *(LAS v4u*)(F.lds + RING_OFF + hl2 * SGU_V_BYTES + (ch >> 2) * 8192 + row * 64 + (ch & 3) * 16) = st.vv[k];
        *(LAS v4u*)(F.lds + RING_OFF + SGU_UOFF + hl2 * SGU_U_BYTES + row * SGU_U_PITCH + ch * 16) = st.uu[k]; }
    LDS_WAIT(); __syncthreads();
    if (next_unit >= 0) sgu_load(a, next_unit, tid, st);
    f32x16 acc[2]; acc[0] = f32x16{}; acc[1] = f32x16{};
    const LAS unsigned char* vbase = F.lds + RING_OFF + hl * SGU_V_BYTES + (8 * hi + ((lane & 15) >> 2)) * 64 + 32 * ((lane >> 4) & 1) + 8 * (lane & 3);
#pragma unroll
    for (int q = 0; q < 8; ++q) if (16 * q < t0 + 32) {
#pragma unroll
        for (int d0 = 0; d0 < 2; ++d0) {
            const s16x4 lo = __builtin_bit_cast(s16x4, __builtin_amdgcn_ds_read_tr16_b64_v4i16((LAS s16x4*)(vbase + d0 * 8192 + q * 1024)));
            const s16x4 hh = __builtin_bit_cast(s16x4, __builtin_amdgcn_ds_read_tr16_b64_v4i16((LAS s16x4*)(vbase + d0 * 8192 + q * 1024 + 256)));
            const bf16x8 vf = (bf16x8){lo[0], lo[1], lo[2], lo[3], hh[0], hh[1], hh[2], hh[3]};
            acc[d0] = __builtin_amdgcn_mfma_f32_32x32x16_bf16(vf, wf[q], acc[d0], 0, 0, 0);
        }
    }
    const float bias = a.sgu_b[h * CHUNK + t0 + r32];
    LAS unsigned char* urow = F.lds + RING_OFF + SGU_UOFF + hl * SGU_U_BYTES + (t0 + r32) * SGU_U_PITCH;
    float y[2][16]; float ss = 0.f;
#pragma unroll
    for (int d0 = 0; d0 < 2; ++d0)
#pragma unroll
        for (int g = 0; g < 4; ++g) { const u32x2 uw = *(const LAS u32x2*)(urow + (32 * d0 + 8 * g + 4 * hi) * 2);
            const float u0 = __builtin_bit_cast(float, uw.x << 16), u1 = __builtin_bit_cast(float, uw.x & 0xffff0000u), u2 = __builtin_bit_cast(float, uw.y << 16), u3 = __builtin_bit_cast(float, uw.y & 0xffff0000u);
            y[d0][4 * g + 0] = u0 * (acc[d0][4 * g + 0] + bias); y[d0][4 * g + 1] = u1 * (acc[d0][4 * g + 1] + bias); y[d0][4 * g + 2] = u2 * (acc[d0][4 * g + 2] + bias); y[d0][4 * g + 3] = u3 * (acc[d0][4 * g + 3] + bias);
            ss += (y[d0][4 * g] * y[d0][4 * g] + y[d0][4 * g + 1] * y[d0][4 * g + 1]) + (y[d0][4 * g + 2] * y[d0][4 * g + 2] + y[d0][4 * g + 3] * y[d0][4 * g + 3]); }
    ss += __shfl_xor(ss, 32);
    const float rs = __builtin_amdgcn_rsqf(ss * (1.0f / 64.0f) + EPS);
#pragma unroll
    for (int d0 = 0; d0 < 2; ++d0)
#pragma unroll
        for (int g = 0; g < 4; ++g) { const f32x4 gg = *(const GAS f32x4*)(a.ona_g + h * 64 + 32 * d0 + 8 * g + 4 * hi);
            u32x2 w; w.x = pk2(y[d0][4 * g] * rs * gg.x, y[d0][4 * g + 1] * rs * gg.y); w.y = pk2(y[d0][4 * g + 2] * rs * gg.z, y[d0][4 * g + 3] * rs * gg.w);
            *(LAS u32x2*)(urow + (32 * d0 + 8 * g + 4 * hi) * 2) = w; }
    LDS_WAIT(); asm volatile("" ::: "memory");
#pragma unroll
    for (int i = 0; i < 4; ++i) { const int row = t0 + i * 8 + (lane >> 3), ch = lane & 7;
        const v4u vv = *(const LAS v4u*)(F.lds + RING_OFF + SGU_UOFF + hl * SGU_U_BYTES + row * SGU_U_PITCH + ch * 16);
        *(GAS v4u*)(a.Y + (row0 + row) * DM + h * 64 + ch * 8) = vv; }
    LDS_WAIT(); __syncthreads();
}
struct Args { const float* in[16]; float* out; unsigned char* ws; };
__global__ void __launch_bounds__(NWAVES * 64, 2) mega_fwd(Args args) {
    extern __shared__ __attribute__((aligned(16))) unsigned char lds[];
    Frame F;
    F.lds = (LAS unsigned char*)lds;
    F.MISC = (volatile LAS unsigned*)(F.lds + MISC_OFF);
    F.tid = threadIdx.x; F.lane = F.tid & 63; F.wave = __builtin_amdgcn_readfirstlane(F.tid >> 6);
    F.G = gridDim.x; { const int bx = blockIdx.x; F.vcu = (F.G % 8 == 0) ? (bx % 8) * (F.G / 8) + bx / 8 : bx; }
    unsigned char* ws = args.ws;
    F.ctl = (gu32*)(ws + WS_CTL);
    const float* x = args.in[0]; const float* norm1_g = args.in[1]; const float* w_in = args.in[2]; const float* ln_g = args.in[3]; const float* ln_b = args.in[4];
    const float* sgu_w = args.in[5]; const float* sgu_b = args.in[6]; const float* q_g = args.in[7]; const float* k_g = args.in[8]; const float* ona_g = args.in[9]; const float* onb_g = args.in[10];
    const float* w_out = args.in[11]; const float* norm2_g = args.in[12]; const float* w_gate = args.in[13]; const float* w_up = args.in[14]; const float* w_down = args.in[15];
    float* out = args.out;
    bf16* WinT = (bf16*)(ws + WS_WIN); bf16* WoT = (bf16*)(ws + WS_WO); unsigned char* WguQ = ws + WS_WGU; unsigned char* WdQ = ws + WS_WD; unsigned char* X1Q = ws + WS_X1Q; bf16* SW = (bf16*)(ws + WS_SW);
    float* ksum = (float*)(ws + WS_KSUM); float* rowss = (float*)(ws + WS_ROWSS);
    bf16* XB = (bf16*)(ws + WS_XN); bf16* X1B = (bf16*)(ws + WS_X1B); float* rstd1 = (float*)(ws + WS_RSTD1); bf16* Yb = (bf16*)(ws + WS_Y); bf16* PROJ = (bf16*)(ws + WS_PROJ); unsigned char* HIDQ = ws + WS_PROJ;
    for (int u = F.tid; u < (PAR_OFF - LDSCTL_OFF) / 4; u += NWAVES * 64) ((LAS unsigned*)(F.lds + LDSCTL_OFF))[u] = 0u;
    { LAS float* par = (LAS float*)(F.lds + PAR_OFF);
      for (int i = F.tid; i < 1152; i += NWAVES * 64) par[i] = (i < 512) ? ln_g[i] : (i < 1024) ? ln_b[i - 512] : (i < 1088) ? q_g[i - 1024] * C2 : k_g[i - 1088]; }
    __syncthreads();
    { gu32* start = F.ctl + CW_START; constexpr unsigned MAGIC = 0x600DF1A6u;
      if (blockIdx.x == 0) {
          for (int i = F.tid; i < XCD_BAR_WORDS; i += NWAVES * 64) F.ctl[CW_BAR + i] = 0u;
          if (F.tid < 64) F.ctl[F.tid] = 0u;
          asm volatile("s_waitcnt vmcnt(0)" ::: "memory"); __syncthreads();
          if (F.tid == 0) { __builtin_amdgcn_fence(__ATOMIC_RELEASE, "agent"); asm volatile("s_waitcnt vmcnt(0)" ::: "memory"); __hip_atomic_store(start, MAGIC, RLX_AGENT); }
      } else {
          if (F.tid == 0) { unsigned sp = 0; while (__hip_atomic_load(start, RLX_AGENT) != MAGIC) { __builtin_amdgcn_s_sleep(2); if (++sp > (1u << 22)) break; }
              __builtin_amdgcn_fence(__ATOMIC_ACQUIRE, "agent"); asm volatile("s_waitcnt vmcnt(0)" ::: "memory"); }
          __syncthreads();
      } }
    const XcdBarrier bar = xcd_barrier_post((unsigned*)(F.ctl + CW_BAR), F.MISC + 8);
    const P0Args p0a{x, norm1_g, w_in, sgu_w, w_out, norm2_g, w_gate, w_up, w_down, WinT, WoT, WguQ, WdQ, SW, XB, rstd1};
    const bool late = (F.G == 256);

    p0_prologue(F, p0a); if (!late) { wset_convert(F, p0a, 1, F.vcu, F.G); wset_convert(F, p0a, 2, F.vcu, F.G); }
    xcd_barrier(bar);

    {
        pg8::Gemm g{XB, WinT, M, INW, DM}; pg8::P1Unit U; U.init(M, INW, F.G, (int)blockIdx.x);
        U.P = PROJ; U.par = (const LAS float*)(F.lds + PAR_OFF); U.ksum = ksum; U.rp.src = rstd1; U.rp.slots = (LAS float*)(F.lds + RSL_OFF); U.rp.mul = 1.0f;
        pg8::gemm_phase<pg8::P1Unit, pg8::P1Unit, PG8_ALIGN, PG8_SP2>(F.lds + RING_OFF, g, U, U);
        if (late && blockIdx.x >= 128) wset_convert(F, p0a, 1, (int)blockIdx.x - 128, 128);
        xcd_barrier(bar);
    }

    {
        const SguArgs sa{PROJ, SW, sgu_b, ona_g, Yb};
        { SguStage sst; int u = F.vcu; if (u < BATCH * 16 * 4) sgu_load(sa, u, F.tid, sst);
          for (; u < BATCH * 16 * 4; u += F.G) { const int un = u + F.G; sgu_unit(F, sa, u, sst, un < BATCH * 16 * 4 ? un : -1); } }
        static_assert(attn_body::ATTN_LDS_BYTES <= RING_BYTES && attn_body::ATTN_PITCH == INW, "attention body geometry vs frame");
        const attn_body::AttnTensors AT{(const attn_body::bf16*)(PROJ + COL_Q), (const attn_body::bf16*)(PROJ + COL_K), (const attn_body::bf16*)(PROJ + COL_V), (attn_body::bf16*)(Yb + WA), ksum, onb_g};
        const attn_body::StaticOrder S((int)F.G, (int)blockIdx.x);
        attn_body::attn_phase<attn_body::StaticOrder>((char*)lds + RING_OFF, AT, S);
        xcd_barrier(bar);
    }

    {
        pg8::Gemm g{Yb, WoT, M, DM, DM}; pg8::StaticOrder S; S.init(M, DM, F.G, (int)blockIdx.x);
        pg8::EpiOutProj E{XB, X1B, X1Q, rowss};
        if (F.G == 256) pg8::gemm_phase<pg8::EpiOutProj, pg8::StaticOrder, false, PG8_SP2>(F.lds + RING_OFF, g, S, E);
        xcd_barrier(bar);
    }

    {
        pg8::Gemm g{(const bf16*)X1Q, (const bf16*)WguQ, M, NGU, DM / 2}; pg8::P4Unit U; U.init(M, NGU, F.G, (int)blockIdx.x);
        U.H = HIDQ; U.rp.src = rowss; U.rp.slots = (LAS float*)(F.lds + RSL_OFF); U.rp.mul = 1.0f / WGU_SCALE;
        pg8::gemm_phase<pg8::P4Unit, pg8::P4Unit, PG8_ALIGN, PG8_SP2, true>(F.lds + RING_OFF, g, U, U);
        if (late && blockIdx.x >= 128) wset_convert(F, p0a, 2, (int)blockIdx.x - 128, 128);
        xcd_barrier(bar);
    }

    {
        pg8::Gemm g{(const bf16*)HIDQ, (const bf16*)WdQ, M, DM, DFF / 2}; pg8::StaticOrder S; S.init(M, DM, F.G, (int)blockIdx.x);
        pg8::EpiDown E{X1B, out};
        pg8::gemm_phase<pg8::EpiDown, pg8::StaticOrder, PG8_ALIGN, PG8_SP2, true>(F.lds + RING_OFF, g, S, E);
    }
    asm volatile("s_waitcnt vmcnt(0)" ::: "memory"); __syncthreads();
    if (F.tid == 0) { const unsigned old = __hip_atomic_fetch_add(F.ctl + CW_EXIT, 1u, RLX_AGENT); if (old == (unsigned)F.G - 1u) __hip_atomic_store(F.ctl + CW_START, 0u, RLX_AGENT); }
}

extern "C" void kernel_launch(void* const* d_in, const int* in_sizes, int n_in, void* d_out, int out_size, void* d_ws, size_t ws_size, hipStream_t stream) {
    static int grid = 0;
    if (grid == 0) {
        if (n_in != 16 || in_sizes[0] != M * DM || out_size != M * DM || ws_size < WS_END) { fprintf(stderr, "kernel_launch: built for 16 inputs, x and out of %d floats, >= %zu bytes of workspace; got n_in %d, in0 %d, out %d, ws %zu; nothing launched\n", M * DM, (size_t)WS_END, n_in, n_in > 0 ? in_sizes[0] : -1, out_size, ws_size); grid = -1; return; }
        int dev = 0, cus = 0, per_cu = 0;
        if (hipGetDevice(&dev) != hipSuccess || hipDeviceGetAttribute(&cus, hipDeviceAttributeMultiprocessorCount, dev) != hipSuccess) { fprintf(stderr, "kernel_launch: hipGetDevice / hipDeviceGetAttribute failed; nothing launched\n"); grid = -1; return; }
        if (hipFuncSetAttribute((const void*)mega_fwd, hipFuncAttributeMaxDynamicSharedMemorySize, LDS_BYTES) != hipSuccess) { fprintf(stderr, "kernel_launch: hipFuncSetAttribute failed\n"); grid = -1; return; }
        if (hipOccupancyMaxActiveBlocksPerMultiprocessor(&per_cu, (const void*)mega_fwd, NWAVES * 64, LDS_BYTES) != hipSuccess || per_cu < 1) { fprintf(stderr, "kernel_launch: occupancy query reports %d workgroups per CU; nothing launched\n", per_cu); (void)hipGetLastError(); grid = -1; return; }
        grid = cus;
        if (grid != 256) fprintf(stderr, "kernel_launch: %d CUs; the out-proj phase needs exactly 256 workgroups\n", grid);
    }
    if (grid < 0) return;
    Args a{};
    for (int i = 0; i < 16; ++i) a.in[i] = (const float*)d_in[i];
    a.out = (float*)d_out; a.ws = (unsigned char*)d_ws;
    hipLaunchKernelGGL(mega_fwd, dim3(grid), dim3(NWAVES * 64), LDS_BYTES, stream, a);
    const hipError_t le = hipPeekAtLastError();
    if (le != hipSuccess) fprintf(stderr, "kernel_launch: launch failed: %s (grid %d x %d threads, %d B LDS)\n", hipGetErrorName(le), grid, NWAVES * 64, LDS_BYTES);
}
```

```cpp
#include <hip/hip_runtime.h>
#include <hip/hip_bf16.h>
#include <cstdio>
#include <cstdint>
#include <cmath>

constexpr int BATCH = 8, SEQ = 2048, DM = 1024, M = BATCH * SEQ;
constexpr int NH = 8, HD = 64, WA = 512, INW = 2560, CHUNK = 128, MBLK = 256, NBLK = SEQ / MBLK, DFF = 2816, NGU = 2 * DFF;
constexpr float EPS = 1e-6f;
constexpr float WGU_SCALE = 32.0f, WD_SCALE = 64.0f;
constexpr float C2 = 0.125f * 1.4426950408889634f;
constexpr int COL_U = 0, COL_VA = 512, COL_Q = 1024, COL_K = 1536, COL_V = 2048;

constexpr size_t MiB = 1u << 20;
constexpr size_t WS_CTL = 0;
constexpr size_t WS_KSUM = 512 * 1024;
constexpr size_t WS_WIN = 1 * MiB;
constexpr size_t WS_WO = 6 * MiB;
constexpr size_t WS_WGU = 8 * MiB;
constexpr size_t WS_WD = 19 * MiB;
constexpr size_t WS_SW = 25 * MiB;
constexpr size_t WS_ROWSS = 26 * MiB;
constexpr size_t WS_RSTD1 = 27 * MiB;
constexpr size_t WS_XN = 32 * MiB;
constexpr size_t WS_X1B = 200 * MiB;
constexpr size_t WS_Y = 64 * MiB;
constexpr size_t WS_PROJ = 96 * MiB;
constexpr size_t WS_X1Q = 184 * MiB;
constexpr size_t WS_END = 232 * MiB;

namespace pg8 {
#define PG8_LAS __attribute__((address_space(3)))
typedef unsigned short bf16_t;
typedef short bf16x8 __attribute__((ext_vector_type(8)));
typedef float f32x4 __attribute__((ext_vector_type(4)));
typedef unsigned u32x4 __attribute__((ext_vector_type(4)));
typedef int v4i_t __attribute__((ext_vector_type(4)));
typedef unsigned u32x2 __attribute__((ext_vector_type(2)));
constexpr int BM = 256, BK = 64, HALF = 128, HTB = HALF * BK * 2  , STAGE_BYTES = 8 * HTB, NXCD = 8, WGM = 8;

__host__ __device__ __forceinline__ int lds_byte(int r, int c) { const int st = (r >> 4) * 2 + (c >> 5), rr = r & 15, cc = c & 31, ob = rr * 64 + cc * 2; return st * 1024 + (ob ^ (((ob >> 9) & 1) << 5)); }
__host__ __device__ __forceinline__ void stage_rc(int b, int& R, int& C) { const int st = b / 1024, sb = b % 1024, swz = sb ^ (((sb >> 9) & 1) << 5); R = (st >> 1) * 16 + swz / 64; C = (st & 1) * 32 + (swz % 64) / 2; }
__host__ __device__ __forceinline__ int perm32(int rho) { const int n = rho >> 4, i = rho & 15; return 8 * (i >> 2) + 4 * n + (i & 3); }

struct Unit { int pm, pn; };
struct Gemm { const bf16_t* A; const bf16_t* Bt; int M, N, K; };

struct StaticOrder {
    int nM, nN, nwg, G, c;
    __host__ __device__ void init(int M, int N, int G_, int c_) { nM = M / BM; nN = N / BM; nwg = nM * nN; G = G_; c = c_; }
    __host__ __device__ bool next(int i, Unit& u) const {
        const long L = (long)i * G + c; if (L >= nwg) return false;
        int wgid = (int)L; { const int q = nwg / NXCD, r = nwg % NXCD, xcd = wgid % NXCD, off = wgid / NXCD; wgid = (xcd < r ? xcd * (q + 1) : r * (q + 1) + (xcd - r) * q) + off; }
        const int nig = WGM * nN, gid = wgid / nig, fm = gid * WGM, gsz = (nM - fm) < WGM ? (nM - fm) : WGM;
        u.pm = fm + ((wgid % nig) % gsz); u.pn = (wgid % nig) / gsz; return true;
    }
    __device__ __forceinline__ void a_ready(const Unit&) const {}
    __device__ __forceinline__ void done(const Unit&) const {}
};

struct RowScalePrefetch {
    const float* src; PG8_LAS float* slots; float mul; mutable float pend = 0.f; mutable int nready = 0, ndone = 0, have = 0;
    template <int MODE> __device__ __forceinline__ void fetch(const Unit& u) const {
        int t = threadIdx.x; asm volatile("" : "+v"(t));
        if (t < 256) { const int row = u.pm * BM + t;
            if (MODE == 0) pend = src[row]; else { const f32x4 r4 = *(const f32x4*)(src + (size_t)row * 4); pend = __builtin_amdgcn_rsqf(((r4[0] + r4[1]) + (r4[2] + r4[3])) * (1.0f / 1024.0f) + 1e-6f) * mul; }
            if (nready == 0) slots[t] = pend; }
        have = (nready != 0); ++nready;
    }
    __device__ __forceinline__ void flush() const {
        if (have) { int t = threadIdx.x; asm volatile("" : "+v"(t)); if (t < 256) slots[((ndone + 1) & 1) * 256 + t] = pend; have = 0; }
    }
    __device__ __forceinline__ const PG8_LAS float* cur() const { return slots + (ndone & 1) * 256; }
};
__device__ __forceinline__ unsigned cvt_pk_bf16(float lo, float hi) { unsigned r; asm volatile("v_cvt_pk_bf16_f32 %0, %1, %2" : "=v"(r) : "v"(lo), "v"(hi)); return r; }
__device__ __forceinline__ float gelu_tanh_f(float x) {
    const float t = x * (-2.3022082f + -0.10294324f * (x * x));
    return x * __builtin_amdgcn_rcpf(1.0f + __builtin_amdgcn_exp2f(t));
}
__device__ __forceinline__ float silu_f(float x) { return x * __builtin_amdgcn_rcpf(1.0f + __builtin_amdgcn_exp2f(-1.4426950408889634f * x)); }
__device__ __forceinline__ float hsum4(const f32x4 v) { return (v[0] + v[1]) + (v[2] + v[3]); }
__device__ __forceinline__ float hsq4(const f32x4 v) { return (v[0] * v[0] + v[1] * v[1]) + (v[2] * v[2] + v[3] * v[3]); }
__device__ __forceinline__ float quad_sum(float s) {
    auto a = __builtin_amdgcn_permlane16_swap(__float_as_uint(s), __float_as_uint(s), false, false); s = __uint_as_float(a[0]) + __uint_as_float(a[1]);
    auto b = __builtin_amdgcn_permlane32_swap(__float_as_uint(s), __float_as_uint(s), false, false); return __uint_as_float(b[0]) + __uint_as_float(b[1]); }
__device__ __forceinline__ u32x2 pack8_f8(const f32x4 a, const f32x4 b) {
    int lo = __builtin_amdgcn_cvt_pk_fp8_f32(a[0], a[1], 0, false); lo = __builtin_amdgcn_cvt_pk_fp8_f32(a[2], a[3], lo, true);
    int hi = __builtin_amdgcn_cvt_pk_fp8_f32(b[0], b[1], 0, false); hi = __builtin_amdgcn_cvt_pk_fp8_f32(b[2], b[3], hi, true);
    u32x2 w; w.x = (unsigned)lo; w.y = (unsigned)hi; return w; }
__device__ __forceinline__ u32x4 pack8(const f32x4 a, const f32x4 b) { u32x4 w; w.x = cvt_pk_bf16(a[0], a[1]); w.y = cvt_pk_bf16(a[2], a[3]); w.z = cvt_pk_bf16(b[0], b[1]); w.w = cvt_pk_bf16(b[2], b[3]); return w; }

struct EpiInProj {
    static constexpr bool PERM = true, AFTER_DRAIN = false; static constexpr int BMAP = 1;
    bf16_t* P; const PG8_LAS float* par; float* ksum; RowScalePrefetch rp;
    __device__ __forceinline__ void operator()(const f32x4 (&acc)[2][2][4][2], const Unit& u, int wr, int wc, int fr, int fq) const {
        asm volatile("" : "+v"(fr), "+v"(fq));
        const int seg = u.pn >> 1, h = (u.pn & 1) * 4 + wc, dl = 8 * fq;
        bf16_t* base = P + (size_t)(u.pm * BM + wr * 64 + fr) * INW + u.pn * BM + wc * 64 + dl;
        float rs1[2][4];
#pragma unroll
        for (int ai = 0; ai < 2; ++ai)
#pragma unroll
            for (int m = 0; m < 4; ++m) rs1[ai][m] = rp.cur()[wr * 64 + fr + ai * HALF + m * 16];
        rp.flush(); ++rp.ndone;
        if (seg == 0) {
#pragma unroll
            for (int ai = 0; ai < 2; ++ai)
#pragma unroll
                for (int m = 0; m < 4; ++m)
#pragma unroll
                    for (int bj = 0; bj < 2; ++bj) { f32x4 a = acc[ai][bj][m][0] * rs1[ai][m], b = acc[ai][bj][m][1] * rs1[ai][m];
#pragma unroll
                        for (int e = 0; e < 4; ++e) { a[e] = gelu_tanh_f(a[e]); b[e] = gelu_tanh_f(b[e]); }
                        *(u32x4*)(base + (size_t)(ai * HALF + m * 16) * INW + 32 * bj) = pack8(a, b); }
        } else if (seg == 1) {
            const PG8_LAS float* lg = par + h * 64 + dl; const PG8_LAS float* lb = par + 512 + h * 64 + dl;
#pragma unroll
            for (int ai = 0; ai < 2; ++ai)
#pragma unroll
                for (int m = 0; m < 4; ++m) { f32x4 g[2][2]; float s = 0.f;
#pragma unroll
                    for (int bj = 0; bj < 2; ++bj)
#pragma unroll
                        for (int n = 0; n < 2; ++n) { const f32x4 a = acc[ai][bj][m][n] * rs1[ai][m];
#pragma unroll
                            for (int e = 0; e < 4; ++e) g[bj][n][e] = gelu_tanh_f(a[e]);
                            s += hsum4(g[bj][n]); }
                    const float mean = quad_sum(s) * (1.0f / 64.0f); float q = 0.f;
#pragma unroll
                    for (int bj = 0; bj < 2; ++bj)
#pragma unroll
                        for (int n = 0; n < 2; ++n) { g[bj][n] = g[bj][n] - mean; q += hsq4(g[bj][n]); }
                    const float rstd = __builtin_amdgcn_rsqf(quad_sum(q) * (1.0f / 64.0f) + EPS);
#pragma unroll
                    for (int bj = 0; bj < 2; ++bj) { const f32x4 G0 = *(const PG8_LAS f32x4*)(lg + 32 * bj), G1 = *(const PG8_LAS f32x4*)(lg + 32 * bj + 4), B0 = *(const PG8_LAS f32x4*)(lb + 32 * bj), B1 = *(const PG8_LAS f32x4*)(lb + 32 * bj + 4);
                        *(u32x4*)(base + (size_t)(ai * HALF + m * 16) * INW + 32 * bj) = pack8(g[bj][0] * rstd * G0 + B0, g[bj][1] * rstd * G1 + B1); }
                    asm volatile("" ::: "memory"); __builtin_amdgcn_sched_barrier(0); }
        } else if (seg == 2 || seg == 3) {
            const PG8_LAS float* gp = par + ((seg == 2) ? 1024 : 1088) + dl;
            f32x4 cs[2][2];
#pragma unroll
            for (int bj = 0; bj < 2; ++bj)
#pragma unroll
                for (int n = 0; n < 2; ++n) cs[bj][n] = (f32x4){0.f, 0.f, 0.f, 0.f};
#pragma unroll
            for (int ai = 0; ai < 2; ++ai)
#pragma unroll
                for (int m = 0; m < 4; ++m) { float q = 0.f;
#pragma unroll
                    for (int bj = 0; bj < 2; ++bj)
#pragma unroll
                        for (int n = 0; n < 2; ++n) q += hsq4(acc[ai][bj][m][n]);
                    const float rstd = rs1[ai][m] * __builtin_amdgcn_rsqf(quad_sum(q) * (1.0f / 64.0f) * (rs1[ai][m] * rs1[ai][m]) + EPS);
#pragma unroll
                    for (int bj = 0; bj < 2; ++bj) { const f32x4 o0 = acc[ai][bj][m][0] * rstd * *(const PG8_LAS f32x4*)(gp + 32 * bj), o1 = acc[ai][bj][m][1] * rstd * *(const PG8_LAS f32x4*)(gp + 32 * bj + 4);
                        cs[bj][0] += o0; cs[bj][1] += o1;
                        *(u32x4*)(base + (size_t)(ai * HALF + m * 16) * INW + 32 * bj) = pack8(o0, o1); }
                    asm volatile("" : "+v"(cs[0][0]), "+v"(cs[0][1]), "+v"(cs[1][0]), "+v"(cs[1][1]));
                    asm volatile("" ::: "memory"); __builtin_amdgcn_sched_barrier(0); }
            if (seg == 3) {
#pragma unroll
                for (int bj = 0; bj < 2; ++bj)
#pragma unroll
                    for (int n = 0; n < 2; ++n) { f32x4 v = cs[bj][n];
#pragma unroll
                        for (int e = 0; e < 4; ++e) { float t = v[e]; t += __shfl_xor(t, 1); t += __shfl_xor(t, 2); t += __shfl_xor(t, 4); t += __shfl_xor(t, 8); v[e] = t; }
                        if (fr == 0) *(f32x4*)(ksum + (((size_t)u.pm * 2 + wr) * NH + h) * 64 + 32 * bj + dl + 4 * n) = v; }
            }
        } else {
#pragma unroll
            for (int ai = 0; ai < 2; ++ai)
#pragma unroll
                for (int m = 0; m < 4; ++m)
#pragma unroll
                    for (int bj = 0; bj < 2; ++bj) *(u32x4*)(base + (size_t)(ai * HALF + m * 16) * INW + 32 * bj) = pack8(acc[ai][bj][m][0] * rs1[ai][m], acc[ai][bj][m][1] * rs1[ai][m]);
        }
    }
};

struct EpiOutProj {
    static constexpr bool PERM = true, AFTER_DRAIN = true; static constexpr int BMAP = 0;
    const bf16_t* xb; bf16_t* x1b; unsigned char* x1q; float* rowss;
    __device__ __forceinline__ void operator()(const f32x4 (&)[2][2][4][2], const Unit&, int, int, int, int) const {}
    __device__ __forceinline__ void fused(f32x4 (&acc)[2][2][4][2], const Unit& u, int wr, int wc, int fr, int fq, PG8_LAS unsigned char* lds, int wid, int lane) const {
        PG8_LAS float* Pl = (PG8_LAS float*)lds;
        const int col0 = u.pn * BM + wc * 32 + 8 * fq;
#pragma unroll
        for (int ai = 0; ai < 2; ++ai)
#pragma unroll
            for (int m = 0; m < 4; ++m) { const int rt = ai * HALF + wr * 64 + m * 16 + fr; const size_t off = (size_t)(u.pm * BM + rt) * DM + col0; float s = 0.f;
#pragma unroll
                for (int bj = 0; bj < 2; ++bj) { const u32x4 w = *(const u32x4*)(xb + off + bj * HALF);
                    const f32x4 v0 = acc[ai][bj][m][0] + (f32x4){__builtin_bit_cast(float, w.x << 16), __builtin_bit_cast(float, w.x & 0xffff0000u), __builtin_bit_cast(float, w.y << 16), __builtin_bit_cast(float, w.y & 0xffff0000u)};
                    const f32x4 v1 = acc[ai][bj][m][1] + (f32x4){__builtin_bit_cast(float, w.z << 16), __builtin_bit_cast(float, w.z & 0xffff0000u), __builtin_bit_cast(float, w.w << 16), __builtin_bit_cast(float, w.w & 0xffff0000u)};
                    *(u32x4*)(x1b + off + bj * HALF) = pack8(v0, v1); *(u32x2*)(x1q + off + bj * HALF) = pack8_f8(v0, v1); s += hsq4(v0) + hsq4(v1); }
                s = quad_sum(s); if (fq == 0) Pl[rt * 4 + wc] = s;
                if (m & 1) asm volatile("" ::: "memory"); }
        asm volatile("s_waitcnt lgkmcnt(0)" ::: "memory"); __builtin_amdgcn_s_barrier(); asm volatile("" ::: "memory");
        const int t = wid * 64 + lane;
        if (t < 256) rowss[(size_t)(u.pm * BM + t) * 4 + u.pn] = (Pl[t * 4 + 0] + Pl[t * 4 + 1]) + (Pl[t * 4 + 2] + Pl[t * 4 + 3]);
    }
};

struct EpiGateUp {
    static constexpr bool PERM = true, AFTER_DRAIN = false; static constexpr int BMAP = 0;
    unsigned char* H; RowScalePrefetch rp;
    __device__ __forceinline__ void operator()(const f32x4 (&acc)[2][2][4][2], const Unit& u, int wr, int wc, int fr, int fq) const {
        const int row0 = u.pm * BM + wr * 64 + fr, col0 = u.pn * HALF + wc * 32 + 8 * fq;
        float rs2[2][4], k1[2][4];
#pragma unroll
        for (int ai = 0; ai < 2; ++ai)
#pragma unroll
            for (int m = 0; m < 4; ++m) { const float rs = rp.cur()[wr * 64 + fr + ai * HALF + m * 16]; rs2[ai][m] = rs * rs; k1[ai][m] = -1.4426950408889634f * rs; }
        rp.flush(); ++rp.ndone;
#pragma unroll
        for (int ai = 0; ai < 2; ++ai)
#pragma unroll
            for (int m = 0; m < 4; ++m) { const int row = row0 + ai * HALF + m * 16;
                f32x4 a = acc[ai][0][m][0], b = acc[ai][0][m][1]; const f32x4 ua = acc[ai][1][m][0], ub = acc[ai][1][m][1];
#pragma unroll
                for (int e = 0; e < 4; ++e) {
                    a[e] = (a[e] * ua[e]) * rs2[ai][m] * __builtin_amdgcn_rcpf(1.0f + __builtin_amdgcn_exp2f(a[e] * k1[ai][m]));
                    b[e] = (b[e] * ub[e]) * rs2[ai][m] * __builtin_amdgcn_rcpf(1.0f + __builtin_amdgcn_exp2f(b[e] * k1[ai][m])); }
                *(u32x2*)(H + (size_t)row * DFF + col0) = pack8_f8(a, b); }
    }
};

struct EpiDown {
    static constexpr bool PERM = true, AFTER_DRAIN = false; static constexpr int BMAP = 0;
    const bf16_t* x1b; float* out;
    __device__ __forceinline__ void operator()(const f32x4 (&acc)[2][2][4][2], const Unit& u, int wr, int wc, int fr, int fq) const {
        const int row0 = u.pm * BM + wr * 64 + fr, col0 = u.pn * BM + wc * 32 + 8 * fq;
#pragma unroll
        for (int ai = 0; ai < 2; ++ai) {
            u32x4 xv[4][2];
#pragma unroll
            for (int m = 0; m < 4; ++m)
#pragma unroll
                for (int bj = 0; bj < 2; ++bj) xv[m][bj] = *(const u32x4*)(x1b + (size_t)(row0 + ai * HALF + m * 16) * DM + col0 + bj * HALF);
#pragma unroll
            for (int m = 0; m < 4; ++m) { float* rowp = out + (size_t)(row0 + ai * HALF + m * 16) * DM + col0;
#pragma unroll
                for (int bj = 0; bj < 2; ++bj) { const u32x4 w = xv[m][bj];
                    const f32x4 x0 = {__builtin_bit_cast(float, w.x << 16), __builtin_bit_cast(float, w.x & 0xffff0000u), __builtin_bit_cast(float, w.y << 16), __builtin_bit_cast(float, w.y & 0xffff0000u)};
                    const f32x4 x1 = {__builtin_bit_cast(float, w.z << 16), __builtin_bit_cast(float, w.z & 0xffff0000u), __builtin_bit_cast(float, w.w << 16), __builtin_bit_cast(float, w.w & 0xffff0000u)};
                    *(f32x4*)(rowp + bj * HALF) = x0 + acc[ai][bj][m][0] * (1.0f / WD_SCALE); *(f32x4*)(rowp + bj * HALF + 4) = x1 + acc[ai][bj][m][1] * (1.0f / WD_SCALE); } }
            asm volatile("" ::: "memory"); }
    }
};

struct P1Unit : StaticOrder, EpiInProj { __device__ __forceinline__ void a_ready(const Unit& u) const { rp.fetch<0>(u); } };
struct P4Unit : StaticOrder, EpiGateUp { __device__ __forceinline__ void a_ready(const Unit& u) const { rp.fetch<1>(u); } };

template <class Epi, class Sched, bool ALIGN_EPI = false, bool SP2 = false, bool F8 = false>
__device__ __forceinline__ void gemm_phase(PG8_LAS unsigned char* lds, const Gemm g, const Sched& S, const Epi& E) {
    int tid_ = threadIdx.x; asm volatile("" : "+v"(tid_));
    const int tid = tid_, wid = __builtin_amdgcn_readfirstlane(tid >> 6), lane = tid & 63, wr = wid >> 2, wc = wid & 3, fr = lane & 15, fq = lane >> 4;
    const int K = g.K, nt = K / BK;
    unsigned voffA[2], voffB[2];
#pragma unroll
    for (int i = 0; i < 2; ++i) { int R, C; stage_rc(tid * 16 + i * 8192, R, C); int Rb = Epi::PERM ? ((R & ~31) + perm32(R & 31)) : R;
        if (Epi::BMAP == 1) Rb = 64 * (R >> 5) + (Rb & 31);
        voffA[i] = (unsigned)(R * K + C) * 2u; voffB[i] = (unsigned)(Rb * K + C) * 2u; }
    const size_t kstep = (size_t)(BK * 2);
    const size_t hstep = (size_t)HALF * K * 2;
    const size_t hstepB = (size_t)(Epi::BMAP == 1 ? 32 : HALF) * K * 2;
    const size_t tstep = 2 * hstep;
    const unsigned ldsw = (unsigned)wid * 1024u;
    const int aoff = lds_byte(wr * 64 + fr, fq * 8), boff = lds_byte(wc * 32 + fr, fq * 8);
#define PG8_SA(b, h) (((b) * 2 + (h)) * HTB)
#define PG8_SB(b, h) ((4 + (b) * 2 + (h)) * HTB)
#define PG8_STAGE(bufoff, gbase, voff) do { _Pragma("unroll") for (int _i = 0; _i < 2; ++_i) \
        __builtin_amdgcn_global_load_lds((const unsigned*)((const char*)(gbase) + (voff)[_i]), (PG8_LAS unsigned*)(lds + (bufoff) + ldsw + _i * 8192), 16, 0, 0); } while (0)
#define PG8_LDA(dst, b, h) do { _Pragma("unroll") for (int m = 0; m < 4; ++m) _Pragma("unroll") for (int k = 0; k < 2; ++k) dst[m][k] = *(const PG8_LAS bf16x8*)(lds + PG8_SA(b, h) + aoff + m * 2048 + k * 1024); } while (0)
#define PG8_LDB(dst, b, h) do { _Pragma("unroll") for (int n = 0; n < 2; ++n) _Pragma("unroll") for (int k = 0; k < 2; ++k) dst[n][k] = *(const PG8_LAS bf16x8*)(lds + PG8_SB(b, h) + boff + n * 2048 + k * 1024); } while (0)
#define PG8_CAT(x) __builtin_shufflevector(__builtin_bit_cast(v4i_t, x[0]), __builtin_bit_cast(v4i_t, x[1]), 0, 1, 2, 3, 4, 5, 6, 7)
#define PG8_MMA(ai, bj, At, Bt) do { __builtin_amdgcn_s_setprio(1); _Pragma("unroll") for (int m = 0; m < 4; ++m) _Pragma("unroll") for (int n = 0; n < 2; ++n) { \
        if constexpr (F8) asm volatile("v_mfma_f32_16x16x128_f8f6f4 %0, %1, %2, %0" : "+v"(acc[ai][bj][m][n]) : "v"(PG8_CAT(Bt[n])), "v"(PG8_CAT(At[m])));       \
        else { _Pragma("unroll") for (int k = 0; k < 2; ++k) acc[ai][bj][m][n] = __builtin_amdgcn_mfma_f32_16x16x32_bf16(Bt[n][k], At[m][k], acc[ai][bj][m][n], 0, 0, 0); } } __builtin_amdgcn_s_setprio(0); } while (0)
#define PG8_WAIT_V(n) asm volatile("s_waitcnt vmcnt(" #n ")" ::: "memory")
#define PG8_WAIT_L(n) asm volatile("s_waitcnt lgkmcnt(" #n ")" ::: "memory")
#define PG8_BAR __builtin_amdgcn_s_barrier()
#define PG8_SCHED __builtin_amdgcn_sched_barrier(0)
#define PG8_PIN_ACC(txt) do { _Pragma("unroll") for (int a_ = 0; a_ < 2; ++a_) _Pragma("unroll") for (int b_ = 0; b_ < 2; ++b_) \
        asm volatile(txt : "+v"(acc[a_][b_][0][0]), "+v"(acc[a_][b_][0][1]), "+v"(acc[a_][b_][1][0]), "+v"(acc[a_][b_][1][1]), "+v"(acc[a_][b_][2][0]), "+v"(acc[a_][b_][2][1]), "+v"(acc[a_][b_][3][0]), "+v"(acc[a_][b_][3][1])); } while (0)
    Unit cur, nxt; int ui = 0;
    if (!S.next(0, cur)) return;
    f32x4 acc[2][2][4][2];
#pragma unroll
    for (int a = 0; a < 2; ++a)
#pragma unroll
        for (int b = 0; b < 2; ++b)
#pragma unroll
            for (int m = 0; m < 4; ++m)
#pragma unroll
                for (int n = 0; n < 2; ++n) acc[a][b][m][n] = (f32x4){0.f, 0.f, 0.f, 0.f};
    if constexpr (F8) PG8_PIN_ACC("");
    bf16x8 At[4][2], B0[2][2], B1[2][2];
    const char* cA = (const char*)g.A + (size_t)cur.pm * tstep; const char* cB = (const char*)g.Bt + (size_t)cur.pn * tstep;
    S.a_ready(cur);
    if constexpr (SP2) {
        PG8_STAGE(PG8_SB(0, 0), cB, voffB); PG8_STAGE(PG8_SB(0, 1), cB + hstepB, voffB); PG8_STAGE(PG8_SA(0, 0), cA, voffA); PG8_STAGE(PG8_SA(0, 1), cA + hstep, voffA);
        if (wr == 1) PG8_BAR;
        PG8_WAIT_V(2); PG8_BAR;
        PG8_STAGE(PG8_SB(1, 0), cB + kstep, voffB); PG8_STAGE(PG8_SA(1, 0), cA + kstep, voffA); PG8_STAGE(PG8_SB(1, 1), cB + hstepB + kstep, voffB);
        PG8_WAIT_V(6); PG8_BAR;
    } else {
        PG8_STAGE(PG8_SB(0, 0), cB, voffB); PG8_STAGE(PG8_SA(0, 0), cA, voffA); PG8_STAGE(PG8_SB(0, 1), cB + hstepB, voffB); PG8_STAGE(PG8_SA(0, 1), cA + hstep, voffA);
        if (wr == 1) PG8_BAR;
        PG8_WAIT_V(4); PG8_BAR;
        PG8_STAGE(PG8_SB(1, 0), cB + kstep, voffB); PG8_STAGE(PG8_SA(1, 0), cA + kstep, voffA); PG8_STAGE(PG8_SB(1, 1), cB + hstepB + kstep, voffB);
        PG8_WAIT_V(6); PG8_BAR;
    }
    for (;;) {
        const bool has_next = S.next(ui + 1, nxt);
        const char* nA = has_next ? (const char*)g.A + (size_t)nxt.pm * tstep : cA; const char* nB = has_next ? (const char*)g.Bt + (size_t)nxt.pn * tstep : cB;
        for (int t = 0; t < nt; t += 2) {
            const bool last = (t == nt - 2);
            const char* a1 = cA + (size_t)(t + 1) * kstep;
            const char* a2 = last ? nA : cA + (size_t)(t + 2) * kstep; const char* b2 = last ? nB : cB + (size_t)(t + 2) * kstep;
            const char* a3 = a2 + kstep; const char* b3 = b2 + kstep;
            if (last && has_next) S.a_ready(nxt);
            if constexpr (SP2) {
            PG8_LDB(B0, 0, 0); PG8_LDB(B1, 0, 1); PG8_SCHED; PG8_LDA(At, 0, 0); PG8_STAGE(PG8_SA(1, 1), a1 + hstep, voffA);
            PG8_WAIT_V(8); PG8_WAIT_L(0); PG8_BAR; PG8_MMA(0, 0, At, B0); PG8_MMA(0, 1, At, B1); PG8_BAR; PG8_SCHED;
            PG8_LDA(At, 0, 1); PG8_STAGE(PG8_SB(0, 0), b2, voffB); PG8_STAGE(PG8_SB(0, 1), b2 + hstepB, voffB); PG8_STAGE(PG8_SA(0, 0), a2, voffA);
            PG8_WAIT_V(8); PG8_WAIT_L(0); PG8_BAR; PG8_MMA(1, 0, At, B0); PG8_MMA(1, 1, At, B1); PG8_BAR; PG8_SCHED;
            PG8_LDB(B0, 1, 0); PG8_LDB(B1, 1, 1); PG8_SCHED; PG8_LDA(At, 1, 0); PG8_STAGE(PG8_SA(0, 1), a2 + hstep, voffA);
            PG8_WAIT_V(8); PG8_WAIT_L(0); PG8_BAR; PG8_MMA(0, 0, At, B0); PG8_MMA(0, 1, At, B1); PG8_BAR; PG8_SCHED;
            PG8_LDA(At, 1, 1); PG8_STAGE(PG8_SB(1, 0), b3, voffB); PG8_STAGE(PG8_SB(1, 1), b3 + hstepB, voffB); PG8_STAGE(PG8_SA(1, 0), a3, voffA);
            PG8_WAIT_V(8); PG8_WAIT_L(0); PG8_BAR; PG8_MMA(1, 0, At, B0); PG8_MMA(1, 1, At, B1); PG8_BAR; PG8_SCHED;
            } else {
            PG8_LDB(B0, 0, 0); PG8_SCHED; PG8_LDA(At, 0, 0); PG8_STAGE(PG8_SA(1, 1), a1 + hstep, voffA);
            PG8_WAIT_L(8); PG8_BAR; PG8_WAIT_L(0); PG8_MMA(0, 0, At, B0); PG8_BAR; PG8_SCHED;
            PG8_LDB(B1, 0, 1); PG8_STAGE(PG8_SB(0, 0), b2, voffB);
            PG8_BAR; PG8_WAIT_L(0); PG8_MMA(0, 1, At, B1); PG8_BAR;
            PG8_LDA(At, 0, 1); PG8_STAGE(PG8_SA(0, 0), a2, voffA);
            PG8_BAR; PG8_WAIT_L(0); PG8_MMA(1, 0, At, B0); PG8_BAR; PG8_SCHED;
            PG8_STAGE(PG8_SB(0, 1), b2 + hstepB, voffB);
            PG8_WAIT_V(6); PG8_BAR; PG8_MMA(1, 1, At, B1); PG8_BAR;
            PG8_LDB(B0, 1, 0); PG8_SCHED; PG8_LDA(At, 1, 0); PG8_STAGE(PG8_SA(0, 1), a2 + hstep, voffA);
            PG8_WAIT_L(8); PG8_BAR; PG8_WAIT_L(0); PG8_MMA(0, 0, At, B0); PG8_BAR; PG8_SCHED;
            PG8_LDB(B1, 1, 1); PG8_STAGE(PG8_SB(1, 0), b3, voffB);
            PG8_BAR; PG8_WAIT_L(0); PG8_MMA(0, 1, At, B1); PG8_BAR;
            PG8_LDA(At, 1, 1); PG8_STAGE(PG8_SA(1, 0), a3, voffA);
            PG8_BAR; PG8_WAIT_L(0); PG8_MMA(1, 0, At, B0); PG8_BAR; PG8_SCHED;
            PG8_STAGE(PG8_SB(1, 1), b3 + hstepB, voffB);
            PG8_WAIT_V(6); PG8_BAR; PG8_MMA(1, 1, At, B1); PG8_BAR;
            }
        }
        if constexpr (F8) PG8_PIN_ACC("s_nop 15");
        if constexpr (ALIGN_EPI) { if (wr == 0) PG8_BAR; }
        if constexpr (!Epi::AFTER_DRAIN) { E(acc, cur, wr, wc, fr, fq); S.done(cur); }
        if (!has_next) break;
#pragma unroll
        for (int a = 0; a < 2; ++a)
#pragma unroll
            for (int b = 0; b < 2; ++b)
#pragma unroll
                for (int m = 0; m < 4; ++m)
#pragma unroll
                    for (int n = 0; n < 2; ++n) acc[a][b][m][n] = (f32x4){0.f, 0.f, 0.f, 0.f};
        if constexpr (F8) PG8_PIN_ACC("");
        cur = nxt; cA = nA; cB = nB; ++ui;
        if constexpr (ALIGN_EPI) { if (wr == 1) PG8_BAR; }
    }
    PG8_WAIT_V(0);
    if constexpr (!ALIGN_EPI) { if (wr == 0) PG8_BAR; }
    PG8_BAR;
    if constexpr (Epi::AFTER_DRAIN) { E.fused(acc, cur, wr, wc, fr, fq, lds, wid, lane); S.done(cur); }
#undef PG8_SA
#undef PG8_SB
#undef PG8_STAGE
#undef PG8_LDA
#undef PG8_LDB
#undef PG8_MMA
#undef PG8_CAT
#undef PG8_PIN_ACC
#undef PG8_WAIT_V
#undef PG8_WAIT_L
#undef PG8_BAR
#undef PG8_SCHED
}
}

#ifndef PG8_SP2
#define PG8_SP2 true
#endif
#ifndef PG8_ALIGN
#define PG8_ALIGN true
#endif

namespace attn_body {
using bf16=__hip_bfloat16;
using bf16x8=__attribute__((ext_vector_type(8)))short;
using s16x4=__attribute__((ext_vector_type(4)))short;
using f32x16=__attribute__((ext_vector_type(16)))float;
using u32x4=__attribute__((ext_vector_type(4)))unsigned;
constexpr int BATCH=8,NHEAD=8,SEQ=2048,D=64,DM=2560,YP=1024;
constexpr int NW=8,QBLK=32,QB=QBLK*NW,KVBLK=64,NQB=SEQ/QB;
constexpr int ATTN_PITCH=DM, ATTN_UNIT_ROWS=QB;
__device__ __forceinline__ int crow(int r,int hi){return (r&3)+8*(r>>2)+4*hi;}
#define SBAR() __builtin_amdgcn_sched_barrier(0)
__device__ __forceinline__ void cmask(f32x16&p0,f32x16&p1,int jb,int qrel,int hi){
  const float NEG=-INFINITY; int kb=64*jb+4*hi;
  #pragma unroll
  for(int r=0;r<16;++r){int kv=kb+(r&3)+8*(r>>2); if(kv>qrel)p0[r]=NEG; if(kv+32>qrel)p1[r]=NEG;}
}

constexpr int NSLOT=3, SLOTB=8192;
constexpr int LDS_K=0, LDS_V=NSLOT*SLOTB, LDS_WS=2*NSLOT*SLOTB, LDS_OST=LDS_WS+NW*64*4, LDS_BYTES=LDS_OST+NW*8192;
constexpr float C2=0.125f*1.4426950408889634f;
__device__ __forceinline__ void glds16(const void*gsrc,unsigned lds_dst){unsigned keep;
  asm volatile("s_mov_b32 %0, m0\n\ts_mov_b32 m0, %2\n\ts_nop 0\n\tglobal_load_lds_dwordx4 %1, off\n\ts_mov_b32 m0, %0":"=&s"(keep):"v"(gsrc),"s"(lds_dst):"memory");}
__device__ __forceinline__ float max3f(float a,float b,float c){float r;asm("v_max3_f32 %0, %1, %2, %3":"=v"(r):"v"(a),"v"(b),"v"(c));return r;}
__device__ __forceinline__ float max2f(float a,float b){float r;asm("v_max_f32_e32 %0, %1, %2":"=v"(r):"v"(a),"v"(b));return r;}
__device__ __forceinline__ float fadd_s(float a,float b){float r;asm("v_add_f32_e32 %0, %1, %2":"=v"(r):"v"(a),"v"(b));return r;}
__device__ __forceinline__ float fsub_s(float a,float b){float r;asm("v_sub_f32_e32 %0, %1, %2":"=v"(r):"v"(a),"v"(b));return r;}
typedef float f32x2_t __attribute__((ext_vector_type(2))); typedef __bf16 bf16x2_t __attribute__((ext_vector_type(2))); typedef float f32x4_t __attribute__((ext_vector_type(4))); typedef unsigned u32x2_t __attribute__((ext_vector_type(2)));
__device__ __forceinline__ unsigned cvtpk_s(float lo,float hi){f32x2_t v={lo,hi};bf16x2_t b=__builtin_convertvector(v,bf16x2_t);return __builtin_bit_cast(unsigned,b);}
#define WAIT_BAR(N) asm volatile("s_waitcnt vmcnt(" #N ") lgkmcnt(0)\n\ts_barrier":::"memory")

__device__ __forceinline__ void qkt(f32x16&p0,f32x16&p1,const char*Kslot,const bf16x8*qr,const f32x16&negm,int r32,int hi){
  const char*kb=Kslot+hi*1024+r32*16;
  #pragma unroll
  for(int d0=0;d0<4;++d0){
    const bf16x8 b0=*reinterpret_cast<const bf16x8*>(kb+d0*2048);
    const bf16x8 b1=*reinterpret_cast<const bf16x8*>(kb+d0*2048+512);
    if(d0==0){p0=__builtin_amdgcn_mfma_f32_32x32x16_bf16(b0,qr[0],negm,0,0,0);p1=__builtin_amdgcn_mfma_f32_32x32x16_bf16(b1,qr[0],negm,0,0,0);}
    else{p0=__builtin_amdgcn_mfma_f32_32x32x16_bf16(b0,qr[d0],p0,0,0,0);p1=__builtin_amdgcn_mfma_f32_32x32x16_bf16(b1,qr[d0],p1,0,0,0);}}
}
typedef __attribute__((address_space(3))) const char* lds_cptr;
typedef short v4i16_t __attribute__((ext_vector_type(4)));
__device__ __forceinline__ void kload8(bf16x8*kf,lds_cptr kp){
  kf[0]=*(const __attribute__((address_space(3))) bf16x8*)(kp);      kf[1]=*(const __attribute__((address_space(3))) bf16x8*)(kp+512);
  kf[2]=*(const __attribute__((address_space(3))) bf16x8*)(kp+2048); kf[3]=*(const __attribute__((address_space(3))) bf16x8*)(kp+2560);
  kf[4]=*(const __attribute__((address_space(3))) bf16x8*)(kp+4096); kf[5]=*(const __attribute__((address_space(3))) bf16x8*)(kp+4608);
  kf[6]=*(const __attribute__((address_space(3))) bf16x8*)(kp+6144); kf[7]=*(const __attribute__((address_space(3))) bf16x8*)(kp+6656);
}
__device__ __forceinline__ void kload2(bf16x8*kf,lds_cptr kp,int j){ kf[2*j]=*(const __attribute__((address_space(3))) bf16x8*)(kp+j*2048); kf[2*j+1]=*(const __attribute__((address_space(3))) bf16x8*)(kp+j*2048+512); }
__device__ __forceinline__ s16x4 vtr(lds_cptr p){ return __builtin_bit_cast(s16x4,__builtin_amdgcn_ds_read_tr16_b64_v4i16((__attribute__((address_space(3))) v4i16_t*)p)); }
__device__ __forceinline__ float rowmax(const f32x16&p0,const f32x16&p1){
  float a=max3f(p0[0],p0[1],p1[0]),b=max3f(p0[2],p0[3],p1[1]);a=max3f(a,p1[2],p1[3]);
  #pragma unroll
  for(int r=4;r<16;r+=4){a=max3f(a,p0[r],p0[r+1]);b=max3f(b,p0[r+2],p0[r+3]);a=max3f(a,p1[r],p1[r+1]);b=max3f(b,p1[r+2],p1[r+3]);}
  const float m=max2f(a,b);
  auto rr=__builtin_amdgcn_permlane32_swap(__float_as_uint(m),__float_as_uint(m),false,false);
  return max2f(__uint_as_float(rr[0]),__uint_as_float(rr[1]));
}
__device__ __forceinline__ void pv(f32x16*o,int vb,bf16x8 pa0,bf16x8 pa1,bf16x8 pa2,bf16x8 pa3){
  #pragma unroll
  for(int d0=0;d0<2;++d0){s16x4 lo[4],hi[4];
    #pragma unroll
    for(int ks=0;ks<4;++ks){
      asm volatile("ds_read_b64_tr_b16 %0,%1 offset:%c2":"=&v"(lo[ks]):"v"(vb),"i"(d0*4096+ks*1024):"memory");
      asm volatile("ds_read_b64_tr_b16 %0,%1 offset:%c2":"=&v"(hi[ks]):"v"(vb),"i"(d0*4096+ks*1024+512):"memory");}
    asm volatile("s_waitcnt lgkmcnt(0)":::"memory");SBAR();
    #define PK(k) (bf16x8){lo[k][0],lo[k][1],lo[k][2],lo[k][3],hi[k][0],hi[k][1],hi[k][2],hi[k][3]}
    o[d0]=__builtin_amdgcn_mfma_f32_32x32x16_bf16(pa0,PK(0),o[d0],0,0,0);
    o[d0]=__builtin_amdgcn_mfma_f32_32x32x16_bf16(pa1,PK(1),o[d0],0,0,0);
    o[d0]=__builtin_amdgcn_mfma_f32_32x32x16_bf16(pa2,PK(2),o[d0],0,0,0);
    o[d0]=__builtin_amdgcn_mfma_f32_32x32x16_bf16(pa3,PK(3),o[d0],0,0,0);
    #undef PK
  }
}

#ifndef ATTN_STORE16
#define ATTN_STORE16(p,v) (*(u32x4*)(p)=(v))
#endif
template<int THRL> __device__ __forceinline__ void attn_unit(int b,int h,int qb,const bf16*Q,const bf16*__restrict__ K,const bf16*__restrict__ V,bf16*Y,const float*__restrict__ ksum,const float*__restrict__ onb_g,char*shm){
  int tid_=threadIdx.x; asm volatile("":"+v"(tid_)); const int tid=tid_,lane=tid&63,r32=lane&31,hi=lane>>5; const int wid=__builtin_amdgcn_readfirstlane(tid>>6);
  const long rowbase=(long)b*SEQ; const int q0=qb*QB;
  const bf16*Qw=Q+(rowbase+q0+wid*QBLK)*DM+h*D;
  const bf16*Kh=K+rowbase*DM+h*D,*Vh=V+rowbase*DM+h*D;
  const unsigned lds0=(unsigned)(uintptr_t)shm;
  float*wsf=(float*)(shm+LDS_WS)+wid*64;
  const bf16*ksrc=Kh+(long)lane*DM+wid*8;
  const bf16*vsrc=Vh+(long)(16*(wid&3)+(lane>>2))*DM+(wid>>2)*32+(lane&3)*8;
  const unsigned kdst=lds0+LDS_K+wid*1024, vdst=lds0+LDS_V+wid*1024;
  #define DMA_K(t,slot) glds16(ksrc+(long)(t)*KVBLK*DM,(unsigned)__builtin_amdgcn_readfirstlane(kdst+(slot)))
  #define DMA_V(t,slot) glds16(vsrc+(long)(t)*KVBLK*DM,(unsigned)__builtin_amdgcn_readfirstlane(vdst+(slot)))
  const int vb0=(int)(lds0+LDS_V)+((lane>>4)&1)*32+(lane&3)*8+(4*hi+((lane&15)>>2))*64;
  const char*Kbase=shm+LDS_K; bf16x8 kf[8];
  const lds_cptr shm3=(lds_cptr)shm; const lds_cptr kp0=shm3+LDS_K+hi*1024+r32*16; const lds_cptr vp0=shm3+LDS_V+((lane>>4)&1)*32+(lane&3)*8+(4*hi+((lane&15)>>2))*64;
  const int NT=(q0+QB)/KVBLK;
  DMA_K(0,0);DMA_V(0,0);DMA_K(1,SLOTB);
  bf16x8 qr[4];
  #pragma unroll
  for(int d0=0;d0<4;++d0)qr[d0]=*reinterpret_cast<const bf16x8*>(&Qw[(long)r32*DM+d0*16+hi*8]);
  unsigned selbits;
  { f32x16 g=f32x16{};
    const float*kr=ksum+((((long)(b*(SEQ/QB)+r32)*2)*NHEAD+h)*D)+hi*8;
    #pragma unroll
    for(int d0=0;d0<4;++d0){ f32x4_t a0={0.f,0.f,0.f,0.f},a1={0.f,0.f,0.f,0.f}; if(r32<qb){a0=*reinterpret_cast<const f32x4_t*>(kr+d0*16)+*reinterpret_cast<const f32x4_t*>(kr+NHEAD*D+d0*16);a1=*reinterpret_cast<const f32x4_t*>(kr+d0*16+4)+*reinterpret_cast<const f32x4_t*>(kr+NHEAD*D+d0*16+4);}
      float hv[8],lv[8];
      #pragma unroll
      for(int e=0;e<4;++e){const float t0=a0[e],t1=a1[e];     hv[e]=__uint_as_float(__float_as_uint(t0)&0xffff0000u);lv[e]=t0-hv[e];hv[4+e]=__uint_as_float(__float_as_uint(t1)&0xffff0000u);lv[4+e]=t1-hv[4+e];}
      u32x4 wh={cvtpk_s(hv[0],hv[1]),cvtpk_s(hv[2],hv[3]),cvtpk_s(hv[4],hv[5]),cvtpk_s(hv[6],hv[7])},wl={cvtpk_s(lv[0],lv[1]),cvtpk_s(lv[2],lv[3]),cvtpk_s(lv[4],lv[5]),cvtpk_s(lv[6],lv[7])};
      g=__builtin_amdgcn_mfma_f32_32x32x16_bf16(__builtin_bit_cast(bf16x8,wh),qr[d0],g,0,0,0);
      g=__builtin_amdgcn_mfma_f32_32x32x16_bf16(__builtin_bit_cast(bf16x8,wl),qr[d0],g,0,0,0);}
    float gt[8];
    #pragma unroll
    for(int r=0;r<4;++r){auto rr=__builtin_amdgcn_permlane32_swap(__float_as_uint(g[r]),__float_as_uint(g[r]),false,false);gt[r]=__uint_as_float(rr[0]);gt[4+r]=__uint_as_float(rr[1]);}
    selbits=1u<<qb;
    #pragma unroll
    for(int n=0;n<7;++n){int rank=0;
      #pragma unroll
      for(int m=0;m<7;++m)if(m!=n)rank+=(m<qb&&(gt[m]>gt[n]||(gt[m]==gt[n]&&m<n)))?1:0;
      if(n<qb&&rank<3)selbits|=1u<<n;}
  }
  #define MSKF(n) ((((selbits>>(n))&1u)!=0u)?0.f:-INFINITY)
  float mhat=0.f,l_reg=0.f;f32x16 o[2];o[0]=f32x16{};o[1]=f32x16{};f32x16 negm;{const float nm0=MSKF(0);
  #pragma unroll
  for(int r=0;r<16;++r)negm[r]=nm0;}asm volatile("":"+v"(negm));
  #define NEWBLK(tt) do{ if((((tt)&3)==0)){ const float nm_=MSKF((tt)>>2)-mhat; _Pragma("unroll") for(int r=0;r<16;++r)negm[r]=nm_; asm volatile("":"+v"(negm)); } }while(0)
  const int qrel=wid*QBLK+r32;
  #define CMASK(P0,P1,t) do{int jb_=(t)-(NT-4); if(jb_>=0)cmask(P0,P1,jb_,qrel,hi);}while(0)
  bool resc=false;
  #define START(P0,P1) do{ const float rm=rowmax(P0,P1); resc=false; \
    { const float dl=(rm==-INFINITY)?0.f:rm; mhat=fadd_s(mhat,dl); \
      _Pragma("unroll") for(int r=0;r<16;++r){P0[r]=fsub_s(P0[r],dl);P1[r]=fsub_s(P1[r],dl);} \
      const float nm_=MSKF(0)-mhat; _Pragma("unroll") for(int r=0;r<16;++r)negm[r]=nm_; asm volatile("":"+v"(negm)); } \
    _Pragma("unroll") for(int r=0;r<16;++r)P0[r]=__builtin_amdgcn_exp2f(P0[r]); }while(0)
  #define RESC() do{ if(resc){ asm volatile("s_waitcnt lgkmcnt(0)":::"memory"); \
      _Pragma("unroll") for(int d_=0;d_<2;++d_) _Pragma("unroll") for(int r=0;r<16;++r)o[d_][r]*=wsf[crow(r,hi)]; } }while(0)
  f32x16 pA0,pA1,pB0,pB1;
  int sl_prev=0,sl_cur=0,sl_next=SLOTB;
  #define ROT() do{sl_prev=sl_cur;sl_cur=sl_next;sl_next=(sl_next==(NSLOT-1)*SLOTB)?0:sl_next+SLOTB;}while(0)
  DMA_K(2,2*SLOTB);
  WAIT_BAR(3);
  qkt(pA0,pA1,Kbase,qr,negm,r32,hi);asm volatile("s_nop 15\n\ts_nop 7":"+v"(pA0),"+v"(pA1));CMASK(pA0,pA1,0);
  START(pA0,pA1);
  _Pragma("unroll") for(int r=0;r<16;++r)pA1[r]=__builtin_amdgcn_exp2f(pA1[r]);
  WAIT_BAR(0);
  DMA_K(3,0);DMA_V(1,SLOTB);
  ROT();
  kload8(kf,kp0+sl_cur);
  WAIT_BAR(2);
  s16x4 vlo[8],vhi[8]; u32x4 pw0,pw1,pw2,pw3;
  #define PKW(P,B) cvtpk_s(P[B],P[B+1])
  #define PAF(k) __builtin_bit_cast(bf16x8,pw##k)
  #define VFR(i) (bf16x8){vlo[i][0],vlo[i][1],vlo[i][2],vlo[i][3],vhi[i][0],vhi[i][1],vhi[i][2],vhi[i][3]}
  #define PIN(x) asm volatile("":"+v"(x))
  #define MX3(a,b,c) __builtin_fmaxf(__builtin_fmaxf((a),(b)),(c))
  #define GAPA(MF,A0,A1,A2,A3,W0,W1,PW) do{ MF; sacc+=A0; sacc+=A1; sacc+=A2; sacc+=A3; PIN(sacc); W0; W1; PIN(PW); SBAR(); }while(0)
  #define EX(v) __builtin_amdgcn_exp2f(v)
  #define GAPB(MF,X,B) do{ MF; X[B]=EX(X[B]); X[B+1]=EX(X[B+1]); X[B+2]=EX(X[B+2]); X[B+3]=EX(X[B+3]); PIN(X); SBAR(); }while(0)
  #define VRD(i) do{ vlo[i]=vtr(vp_+(((i)>>2)*4096+((i)&3)*1024)); vhi[i]=vtr(vp_+(((i)>>2)*4096+((i)&3)*1024+512)); }while(0)
  #define KRD(G,j) do{ if(G){ kload2(kf,kp0+sl_next,j); SBAR(); } }while(0)
  #define STEP(C0,C1,P0,P1,t,GK,GV,GL) do{ SBAR(); \
    const lds_cptr vp_=vp0+sl_prev; \
    VRD(0); SBAR(); float sacc=(P0[0]+P0[1]); \
    GAPA(C0=__builtin_amdgcn_mfma_f32_32x32x16_bf16(kf[0],qr[0],negm,0,0,0), P0[2],P0[3],P0[4],P0[5],     pw0[0]=PKW(P0,0), pw0[1]=PKW(P0,2), pw0); \
    VRD(4); SBAR(); GAPA(C1=__builtin_amdgcn_mfma_f32_32x32x16_bf16(kf[1],qr[0],negm,0,0,0), P0[6],P0[7],P0[8],P0[9],     pw0[2]=PKW(P0,4), pw0[3]=PKW(P0,6), pw0); \
    VRD(1); SBAR(); GAPA(C0=__builtin_amdgcn_mfma_f32_32x32x16_bf16(kf[2],qr[1],C0,0,0,0),   P0[10],P0[11],P0[12],P0[13], pw1[0]=PKW(P0,8), pw1[1]=PKW(P0,10), pw1); \
    VRD(5); SBAR(); GAPA(C1=__builtin_amdgcn_mfma_f32_32x32x16_bf16(kf[3],qr[1],C1,0,0,0),   P0[14],P0[15],P1[0],P1[1],   pw1[2]=PKW(P0,12),pw1[3]=PKW(P0,14), pw1); \
    VRD(2); SBAR(); GAPA(C0=__builtin_amdgcn_mfma_f32_32x32x16_bf16(kf[4],qr[2],C0,0,0,0),   P1[2],P1[3],P1[4],P1[5],     pw2[0]=PKW(P1,0), pw2[1]=PKW(P1,2), pw2); \
    VRD(6); SBAR(); GAPA(C1=__builtin_amdgcn_mfma_f32_32x32x16_bf16(kf[5],qr[2],C1,0,0,0),   P1[6],P1[7],P1[8],P1[9],     pw2[2]=PKW(P1,4), pw2[3]=PKW(P1,6), pw2); \
    VRD(3); SBAR(); GAPA(C0=__builtin_amdgcn_mfma_f32_32x32x16_bf16(kf[6],qr[3],C0,0,0,0),   P1[10],P1[11],P1[12],P1[13], pw3[0]=PKW(P1,8), pw3[1]=PKW(P1,10), pw3); \
    VRD(7); SBAR(); GAPA(C1=__builtin_amdgcn_mfma_f32_32x32x16_bf16(kf[7],qr[3],C1,0,0,0),   P1[14],P1[15],0.f,0.f,       pw3[2]=PKW(P1,12),pw3[3]=PKW(P1,14), pw3); \
    l_reg+=sacc; \
    if(GK){DMA_K((t)+3,sl_cur);} if(GV){DMA_V((t)+1,sl_next);} \
    CMASK(C0,C1,t); \
    { float a=MX3(C0[0],C0[1],C1[0]),b=MX3(C0[2],C0[3],C1[1]); a=MX3(a,C1[2],C1[3]); \
      _Pragma("unroll") for(int r=4;r<16;r+=4){a=MX3(a,C0[r],C0[r+1]);b=MX3(b,C0[r+2],C0[r+3]);a=MX3(a,C1[r],C1[r+1]);b=MX3(b,C1[r+2],C1[r+3]);} \
      float rm=__builtin_fmaxf(a,b); { auto rr=__builtin_amdgcn_permlane32_swap(__float_as_uint(rm),__float_as_uint(rm),false,false); rm=__builtin_fmaxf(__uint_as_float(rr[0]),__uint_as_float(rr[1])); } \
      resc=false; \
      if(__builtin_expect(__any(rm>(float)THRL),0)){ const float dl=__builtin_fmaxf(rm,0.f); mhat+=dl; \
        _Pragma("unroll") for(int r=0;r<16;++r){C0[r]-=dl;C1[r]-=dl;} \
        const float nm_=MSKF((t)>>2)-mhat; _Pragma("unroll") for(int r=0;r<16;++r)negm[r]=nm_; asm volatile("":"+v"(negm)); \
        const float f=__builtin_amdgcn_exp2f(-dl); l_reg*=f; if(hi==0)wsf[r32]=f; resc=true; } } \
    SBAR(); \
    GAPB(o[0]=__builtin_amdgcn_mfma_f32_32x32x16_bf16(PAF(0),VFR(0),o[0],0,0,0), C0,0); \
    GAPB(o[1]=__builtin_amdgcn_mfma_f32_32x32x16_bf16(PAF(0),VFR(4),o[1],0,0,0), C0,4); \
    KRD(GL,0); GAPB(o[0]=__builtin_amdgcn_mfma_f32_32x32x16_bf16(PAF(1),VFR(1),o[0],0,0,0), C0,8); \
    KRD(GL,1); GAPB(o[1]=__builtin_amdgcn_mfma_f32_32x32x16_bf16(PAF(1),VFR(5),o[1],0,0,0), C0,12); \
    KRD(GL,2); GAPB(o[0]=__builtin_amdgcn_mfma_f32_32x32x16_bf16(PAF(2),VFR(2),o[0],0,0,0), C1,0); \
    KRD(GL,3); GAPB(o[1]=__builtin_amdgcn_mfma_f32_32x32x16_bf16(PAF(2),VFR(6),o[1],0,0,0), C1,4); \
    GAPB(o[0]=__builtin_amdgcn_mfma_f32_32x32x16_bf16(PAF(3),VFR(3),o[0],0,0,0), C1,8); \
    GAPB(o[1]=__builtin_amdgcn_mfma_f32_32x32x16_bf16(PAF(3),VFR(7),o[1],0,0,0), C1,12); \
    }while(0)
  int t=1;
  #undef CMASK
  #define CMASK(P0,P1,t) do{}while(0)
  for(;t+5<NT;t+=2){
    STEP(pB0,pB1,pA0,pA1,t,true,true,true);     WAIT_BAR(2); RESC(); ROT(); NEWBLK(t+1);
    STEP(pA0,pA1,pB0,pB1,t+1,true,true,true);   WAIT_BAR(2); RESC(); ROT();
  }
  #undef CMASK
  #define CMASK(P0,P1,t) do{int jb_=(t)-(NT-4); if(jb_>=0)cmask(P0,P1,jb_,qrel,hi);}while(0)
  #define ENDW(tt) do{ if((tt)+3<NT){WAIT_BAR(2);} else if((tt)+2<NT){WAIT_BAR(1);} else {WAIT_BAR(0);} }while(0)
  for(;t+1<NT;t+=2){
    STEP(pB0,pB1,pA0,pA1,t,(t+3<NT),(t+1<NT),(t+1<NT));       ENDW(t);   RESC(); ROT(); NEWBLK(t+1);
    STEP(pA0,pA1,pB0,pB1,t+1,(t+4<NT),(t+2<NT),(t+2<NT));     ENDW(t+1); RESC(); ROT();
  }
  STEP(pB0,pB1,pA0,pA1,NT-1,false,false,false); RESC();
  { float sacc=pB0[0]+pB0[1]; _Pragma("unroll") for(int r=2;r<16;++r)sacc+=pB0[r]; _Pragma("unroll") for(int r=0;r<16;++r)sacc+=pB1[r]; l_reg+=sacc;
    pw0=(u32x4){PKW(pB0,0),PKW(pB0,2),PKW(pB0,4),PKW(pB0,6)};pw1=(u32x4){PKW(pB0,8),PKW(pB0,10),PKW(pB0,12),PKW(pB0,14)};pw2=(u32x4){PKW(pB1,0),PKW(pB1,2),PKW(pB1,4),PKW(pB1,6)};pw3=(u32x4){PKW(pB1,8),PKW(pB1,10),PKW(pB1,12),PKW(pB1,14)};
    SBAR(); pv(o,vb0+sl_cur,PAF(0),PAF(1),PAF(2),PAF(3)); }
  #undef PKW
  #undef PAF
  #undef VFR
  #undef PIN
  #undef MX3
  #undef GAPA
  #undef GAPB
  #undef EX
  #undef VRD
  #undef KRD
  #undef STEP
  #undef ENDW
  {auto rr=__builtin_amdgcn_permlane32_swap(__float_as_uint(l_reg),__float_as_uint(l_reg),false,false);l_reg=__uint_as_float(rr[0])+__uint_as_float(rr[1]);}
  if(hi==0)wsf[32+r32]=l_reg;asm volatile("s_waitcnt lgkmcnt(0)":::"memory");
  float rli[16];
  #pragma unroll
  for(int r=0;r<16;++r)rli[r]=__builtin_amdgcn_rcpf(wsf[32+crow(r,hi)]);
  bf16*Yw=Y+(rowbase+q0+wid*QBLK)*YP+h*D;
  { float*stg=(float*)(shm+LDS_OST)+wid*2048;
    #pragma unroll
    for(int r=0;r<16;++r){const int orow=crow(r,hi);
      #pragma unroll
      for(int d0=0;d0<2;++d0)stg[orow*64+d0*32+r32]=o[d0][r]*rli[r];}
    asm volatile("s_waitcnt lgkmcnt(0)":::"memory");
    const int c4=lane&15; const f32x4_t g4=*reinterpret_cast<const f32x4_t*>(onb_g+h*D+c4*4);
    #pragma unroll
    for(int i=0;i<8;++i){const int row=i*4+(lane>>4); const f32x4_t v=*(const f32x4_t*)(stg+row*64+c4*4);
      float ss=(v[0]*v[0]+v[1]*v[1])+(v[2]*v[2]+v[3]*v[3]); ss+=__shfl_xor(ss,1); ss+=__shfl_xor(ss,2); ss+=__shfl_xor(ss,4); ss+=__shfl_xor(ss,8);
      const float rs=__builtin_amdgcn_rsqf(ss*(1.0f/64.0f)+1e-6f);
      u32x2_t w; w.x=cvtpk_s(v[0]*rs*g4[0],v[1]*rs*g4[1]); w.y=cvtpk_s(v[2]*rs*g4[2],v[3]*rs*g4[3]);
      *(u32x2_t*)(Yw+(long)row*YP+c4*4)=w;} }
  asm volatile("s_waitcnt lgkmcnt(0)\n\ts_barrier":::"memory");
  #undef DMA_K
  #undef DMA_V
  #undef MSKF
  #undef NEWBLK
  #undef CMASK
  #undef START
  #undef RESC
  #undef ROT
}
constexpr int ATTN_LDS_BYTES=LDS_BYTES;
struct AttnTensors { const bf16* Q; const bf16* K; const bf16* V; bf16* Y; const float* ksum; const float* onb_g; };
struct AttnUnit { int bh; int qb; };
struct StaticOrder {
  int vcu,G;
  __device__ __forceinline__ explicit StaticOrder(int grid,int block):vcu((grid%8==0)?(block%8)*(grid/8)+block/8:block),G(grid){}
  __device__ __forceinline__ bool next(int i,AttnUnit&u)const{ const int p=vcu+(i>>1)*G; if(p>=BATCH*NHEAD*4)return false; const int s=p&3; u.bh=p>>2; u.qb=(i&1)?7-s:s; return true; }
  __device__ __forceinline__ void a_ready(const AttnUnit&)const{}
  __device__ __forceinline__ void done(const AttnUnit&)const{}
};
template<class Sched,int THRL=8> __device__ __forceinline__ void attn_phase(char*lds,const AttnTensors&T,const Sched&S){
  AttnUnit u;
  for(int i=0;S.next(i,u);++i){ S.a_ready(u); attn_unit<THRL>(u.bh/NHEAD,u.bh%NHEAD,u.qb,T.Q,T.K,T.V,T.Y,T.ksum,T.onb_g,lds); S.done(u); }
}
#undef SBAR
#undef WAIT_BAR
}
constexpr int NWAVES = 8;
constexpr int CW_TMO = 0, CW_CODE = 1, CW_EXIT = 2, CW_START = 64;
constexpr int CW_BAR = 4096;
constexpr int RING_OFF = 0, RING_BYTES = 131072;
constexpr int LDSCTL_OFF = RING_BYTES, MISC_OFF = LDSCTL_OFF + 320;
constexpr int LDS_BYTES = 147456;
constexpr int PAR_OFF = LDSCTL_OFF + 1024;
constexpr int RSL_OFF = PAR_OFF + 5120;
static_assert(MISC_OFF + 128 <= PAR_OFF && PAR_OFF + 1152 * 4 <= RSL_OFF && RSL_OFF + 2048 <= LDS_BYTES, "LDS map");

#define GAS __attribute__((address_space(1)))
#define LAS __attribute__((address_space(3)))
typedef unsigned short bf16;
typedef unsigned v4u __attribute__((ext_vector_type(4)));
typedef float f32x4 __attribute__((ext_vector_type(4)));
typedef short bf16x8 __attribute__((ext_vector_type(8)));
typedef GAS unsigned gu32;
typedef GAS unsigned long long gu64;
#define RLX_AGENT __ATOMIC_RELAXED, __HIP_MEMORY_SCOPE_AGENT
#define LDS_WAIT() asm volatile("s_waitcnt lgkmcnt(0)" ::: "memory")
#define VM_WAIT() asm volatile("s_waitcnt vmcnt(0)" ::: "memory")
__device__ __forceinline__ unsigned long long rt() { return __builtin_amdgcn_s_memrealtime(); }
__device__ __forceinline__ unsigned f2bf(float f) { unsigned u = __builtin_bit_cast(unsigned, f); return (u + 0x7fffu + ((u >> 16) & 1u)) >> 16; }
__device__ __forceinline__ unsigned pk2(float lo, float hi) { return f2bf(lo) | (f2bf(hi) << 16); }

#define XB_TMO      128
#define XB_XCNT(j)  (256  + 64 * (j))
#define XB_XSUB(j)  (1280 + 64 * (j))
#define XB_XGEN(j)  (2304 + 64 * (j))
#define XB_TOP      3328
#define XB_TOPGEN   3392
#define XCD_BAR_WORDS 3456
#define XB_SPIN_CAP (1u << 18)

__device__ __forceinline__ unsigned xb_ld(unsigned* p)              { return __hip_atomic_load(p, __ATOMIC_RELAXED, __HIP_MEMORY_SCOPE_AGENT); }
__device__ __forceinline__ unsigned xb_add(unsigned* p, unsigned v) { return __hip_atomic_fetch_add(p, v, __ATOMIC_RELAXED, __HIP_MEMORY_SCOPE_AGENT); }
__device__ __forceinline__ unsigned xb_xcc_id() { return (unsigned)__builtin_amdgcn_s_getreg((3 << 11) | 20) & 0xFu; }
#define XB_SPIN(cond, bar) do { unsigned _sp = 0; while (cond) { __builtin_amdgcn_s_sleep(1); \
    if ((++_sp & 255u) == 0u) { if (xb_ld(&(bar)[XB_TMO])) break; if (_sp > XB_SPIN_CAP) { atomicAdd(&(bar)[XB_TMO], 1u); break; } } } } while (0)

struct XcdBarrier {
    unsigned* bar; unsigned x;
    volatile LAS unsigned* st;
};

__device__ __forceinline__ XcdBarrier xcd_barrier_post(unsigned* bar, volatile LAS unsigned* st) {
    XcdBarrier b; b.bar = bar; b.x = xb_xcc_id(); b.st = st;
    if (threadIdx.x == 0) (void)xb_add(&bar[XB_XCNT(b.x)], 1u);
    return b;
}
__device__ __forceinline__ void xcd_barrier_complete(unsigned* bar, unsigned x, unsigned& nloc, unsigned& nx) {
    const unsigned G = gridDim.x * gridDim.y * gridDim.z;
    unsigned sum, cnt, mine, sp = 0u;
    for (;;) {
        sum = 0u; cnt = 0u; mine = 0u;
#pragma unroll
        for (unsigned j = 0; j < 16; ++j) { const unsigned c = xb_ld(&bar[XB_XCNT(j)]); sum += c; cnt += (c > 0u) ? 1u : 0u; mine = (j == x) ? c : mine; }
        if (sum == G) break;
        __builtin_amdgcn_s_sleep(1);
        if ((++sp & 255u) == 0u) { if (xb_ld(&bar[XB_TMO])) break; if (sp > XB_SPIN_CAP) { atomicAdd(&bar[XB_TMO], 1u); break; } }
    }
    nloc = mine > 0u ? mine : 1u; nx = cnt > 0u ? cnt : 1u;
}

__device__ __forceinline__ void xcd_barrier(const XcdBarrier& b) {
    asm volatile("s_waitcnt vmcnt(0)" ::: "memory");
    __syncthreads();
    if (threadIdx.x == 0) {
        unsigned* bar = b.bar;
        __builtin_amdgcn_s_waitcnt(0);
        unsigned nloc = b.st[0], nx = b.st[1];
        if (nloc == 0u) { xcd_barrier_complete(bar, b.x, nloc, nx); b.st[0] = nloc; b.st[1] = nx; }
        const unsigned old = xb_add(&bar[XB_XSUB(b.x)], 1u);
        const unsigned gen = old / nloc;
        if (old + 1u == (gen + 1u) * nloc) {
            __builtin_amdgcn_fence(__ATOMIC_RELEASE, "agent");
            asm volatile("s_waitcnt vmcnt(0)" ::: "memory");
            const unsigned og = xb_add(&bar[XB_TOP], 1u);
            const unsigned tg = og / nx;
            if (og + 1u == (tg + 1u) * nx) xb_add(&bar[XB_TOPGEN], 1u);
            else XB_SPIN(xb_ld(&bar[XB_TOPGEN]) == tg, bar);
            __builtin_amdgcn_fence(__ATOMIC_ACQUIRE, "agent");
            xb_add(&bar[XB_XGEN(b.x)], 1u);
            asm volatile("s_waitcnt vmcnt(0)" ::: "memory");
        } else {
            XB_SPIN(xb_ld(&bar[XB_XGEN(b.x)]) == gen, bar);
            __builtin_amdgcn_fence(__ATOMIC_ACQUIRE, "agent");
            asm volatile("s_waitcnt vmcnt(0)" ::: "memory");
        }
    }
    __syncthreads();
}

struct Frame {
    LAS unsigned char* lds;
    volatile LAS unsigned* MISC;
    gu32* ctl;
    int tid, lane, wave;
    int vcu, G;
};

__device__ __forceinline__ float wave_sum(float v) {
#pragma unroll
    for (int o = 1; o < 64; o <<= 1) v += __shfl_xor(v, o);
    return v;
}
struct WTile { const float* W; const float* g; void* WT; int K, N, k0, n0; float scale; int f8, gu; };
constexpr int WT_S = 257;
__device__ __forceinline__ void wtile_load(const WTile& t, int wave, int lane, f32x4 (&v)[8]) {
#pragma unroll
    for (int i = 0; i < 8; ++i) v[i] = *(const GAS f32x4*)(t.W + (size_t)(t.k0 + wave + 8 * i) * t.N + t.n0 + 4 * lane);
}
__device__ __forceinline__ void wtile_store(const WTile& t, int tid, int wave, int lane, const f32x4 (&v)[8], LAS float* scr) {
#pragma unroll
    for (int i = 0; i < 8; ++i) { const int kk = wave + 8 * i; const float sc = t.g ? t.g[t.k0 + kk] * t.scale : t.scale; const f32x4 x = v[i] * sc;
        LAS float* p = scr + kk * WT_S + 4 * lane; p[0] = x.x; p[1] = x.y; p[2] = x.z; p[3] = x.w; }
    LDS_WAIT(); __syncthreads();
    if (!t.f8) {
#pragma unroll
        for (int j = 0; j < 4; ++j) { const int p = tid + 512 * j, c = p & 7, n = p >> 3; const LAS float* s = scr + (8 * c) * WT_S + n;
            v4u o; o.x = pk2(s[0 * WT_S], s[1 * WT_S]); o.y = pk2(s[2 * WT_S], s[3 * WT_S]); o.z = pk2(s[4 * WT_S], s[5 * WT_S]); o.w = pk2(s[6 * WT_S], s[7 * WT_S]);
            const int jn = t.n0 + n, row = t.gu ? ((jn >> 7) * 256 + (jn & 127) + (t.gu == 2 ? 128 : 0)) : jn;
            *(GAS v4u*)((bf16*)t.WT + (size_t)row * t.K + t.k0 + 8 * c) = o; }
    } else {
#pragma unroll
        for (int j = 0; j < 2; ++j) { const int p = tid + 512 * j, c = p & 3, n = p >> 2; const LAS float* s = scr + (16 * c) * WT_S + n;
            int w[4];
#pragma unroll
            for (int e = 0; e < 4; ++e) { w[e] = __builtin_amdgcn_cvt_pk_fp8_f32(s[(4 * e) * WT_S], s[(4 * e + 1) * WT_S], 0, false); w[e] = __builtin_amdgcn_cvt_pk_fp8_f32(s[(4 * e + 2) * WT_S], s[(4 * e + 3) * WT_S], w[e], true); }
            v4u o; o.x = (unsigned)w[0]; o.y = (unsigned)w[1]; o.z = (unsigned)w[2]; o.w = (unsigned)w[3];
            const int jn = t.n0 + n, row = t.gu ? ((jn >> 7) * 256 + (jn & 127) + (t.gu == 2 ? 128 : 0)) : jn;
            *(GAS v4u*)((unsigned char*)t.WT + (size_t)row * t.K + t.k0 + 16 * c) = o; }
    }
    LDS_WAIT(); __syncthreads();
}
template <int NR> __device__ __forceinline__ void rows_to_bf16_rstd(int lane, const float* xrow, size_t rstride, bf16* orow, float* rstd) {
    f32x4 v[NR][4];
#pragma unroll
    for (int r = 0; r < NR; ++r)
#pragma unroll
        for (int j = 0; j < 4; ++j) v[r][j] = ((const GAS f32x4*)(xrow + r * rstride) + lane)[64 * j];
#pragma unroll
    for (int r = 0; r < NR; ++r) { float s = 0.f;
#pragma unroll
        for (int j = 0; j < 4; ++j) s += (v[r][j].x * v[r][j].x + v[r][j].y * v[r][j].y) + (v[r][j].z * v[r][j].z + v[r][j].w * v[r][j].w);
        const float rs = 1.f / sqrtf(wave_sum(s) * (1.f / DM) + EPS); if (lane == 0) rstd[r] = rs;
        GAS unsigned long long* o8 = (GAS unsigned long long*)(orow + r * rstride) + lane;
#pragma unroll
        for (int j = 0; j < 4; ++j) o8[64 * j] = (unsigned long long)pk2(v[r][j].x, v[r][j].y) | ((unsigned long long)pk2(v[r][j].z, v[r][j].w) << 32); }
}
struct P0Args { const float *x, *norm1_g, *w_in, *sgu_w, *w_out, *norm2_g, *w_gate, *w_up, *w_down; bf16 *WinT, *WoT; unsigned char *WguQ, *WdQ; bf16 *SW, *XN; float* rstd1; };
constexpr int WT_IN = (DM / 64) * (INW / 256), WT_O = (DM / 64) * (DM / 256), WT_G = (DM / 64) * (DFF / 256), WT_D = (DFF / 64) * (DM / 256);
__device__ __forceinline__ int wset_count(int set) { return set == 0 ? WT_IN : set == 1 ? WT_O + 2 * WT_G : WT_D; }
__device__ __forceinline__ WTile wset_tile(const P0Args& a, int set, int r) {
    if (set == 0) { const int nb = INW / 256; return WTile{a.w_in, a.norm1_g, a.WinT, DM, INW, 64 * (r / nb), 256 * (r % nb), 1.0f, 0, 0}; }
    if (set == 2) { const int nb = DM / 256; return WTile{a.w_down, nullptr, a.WdQ, DFF, DM, 64 * (r / nb), 256 * (r % nb), WD_SCALE, 1, 0}; }
    if (r < WT_O) { const int nb = DM / 256; return WTile{a.w_out, nullptr, a.WoT, DM, DM, 64 * (r / nb), 256 * (r % nb), 1.0f, 0, 0}; } r -= WT_O;
    { const bool up = r >= WT_G; if (up) r -= WT_G; const int nb = DFF / 256; return WTile{up ? a.w_up : a.w_gate, a.norm2_g, a.WguQ, DM, DFF, 64 * (r / nb), 256 * (r % nb), WGU_SCALE, 1, up ? 2 : 1}; }
}
__device__ __forceinline__ void wset_convert(Frame& F, const P0Args& a, int set, int wg, int nwg) {
    LAS float* scr = (LAS float*)(F.lds + RING_OFF);
    const int cnt = wset_count(set); int r = wg; if (r >= cnt) return;
    WTile cur = wset_tile(a, set, r); f32x4 v[8], vn[8]; wtile_load(cur, F.wave, F.lane, v);
    for (;;) {
        const int rn = r + nwg; const bool more = rn < cnt; WTile nxt = cur;
        if (more) { nxt = wset_tile(a, set, rn); wtile_load(nxt, F.wave, F.lane, vn); }
        wtile_store(cur, F.tid, F.wave, F.lane, v, scr);
        if (!more) break;
#pragma unroll
        for (int i = 0; i < 8; ++i) v[i] = vn[i];
        cur = nxt; r = rn;
    }
}
__device__ __forceinline__ void p0_prologue(Frame& F, const P0Args& a) {
    const int gw = F.vcu * NWAVES + F.wave, NGW = F.G * NWAVES;
    wset_convert(F, a, 0, F.vcu, F.G);
    for (int m = 4 * gw; m < M; m += 4 * NGW) rows_to_bf16_rstd<4>(F.lane, a.x + (size_t)m * DM, DM, a.XN + (size_t)m * DM, a.rstd1 + m);
    for (int i = (F.vcu * NWAVES * 64 + F.tid); i < NH * CHUNK * CHUNK; i += F.G * NWAVES * 64) { const int t = (i / CHUNK) % CHUNK, s = i % CHUNK; a.SW[i] = (bf16)f2bf(s <= t ? a.sgu_w[i] : 0.0f); }
}

constexpr int SGU_V_BYTES = 16384, SGU_U_PITCH = 144, SGU_U_BYTES = 128 * SGU_U_PITCH, SGU_UOFF = 2 * SGU_V_BYTES;
struct SguArgs { const bf16* P; const bf16* SW; const float* sgu_b; const float* ona_g; bf16* Y; };
typedef float f32x16 __attribute__((ext_vector_type(16)));
typedef short s16x4 __attribute__((ext_vector_type(4)));
typedef unsigned u32x2 __attribute__((ext_vector_type(2)));
__device__ __forceinline__ int crow16(int r, int hi) { return (r & 3) + 8 * (r >> 2) + 4 * hi; }
struct SguStage { v4u vv[4], uu[4]; };
__device__ __forceinline__ void sgu_load(const SguArgs& a, int unit, int tid, SguStage& s) {
    const int b = unit >> 6, c = (unit >> 2) & 15, hp = unit & 3; const size_t row0 = (size_t)b * SEQ + c * CHUNK;
#pragma unroll
    for (int k = 0; k < 4; ++k) { const int i = tid + 512 * k, hl = i >> 10, row = (i >> 3) & 127, ch = i & 7;
        const bf16* src = a.P + (row0 + row) * INW + (2 * hp + hl) * 64 + ch * 8;
        s.vv[k] = *(const GAS v4u*)(src + COL_VA); s.uu[k] = *(const GAS v4u*)(src + COL_U); }
}
__device__ __forceinline__ void sgu_unit(Frame& F, const SguArgs& a, int unit, SguStage& st, int next_unit) {
    const int b = unit >> 6, c = (unit >> 2) & 15, hp = unit & 3;
    int tid_ = threadIdx.x; asm volatile("" : "+v"(tid_)); const int tid = tid_, lane = tid & 63, wid = F.wave, r32 = lane & 31, hi = lane >> 5;
    const size_t row0 = (size_t)b * SEQ + c * CHUNK;
    const int hl = wid >> 2, h = 2 * hp + hl, t0 = 32 * (wid & 3);
    const bf16* wrow = a.SW + ((size_t)h * CHUNK + t0 + r32) * CHUNK + 8 * hi;
    bf16x8 wf[8];
#pragma unroll
    for (int q = 0; q < 8; ++q) if (16 * q < t0 + 32) wf[q] = *(const GAS bf16x8*)(wrow + 16 * q);
#pragma unroll
    for (int k = 0; k < 4; ++k) { const int i = tid + 512 * k, hl2 = i >> 10, row = (i >> 3) & 127, ch = i & 7;
        *(LAS v4u*)(F.lds + RING_OFF + hl2 * SGU_V_BYTES + (ch >> 2) * 8192 + row * 64 + (ch & 3) * 16) = st.vv[k];
        *(LAS v4u*)(F.lds + RING_OFF + SGU_UOFF + hl2 * SGU_U_BYTES + row * SGU_U_PITCH + ch * 16) = st.uu[k]; }
    LDS_WAIT(); __syncthreads();
    if (next_unit >= 0) sgu_load(a, next_unit, tid, st);
    f32x16 acc[2]; acc[0] = f32x16{}; acc[1] = f32x16{};
    const LAS unsigned char* vbase = F.lds + RING_OFF + hl * SGU_V_BYTES + (8 * hi + ((lane & 15) >> 2)) * 64 + 32 * ((lane >> 4) & 1) + 8 * (lane & 3);
#pragma unroll
    for (int q = 0; q < 8; ++q) if (16 * q < t0 + 32) {
#pragma unroll
        for (int d0 = 0; d0 < 2; ++d0) {
            const s16x4 lo = __builtin_bit_cast(s16x4, __builtin_amdgcn_ds_read_tr16_b64_v4i16((LAS s16x4*)(vbase + d0 * 8192 + q * 1024)));
            const s16x4 hh = __builtin_bit_cast(s16x4, __builtin_amdgcn_ds_read_tr16_b64_v4i16((LAS s16x4*)(vbase + d0 * 8192 + q * 1024 + 256)));
            const bf16x8 vf = (bf16x8){lo[0], lo[1], lo[2], lo[3], hh[0], hh[1], hh[2], hh[3]};
            acc[d0] = __builtin_amdgcn_mfma_f32_32x32x16_bf16(vf, wf[q], acc[d0], 0, 0, 0);
        }
    }
    const float bias = a.sgu_b[h * CHUNK + t0 + r32];
    LAS unsigned char* urow = F.lds + RING_OFF + SGU_UOFF + hl * SGU_U_BYTES + (t0 + r32) * SGU_U_PITCH;
    float y[2][16]; float ss = 0.f;
#pragma unroll
    for (int d0 = 0; d0 < 2; ++d0)
#pragma unroll
        for (int g = 0; g < 4; ++g) { const u32x2 uw = *(const LAS u32x2*)(urow + (32 * d0 + 8 * g + 4 * hi) * 2);
            const float u0 = __builtin_bit_cast(float, uw.x << 16), u1 = __builtin_bit_cast(float, uw.x & 0xffff0000u), u2 = __builtin_bit_cast(float, uw.y << 16), u3 = __builtin_bit_cast(float, uw.y & 0xffff0000u);
            y[d0][4 * g + 0] = u0 * (acc[d0][4 * g + 0] + bias); y[d0][4 * g + 1] = u1 * (acc[d0][4 * g + 1] + bias); y[d0][4 * g + 2] = u2 * (acc[d0][4 * g + 2] + bias); y[d0][4 * g + 3] = u3 * (acc[d0][4 * g + 3] + bias);
            ss += (y[d0][4 * g] * y[d0][4 * g] + y[d0][4 * g + 1] * y[d0][4 * g + 1]) + (y[d0][4 * g + 2] * y[d0][4 * g + 2] + y[d0][4 * g + 3] * y[d0][4 * g + 3]); }
    ss += __shfl_xor(ss, 32);
    const float rs = __builtin_amdgcn_rsqf(ss * (1.0f / 64.0f) + EPS);
#pragma unroll
    for (int d0 = 0; d0 < 2; ++d0)
#pragma unroll
        for (int g = 0; g < 4; ++g) { const f32x4 gg = *(const GAS f32x4*)(a.ona_g + h * 64 + 32 * d0 + 8 * g + 4 * hi);
            u32x2 w; w.x = pk2(y[d0][4 * g] * rs * gg.x, y[d0][4 * g + 1] * rs * gg.y); w.y = pk2(y[d0][4 * g + 2] * rs * gg.z, y[d0][4 * g + 3] * rs * gg.w);
            *(LAS u32x2*)(urow + (32 * d0 + 8 * g + 4 * hi) * 2) = w; }
    LDS_WAIT(); asm volatile("" ::: "memory");
#pragma unroll
    for (int i = 0; i < 4; ++i) { const int row = t0 + i * 8 + (lane >> 3), ch = lane & 7;
        const v4u vv = *(const LAS v4u*)(F.lds + RING_OFF + SGU_UOFF + hl * SGU_U_BYTES + row * SGU_U_PITCH + ch * 16);
        *(GAS v4u*)(a.Y + (row0 + row) * DM + h * 64 + ch * 8) = vv; }
    LDS_WAIT(); __syncthreads();
}
struct Args { const float* in[16]; float* out; unsigned char* ws; };
__global__ void __launch_bounds__(NWAVES * 64, 2) mega_fwd(Args args) {
    extern __shared__ __attribute__((aligned(16))) unsigned char lds[];
    Frame F;
    F.lds = (LAS unsigned char*)lds;
    F.MISC = (volatile LAS unsigned*)(F.lds + MISC_OFF);
    F.tid = threadIdx.x; F.lane = F.tid & 63; F.wave = __builtin_amdgcn_readfirstlane(F.tid >> 6);
    F.G = gridDim.x; { const int bx = blockIdx.x; F.vcu = (F.G % 8 == 0) ? (bx % 8) * (F.G / 8) + bx / 8 : bx; }
    unsigned char* ws = args.ws;
    F.ctl = (gu32*)(ws + WS_CTL);
    const float* x = args.in[0]; const float* norm1_g = args.in[1]; const float* w_in = args.in[2]; const float* ln_g = args.in[3]; const float* ln_b = args.in[4];
    const float* sgu_w = args.in[5]; const float* sgu_b = args.in[6]; const float* q_g = args.in[7]; const float* k_g = args.in[8]; const float* ona_g = args.in[9]; const float* onb_g = args.in[10];
    const float* w_out = args.in[11]; const float* norm2_g = args.in[12]; const float* w_gate = args.in[13]; const float* w_up = args.in[14]; const float* w_down = args.in[15];
    float* out = args.out;
    bf16* WinT = (bf16*)(ws + WS_WIN); bf16* WoT = (bf16*)(ws + WS_WO); unsigned char* WguQ = ws + WS_WGU; unsigned char* WdQ = ws + WS_WD; unsigned char* X1Q = ws + WS_X1Q; bf16* SW = (bf16*)(ws + WS_SW);
    float* ksum = (float*)(ws + WS_KSUM); float* rowss = (float*)(ws + WS_ROWSS);
    bf16* XB = (bf16*)(ws + WS_XN); bf16* X1B = (bf16*)(ws + WS_X1B); float* rstd1 = (float*)(ws + WS_RSTD1); bf16* Yb = (bf16*)(ws + WS_Y); bf16* PROJ = (bf16*)(ws + WS_PROJ); unsigned char* HIDQ = ws + WS_PROJ;
    for (int u = F.tid; u < (PAR_OFF - LDSCTL_OFF) / 4; u += NWAVES * 64) ((LAS unsigned*)(F.lds + LDSCTL_OFF))[u] = 0u;
    { LAS float* par = (LAS float*)(F.lds + PAR_OFF);
      for (int i = F.tid; i < 1152; i += NWAVES * 64) par[i] = (i < 512) ? ln_g[i] : (i < 1024) ? ln_b[i - 512] : (i < 1088) ? q_g[i - 1024] * C2 : k_g[i - 1088]; }
    __syncthreads();
    constexpr unsigned MAGIC = 0x600DF1A6u;
    if (blockIdx.x == 0) {
        for (int i = F.tid; i < XCD_BAR_WORDS; i += NWAVES * 64) F.ctl[CW_BAR + i] = 0u;
        if (F.tid < 64) F.ctl[F.tid] = 0u;
        asm volatile("s_waitcnt vmcnt(0)" ::: "memory"); __syncthreads();
        if (F.tid == 0) { __builtin_amdgcn_fence(__ATOMIC_RELEASE, "agent"); asm volatile("s_waitcnt vmcnt(0)" ::: "memory"); __hip_atomic_store(F.ctl + CW_START, MAGIC, RLX_AGENT); }
    }
    const P0Args p0a{x, norm1_g, w_in, sgu_w, w_out, norm2_g, w_gate, w_up, w_down, WinT, WoT, WguQ, WdQ, SW, XB, rstd1};
    const bool late = (F.G == 256);

    p0_prologue(F, p0a); if (!late) { wset_convert(F, p0a, 1, F.vcu, F.G); wset_convert(F, p0a, 2, F.vcu, F.G); }
    if (blockIdx.x != 0) {
        if (F.tid == 0) { unsigned sp = 0; while (__hip_atomic_load(F.ctl + CW_START, RLX_AGENT) != MAGIC) { __builtin_amdgcn_s_sleep(2); if (++sp > (1u << 22)) break; }
            __builtin_amdgcn_fence(__ATOMIC_ACQUIRE, "agent"); asm volatile("s_waitcnt vmcnt(0)" ::: "memory"); }
        __syncthreads();
    }
    const XcdBarrier bar = xcd_barrier_post((unsigned*)(F.ctl + CW_BAR), F.MISC + 8);
    xcd_barrier(bar);

    {
        pg8::Gemm g{XB, WinT, M, INW, DM}; pg8::P1Unit U; U.init(M, INW, F.G, (int)blockIdx.x);
        U.P = PROJ; U.par = (const LAS float*)(F.lds + PAR_OFF); U.ksum = ksum; U.rp.src = rstd1; U.rp.slots = (LAS float*)(F.lds + RSL_OFF); U.rp.mul = 1.0f;
        pg8::gemm_phase<pg8::P1Unit, pg8::P1Unit, PG8_ALIGN, PG8_SP2>(F.lds + RING_OFF, g, U, U);
        if (late && blockIdx.x >= 128) wset_convert(F, p0a, 1, (int)blockIdx.x - 128, 128);
        xcd_barrier(bar);
    }

    {
        const SguArgs sa{PROJ, SW, sgu_b, ona_g, Yb};
        { SguStage sst; int u = F.vcu; if (u < BATCH * 16 * 4) sgu_load(sa, u, F.tid, sst);
          for (; u < BATCH * 16 * 4; u += F.G) { const int un = u + F.G; sgu_unit(F, sa, u, sst, un < BATCH * 16 * 4 ? un : -1); } }
        static_assert(attn_body::ATTN_LDS_BYTES <= RING_BYTES && attn_body::ATTN_PITCH == INW, "attention body geometry vs frame");
        const attn_body::AttnTensors AT{(const attn_body::bf16*)(PROJ + COL_Q), (const attn_body::bf16*)(PROJ + COL_K), (const attn_body::bf16*)(PROJ + COL_V), (attn_body::bf16*)(Yb + WA), ksum, onb_g};
        const attn_body::StaticOrder S((int)F.G, (int)blockIdx.x);
        attn_body::attn_phase<attn_body::StaticOrder>((char*)lds + RING_OFF, AT, S);
        xcd_barrier(bar);
    }

    {
        pg8::Gemm g{Yb, WoT, M, DM, DM}; pg8::StaticOrder S; S.init(M, DM, F.G, (int)blockIdx.x);
        pg8::EpiOutProj E{XB, X1B, X1Q, rowss};
        if (F.G == 256) pg8::gemm_phase<pg8::EpiOutProj, pg8::StaticOrder, false, PG8_SP2>(F.lds + RING_OFF, g, S, E);
        xcd_barrier(bar);
    }

    {
        pg8::Gemm g{(const bf16*)X1Q, (const bf16*)WguQ, M, NGU, DM / 2}; pg8::P4Unit U; U.init(M, NGU, F.G, (int)blockIdx.x);
        U.H = HIDQ; U.rp.src = rowss; U.rp.slots = (LAS float*)(F.lds + RSL_OFF); U.rp.mul = 1.0f / WGU_SCALE;
        pg8::gemm_phase<pg8::P4Unit, pg8::P4Unit, PG8_ALIGN, PG8_SP2, true>(F.lds + RING_OFF, g, U, U);
        if (late && blockIdx.x >= 128) wset_convert(F, p0a, 2, (int)blockIdx.x - 128, 128);
        xcd_barrier(bar);
    }

    {
        pg8::Gemm g{(const bf16*)HIDQ, (const bf16*)WdQ, M, DM, DFF / 2}; pg8::StaticOrder S; S.init(M, DM, F.G, (int)blockIdx.x);
        pg8::EpiDown E{X1B, out};
        pg8::gemm_phase<pg8::EpiDown, pg8::StaticOrder, PG8_ALIGN, PG8_SP2, true>(F.lds + RING_OFF, g, S, E);
    }
    asm volatile("s_waitcnt vmcnt(0)" ::: "memory"); __syncthreads();
    if (F.tid == 0) { const unsigned old = __hip_atomic_fetch_add(F.ctl + CW_EXIT, 1u, RLX_AGENT); if (old == (unsigned)F.G - 1u) __hip_atomic_store(F.ctl + CW_START, 0u, RLX_AGENT); }
}

extern "C" void kernel_launch(void* const* d_in, const int* in_sizes, int n_in, void* d_out, int out_size, void* d_ws, size_t ws_size, hipStream_t stream) {
    static int grid = 0;
    if (grid == 0) {
        if (n_in != 16 || in_sizes[0] != M * DM || out_size != M * DM || ws_size < WS_END) { fprintf(stderr, "kernel_launch: built for 16 inputs, x and out of %d floats, >= %zu bytes of workspace; got n_in %d, in0 %d, out %d, ws %zu; nothing launched\n", M * DM, (size_t)WS_END, n_in, n_in > 0 ? in_sizes[0] : -1, out_size, ws_size); grid = -1; return; }
        int dev = 0, cus = 0, per_cu = 0;
        if (hipGetDevice(&dev) != hipSuccess || hipDeviceGetAttribute(&cus, hipDeviceAttributeMultiprocessorCount, dev) != hipSuccess) { fprintf(stderr, "kernel_launch: hipGetDevice / hipDeviceGetAttribute failed; nothing launched\n"); grid = -1; return; }
        if (hipFuncSetAttribute((const void*)mega_fwd, hipFuncAttributeMaxDynamicSharedMemorySize, LDS_BYTES) != hipSuccess) { fprintf(stderr, "kernel_launch: hipFuncSetAttribute failed\n"); grid = -1; return; }
        if (hipOccupancyMaxActiveBlocksPerMultiprocessor(&per_cu, (const void*)mega_fwd, NWAVES * 64, LDS_BYTES) != hipSuccess || per_cu < 1) { fprintf(stderr, "kernel_launch: occupancy query reports %d workgroups per CU; nothing launched\n", per_cu); (void)hipGetLastError(); grid = -1; return; }
        grid = cus;
        if (grid != 256) fprintf(stderr, "kernel_launch: %d CUs; the out-proj phase needs exactly 256 workgroups\n", grid);
    }
    if (grid < 0) return;
    Args a{};
    for (int i = 0; i < 16; ++i) a.in[i] = (const float*)d_in[i];
    a.out = (float*)d_out; a.ws = (unsigned char*)d_ws;
    hipLaunchKernelGGL(mega_fwd, dim3(grid), dim3(NWAVES * 64), LDS_BYTES, stream, a);
    const hipError_t le = hipPeekAtLastError();
    if (le != hipSuccess) fprintf(stderr, "kernel_launch: launch failed: %s (grid %d x %d threads, %d B LDS)\n", hipGetErrorName(le), grid, NWAVES * 64, LDS_BYTES);
}
```

```cpp
#include <hip/hip_runtime.h>
#include <hip/hip_bf16.h>
#include <cstdio>
#include <cstdint>
#include <cmath>

constexpr int BATCH = 8, SEQ = 2048, DM = 1024, M = BATCH * SEQ;
constexpr int NH = 8, HD = 64, WA = 512, INW = 2560, CHUNK = 128, MBLK = 256, NBLK = SEQ / MBLK, DFF = 2816, NGU = 2 * DFF;
constexpr float EPS = 1e-6f;
constexpr float WGU_SCALE = 32.0f, WD_SCALE = 64.0f, WO_SCALE = 32.0f, Y_SCALE = 16.0f;
constexpr float C2 = 0.125f * 1.4426950408889634f;
constexpr int COL_U = 0, COL_VA = 512, COL_Q = 1024, COL_K = 1536, COL_V = 2048;

constexpr size_t MiB = 1u << 20;
constexpr size_t WS_CTL = 0;
constexpr size_t WS_KSUM = 512 * 1024;
constexpr size_t WS_WIN = 1 * MiB;
constexpr size_t WS_WO = 6 * MiB;
constexpr size_t WS_WGU = 8 * MiB;
constexpr size_t WS_WD = 19 * MiB;
constexpr size_t WS_SW = 25 * MiB;
constexpr size_t WS_ROWSS = 26 * MiB;
constexpr size_t WS_RSTD1 = 27 * MiB;
constexpr size_t WS_XN = 32 * MiB;
constexpr size_t WS_X1B = 200 * MiB;
constexpr size_t WS_Y = 64 * MiB;
constexpr size_t WS_PROJ = 96 * MiB;
constexpr size_t WS_X1Q = 184 * MiB;
constexpr size_t WS_END = 232 * MiB;

namespace pg8 {
#define PG8_LAS __attribute__((address_space(3)))
typedef unsigned short bf16_t;
typedef short bf16x8 __attribute__((ext_vector_type(8)));
typedef float f32x4 __attribute__((ext_vector_type(4)));
typedef unsigned u32x4 __attribute__((ext_vector_type(4)));
typedef int v4i_t __attribute__((ext_vector_type(4)));
typedef unsigned u32x2 __attribute__((ext_vector_type(2)));
constexpr int BM = 256, BK = 64, HALF = 128, HTB = HALF * BK * 2  , STAGE_BYTES = 8 * HTB, NXCD = 8, WGM = 8;

__host__ __device__ __forceinline__ int lds_byte(int r, int c) { const int st = (r >> 4) * 2 + (c >> 5), rr = r & 15, cc = c & 31, ob = rr * 64 + cc * 2; return st * 1024 + (ob ^ (((ob >> 9) & 1) << 5)); }
__host__ __device__ __forceinline__ void stage_rc(int b, int& R, int& C) { const int st = b / 1024, sb = b % 1024, swz = sb ^ (((sb >> 9) & 1) << 5); R = (st >> 1) * 16 + swz / 64; C = (st & 1) * 32 + (swz % 64) / 2; }
__host__ __device__ __forceinline__ int perm32(int rho) { const int n = rho >> 4, i = rho & 15; return 8 * (i >> 2) + 4 * n + (i & 3); }

struct Unit { int pm, pn; };
struct Gemm { const bf16_t* A; const bf16_t* Bt; int M, N, K; };

struct StaticOrder {
    int nM, nN, nwg, G, c;
    __host__ __device__ void init(int M, int N, int G_, int c_) { nM = M / BM; nN = N / BM; nwg = nM * nN; G = G_; c = c_; }
    __host__ __device__ bool next(int i, Unit& u) const {
        const long L = (long)i * G + c; if (L >= nwg) return false;
        int wgid = (int)L; { const int q = nwg / NXCD, r = nwg % NXCD, xcd = wgid % NXCD, off = wgid / NXCD; wgid = (xcd < r ? xcd * (q + 1) : r * (q + 1) + (xcd - r) * q) + off; }
        const int nig = WGM * nN, gid = wgid / nig, fm = gid * WGM, gsz = (nM - fm) < WGM ? (nM - fm) : WGM;
        u.pm = fm + ((wgid % nig) % gsz); u.pn = (wgid % nig) / gsz; return true;
    }
    __device__ __forceinline__ void a_ready(const Unit&) const {}
    __device__ __forceinline__ void done(const Unit&) const {}
};

struct RowScalePrefetch {
    const float* src; PG8_LAS float* slots; float mul; mutable float pend = 0.f; mutable int nready = 0, ndone = 0, have = 0;
    template <int MODE> __device__ __forceinline__ void fetch(const Unit& u) const {
        int t = threadIdx.x; asm volatile("" : "+v"(t));
        if (t < 256) { const int row = u.pm * BM + t;
            if (MODE == 0) pend = src[row]; else { const f32x4 r4 = *(const f32x4*)(src + (size_t)row * 4); pend = __builtin_amdgcn_rsqf(((r4[0] + r4[1]) + (r4[2] + r4[3])) * (1.0f / 1024.0f) + 1e-6f) * mul; }
            if (nready == 0) slots[t] = pend; }
        have = (nready != 0); ++nready;
    }
    __device__ __forceinline__ void flush() const {
        if (have) { int t = threadIdx.x; asm volatile("" : "+v"(t)); if (t < 256) slots[((ndone + 1) & 1) * 256 + t] = pend; have = 0; }
    }
    __device__ __forceinline__ const PG8_LAS float* cur() const { return slots + (ndone & 1) * 256; }
};
__device__ __forceinline__ unsigned cvt_pk_bf16(float lo, float hi) { unsigned r; asm volatile("v_cvt_pk_bf16_f32 %0, %1, %2" : "=v"(r) : "v"(lo), "v"(hi)); return r; }
__device__ __forceinline__ float gelu_tanh_f(float x) {
    const float t = x * (-2.3022082f + -0.10294324f * (x * x));
    return x * __builtin_amdgcn_rcpf(1.0f + __builtin_amdgcn_exp2f(t));
}
__device__ __forceinline__ float gelu_tanh_rs(float a, float K0, float K1, float c) { const float t = a * __builtin_fmaf(a * a, K1, K0); return a * __builtin_amdgcn_rcpf(__builtin_fmaf(__builtin_amdgcn_exp2f(t), c, c)); }
__device__ __forceinline__ float silu_f(float x) { return x * __builtin_amdgcn_rcpf(1.0f + __builtin_amdgcn_exp2f(-1.4426950408889634f * x)); }
__device__ __forceinline__ float hsum4(const f32x4 v) { return (v[0] + v[1]) + (v[2] + v[3]); }
__device__ __forceinline__ float hsq4(const f32x4 v) { return (v[0] * v[0] + v[1] * v[1]) + (v[2] * v[2] + v[3] * v[3]); }
__device__ __forceinline__ float quad_sum(float s) {
    auto a = __builtin_amdgcn_permlane16_swap(__float_as_uint(s), __float_as_uint(s), false, false); s = __uint_as_float(a[0]) + __uint_as_float(a[1]);
    auto b = __builtin_amdgcn_permlane32_swap(__float_as_uint(s), __float_as_uint(s), false, false); return __uint_as_float(b[0]) + __uint_as_float(b[1]); }
__device__ __forceinline__ u32x2 pack8_f8(const f32x4 a, const f32x4 b) {
    int lo = __builtin_amdgcn_cvt_pk_fp8_f32(a[0], a[1], 0, false); lo = __builtin_amdgcn_cvt_pk_fp8_f32(a[2], a[3], lo, true);
    int hi = __builtin_amdgcn_cvt_pk_fp8_f32(b[0], b[1], 0, false); hi = __builtin_amdgcn_cvt_pk_fp8_f32(b[2], b[3], hi, true);
    u32x2 w; w.x = (unsigned)lo; w.y = (unsigned)hi; return w; }
__device__ __forceinline__ u32x4 pack8(const f32x4 a, const f32x4 b) { u32x4 w; w.x = cvt_pk_bf16(a[0], a[1]); w.y = cvt_pk_bf16(a[2], a[3]); w.z = cvt_pk_bf16(b[0], b[1]); w.w = cvt_pk_bf16(b[2], b[3]); return w; }

struct EpiInProj {
    static constexpr bool PERM = true, AFTER_DRAIN = false; static constexpr int BMAP = 1;
    bf16_t* P; const PG8_LAS float* par; float* ksum; RowScalePrefetch rp;
    __device__ __forceinline__ void operator()(const f32x4 (&acc)[2][2][4][2], const Unit& u, int wr, int wc, int fr, int fq) const {
        asm volatile("" : "+v"(fr), "+v"(fq));
        const int seg = u.pn >> 1, h = (u.pn & 1) * 4 + wc, dl = 8 * fq;
        bf16_t* base = P + (size_t)(u.pm * BM + wr * 64 + fr) * INW + u.pn * BM + wc * 64 + dl;
        float rs1[2][4];
#pragma unroll
        for (int ai = 0; ai < 2; ++ai)
#pragma unroll
            for (int m = 0; m < 4; ++m) rs1[ai][m] = rp.cur()[wr * 64 + fr + ai * HALF + m * 16];
        rp.flush(); ++rp.ndone;
        if (seg == 0) {
#pragma unroll
            for (int ai = 0; ai < 2; ++ai)
#pragma unroll
                for (int m = 0; m < 4; ++m)
#pragma unroll
                    for (int bj = 0; bj < 2; ++bj) { f32x4 a = acc[ai][bj][m][0], b = acc[ai][bj][m][1]; const float r_ = rs1[ai][m], K0_ = -2.3022082f * r_, K1_ = -0.10294324f * (r_ * r_ * r_), c_ = __builtin_amdgcn_rcpf(r_);
#pragma unroll
                        for (int e = 0; e < 4; ++e) { a[e] = gelu_tanh_rs(a[e], K0_, K1_, c_); b[e] = gelu_tanh_rs(b[e], K0_, K1_, c_); }
                        *(u32x4*)(base + (size_t)(ai * HALF + m * 16) * INW + 32 * bj) = pack8(a, b); }
        } else if (seg == 1) {
            const PG8_LAS float* lg = par + h * 64 + dl; const PG8_LAS float* lb = par + 512 + h * 64 + dl;
#pragma unroll
            for (int ai = 0; ai < 2; ++ai)
#pragma unroll
                for (int m = 0; m < 4; ++m) { f32x4 g[2][2]; float s = 0.f; const float r_ = rs1[ai][m], K0_ = -2.3022082f * r_, K1_ = -0.10294324f * (r_ * r_ * r_), c_ = __builtin_amdgcn_rcpf(r_);
#pragma unroll
                    for (int bj = 0; bj < 2; ++bj)
#pragma unroll
                        for (int n = 0; n < 2; ++n) { const f32x4 a = acc[ai][bj][m][n];
#pragma unroll
                            for (int e = 0; e < 4; ++e) g[bj][n][e] = gelu_tanh_rs(a[e], K0_, K1_, c_);
                            s += hsum4(g[bj][n]); }
                    const float mean = quad_sum(s) * (1.0f / 64.0f); float q = 0.f;
#pragma unroll
                    for (int bj = 0; bj < 2; ++bj)
#pragma unroll
                        for (int n = 0; n < 2; ++n) { g[bj][n] = g[bj][n] - mean; q += hsq4(g[bj][n]); }
                    const float rstd = __builtin_amdgcn_rsqf(quad_sum(q) * (1.0f / 64.0f) + EPS);
#pragma unroll
                    for (int bj = 0; bj < 2; ++bj) { const f32x4 G0 = *(const PG8_LAS f32x4*)(lg + 32 * bj), G1 = *(const PG8_LAS f32x4*)(lg + 32 * bj + 4), B0 = *(const PG8_LAS f32x4*)(lb + 32 * bj), B1 = *(const PG8_LAS f32x4*)(lb + 32 * bj + 4);
                        *(u32x4*)(base + (size_t)(ai * HALF + m * 16) * INW + 32 * bj) = pack8(g[bj][0] * rstd * G0 + B0, g[bj][1] * rstd * G1 + B1); }
                    asm volatile("" ::: "memory"); __builtin_amdgcn_sched_barrier(0); }
        } else if (seg == 2 || seg == 3) {
            const PG8_LAS float* gp = par + ((seg == 2) ? 1024 : 1088) + dl;
            f32x4 cs[2][2];
#pragma unroll
            for (int bj = 0; bj < 2; ++bj)
#pragma unroll
                for (int n = 0; n < 2; ++n) cs[bj][n] = (f32x4){0.f, 0.f, 0.f, 0.f};
#pragma unroll
            for (int ai = 0; ai < 2; ++ai)
#pragma unroll
                for (int m = 0; m < 4; ++m) { float q = 0.f;
#pragma unroll
                    for (int bj = 0; bj < 2; ++bj)
#pragma unroll
                        for (int n = 0; n < 2; ++n) q += hsq4(acc[ai][bj][m][n]);
                    const float rstd = rs1[ai][m] * __builtin_amdgcn_rsqf(quad_sum(q) * (1.0f / 64.0f) * (rs1[ai][m] * rs1[ai][m]) + EPS);
#pragma unroll
                    for (int bj = 0; bj < 2; ++bj) { const f32x4 o0 = acc[ai][bj][m][0] * rstd * *(const PG8_LAS f32x4*)(gp + 32 * bj), o1 = acc[ai][bj][m][1] * rstd * *(const PG8_LAS f32x4*)(gp + 32 * bj + 4);
                        cs[bj][0] += o0; cs[bj][1] += o1;
                        *(u32x4*)(base + (size_t)(ai * HALF + m * 16) * INW + 32 * bj) = pack8(o0, o1); }
                    asm volatile("" : "+v"(cs[0][0]), "+v"(cs[0][1]), "+v"(cs[1][0]), "+v"(cs[1][1]));
                    asm volatile("" ::: "memory"); __builtin_amdgcn_sched_barrier(0); }
            if (seg == 3) {
#pragma unroll
                for (int bj = 0; bj < 2; ++bj)
#pragma unroll
                    for (int n = 0; n < 2; ++n) { f32x4 v = cs[bj][n];
#pragma unroll
                        for (int e = 0; e < 4; ++e) { float t = v[e]; t += __shfl_xor(t, 1); t += __shfl_xor(t, 2); t += __shfl_xor(t, 4); t += __shfl_xor(t, 8); v[e] = t; }
                        if (fr == 0) *(f32x4*)(ksum + (((size_t)u.pm * 2 + wr) * NH + h) * 64 + 32 * bj + dl + 4 * n) = v; }
            }
        } else {
#pragma unroll
            for (int ai = 0; ai < 2; ++ai)
#pragma unroll
                for (int m = 0; m < 4; ++m)
#pragma unroll
                    for (int bj = 0; bj < 2; ++bj) *(u32x4*)(base + (size_t)(ai * HALF + m * 16) * INW + 32 * bj) = pack8(acc[ai][bj][m][0] * rs1[ai][m], acc[ai][bj][m][1] * rs1[ai][m]);
        }
    }
};

struct EpiOutProj {
    static constexpr bool PERM = true, AFTER_DRAIN = true; static constexpr int BMAP = 0;
    const bf16_t* xb; bf16_t* x1b; unsigned char* x1q; float* rowss;
    __device__ __forceinline__ void operator()(const f32x4 (&)[2][2][4][2], const Unit&, int, int, int, int) const {}
    __device__ __forceinline__ void fused(f32x4 (&acc)[2][2][4][2], const Unit& u, int wr, int wc, int fr, int fq, PG8_LAS unsigned char* lds, int wid, int lane) const {
        PG8_LAS float* Pl = (PG8_LAS float*)lds;
        const int col0 = u.pn * BM + wc * 32 + 8 * fq;
#pragma unroll
        for (int ai = 0; ai < 2; ++ai)
#pragma unroll
            for (int m = 0; m < 4; ++m) { const int rt = ai * HALF + wr * 64 + m * 16 + fr; const size_t off = (size_t)(u.pm * BM + rt) * DM + col0; float s = 0.f;
#pragma unroll
                for (int bj = 0; bj < 2; ++bj) { const u32x4 w = *(const u32x4*)(xb + off + bj * HALF);
                    const f32x4 v0 = acc[ai][bj][m][0] * (1.0f / (WO_SCALE * Y_SCALE)) + (f32x4){__builtin_bit_cast(float, w.x << 16), __builtin_bit_cast(float, w.x & 0xffff0000u), __builtin_bit_cast(float, w.y << 16), __builtin_bit_cast(float, w.y & 0xffff0000u)};
                    const f32x4 v1 = acc[ai][bj][m][1] * (1.0f / (WO_SCALE * Y_SCALE)) + (f32x4){__builtin_bit_cast(float, w.z << 16), __builtin_bit_cast(float, w.z & 0xffff0000u), __builtin_bit_cast(float, w.w << 16), __builtin_bit_cast(float, w.w & 0xffff0000u)};
                    *(u32x4*)(x1b + off + bj * HALF) = pack8(v0, v1); *(u32x2*)(x1q + off + bj * HALF) = pack8_f8(v0, v1); s += hsq4(v0) + hsq4(v1); }
                s = quad_sum(s); if (fq == 0) Pl[rt * 4 + wc] = s;
                if (m & 1) asm volatile("" ::: "memory"); }
        asm volatile("s_waitcnt lgkmcnt(0)" ::: "memory"); __builtin_amdgcn_s_barrier(); asm volatile("" ::: "memory");
        const int t = wid * 64 + lane;
        if (t < 256) rowss[(size_t)(u.pm * BM + t) * 4 + u.pn] = (Pl[t * 4 + 0] + Pl[t * 4 + 1]) + (Pl[t * 4 + 2] + Pl[t * 4 + 3]);
    }
};

struct EpiGateUp {
    static constexpr bool PERM = true, AFTER_DRAIN = false; static constexpr int BMAP = 0;
    unsigned char* H; RowScalePrefetch rp;
    __device__ __forceinline__ void operator()(const f32x4 (&acc)[2][2][4][2], const Unit& u, int wr, int wc, int fr, int fq) const {
        const int row0 = u.pm * BM + wr * 64 + fr, col0 = u.pn * HALF + wc * 32 + 8 * fq;
        float rs2[2][4], k1[2][4];
#pragma unroll
        for (int ai = 0; ai < 2; ++ai)
#pragma unroll
            for (int m = 0; m < 4; ++m) { const float rs = rp.cur()[wr * 64 + fr + ai * HALF + m * 16]; rs2[ai][m] = __builtin_amdgcn_rcpf(rs * rs); k1[ai][m] = -1.4426950408889634f * rs; }
        rp.flush(); ++rp.ndone;
#pragma unroll
        for (int ai = 0; ai < 2; ++ai)
#pragma unroll
            for (int m = 0; m < 4; ++m) { const int row = row0 + ai * HALF + m * 16;
                f32x4 a = acc[ai][0][m][0], b = acc[ai][0][m][1]; const f32x4 ua = acc[ai][1][m][0], ub = acc[ai][1][m][1];
#pragma unroll
                for (int e = 0; e < 4; ++e) {
                    a[e] = (a[e] * ua[e]) * __builtin_amdgcn_rcpf(__builtin_fmaf(__builtin_amdgcn_exp2f(a[e] * k1[ai][m]), rs2[ai][m], rs2[ai][m]));
                    b[e] = (b[e] * ub[e]) * __builtin_amdgcn_rcpf(__builtin_fmaf(__builtin_amdgcn_exp2f(b[e] * k1[ai][m]), rs2[ai][m], rs2[ai][m])); }
                *(u32x2*)(H + (size_t)row * DFF + col0) = pack8_f8(a, b); }
    }
};

struct EpiDown {
    static constexpr bool PERM = true, AFTER_DRAIN = true; static constexpr int BMAP = 0;
    const bf16_t* x1b; float* out;
    __device__ __forceinline__ void operator()(const f32x4 (&)[2][2][4][2], const Unit&, int, int, int, int) const {}
    __device__ __forceinline__ void fused(f32x4 (&acc)[2][2][4][2], const Unit& u, int wr, int wc, int fr, int fq, PG8_LAS unsigned char* lds, int wid, int lane) const {
        constexpr int PITCH = 272;
        PG8_LAS unsigned char* st = lds + wid * (16 * PITCH);
        const int seg = lane >> 3, ch = lane & 7;
#pragma unroll
        for (int ai = 0; ai < 2; ++ai) {
            u32x2 xw[4][4];
#pragma unroll
            for (int m = 0; m < 4; ++m)
#pragma unroll
                for (int j = 0; j < 4; ++j) { const int sg = seg + 8 * j, r = sg >> 1, h = sg & 1;
                    xw[m][j] = *(const u32x2*)(x1b + (size_t)(u.pm * BM + ai * HALF + wr * 64 + m * 16 + r) * DM + u.pn * BM + h * HALF + wc * 32 + ch * 4); }
#pragma unroll
            for (int m = 0; m < 4; ++m) {
#pragma unroll
                for (int bj = 0; bj < 2; ++bj) { *(PG8_LAS f32x4*)(st + fr * PITCH + bj * 128 + 32 * fq) = acc[ai][bj][m][0] * (1.0f / WD_SCALE); *(PG8_LAS f32x4*)(st + fr * PITCH + bj * 128 + 32 * fq + 16) = acc[ai][bj][m][1] * (1.0f / WD_SCALE); }
                asm volatile("s_waitcnt lgkmcnt(0)" ::: "memory");
                const int rowb = u.pm * BM + ai * HALF + wr * 64 + m * 16;
#pragma unroll
                for (int j = 0; j < 4; ++j) { const int sg = seg + 8 * j, r = sg >> 1, h = sg & 1;
                    const f32x4 a = *(const PG8_LAS f32x4*)(st + r * PITCH + h * 128 + ch * 16);
                    const size_t off = (size_t)(rowb + r) * DM + u.pn * BM + h * HALF + wc * 32 + ch * 4;
                    const u32x2 w = xw[m][j];
                    const f32x4 x = {__builtin_bit_cast(float, w.x << 16), __builtin_bit_cast(float, w.x & 0xffff0000u), __builtin_bit_cast(float, w.y << 16), __builtin_bit_cast(float, w.y & 0xffff0000u)};
                    *(f32x4*)(out + off) = x + a; }
                asm volatile("s_waitcnt lgkmcnt(0)" ::: "memory"); }
        }
    }
};

struct P1Unit : StaticOrder, EpiInProj {
    __device__ __forceinline__ bool next(int i, Unit& u) const { if (!StaticOrder::next(i, u)) return false; u.pn = (int)((0x1076983254ull >> (4 * u.pn)) & 15u); return true; }
    __device__ __forceinline__ void a_ready(const Unit& u) const { rp.fetch<0>(u); }
};
struct P4Unit : StaticOrder, EpiGateUp { __device__ __forceinline__ void a_ready(const Unit& u) const { rp.fetch<1>(u); } };

template <class Epi, class Sched, bool ALIGN_EPI = false, bool SP2 = false, bool F8 = false>
__device__ __forceinline__ void gemm_phase(PG8_LAS unsigned char* lds, const Gemm g, const Sched& S, const Epi& E) {
    int tid_ = threadIdx.x; asm volatile("" : "+v"(tid_));
    const int tid = tid_, wid = __builtin_amdgcn_readfirstlane(tid >> 6), lane = tid & 63, wr = wid >> 2, wc = wid & 3, fr = lane & 15, fq = lane >> 4;
    const int K = g.K, nt = K / BK;
    unsigned voffA[2], voffB[2];
#pragma unroll
    for (int i = 0; i < 2; ++i) { int R, C; stage_rc(tid * 16 + i * 8192, R, C); int Rb = Epi::PERM ? ((R & ~31) + perm32(R & 31)) : R;
        if (Epi::BMAP == 1) Rb = 64 * (R >> 5) + (Rb & 31);
        voffA[i] = (unsigned)(R * K + C) * 2u; voffB[i] = (unsigned)(Rb * K + C) * 2u; }
    const size_t kstep = (size_t)(BK * 2);
    const size_t hstep = (size_t)HALF * K * 2;
    const size_t hstepB = (size_t)(Epi::BMAP == 1 ? 32 : HALF) * K * 2;
    const size_t tstep = 2 * hstep;
    const unsigned ldsw = (unsigned)wid * 1024u;
    const int aoff = lds_byte(wr * 64 + fr, fq * 8), boff = lds_byte(wc * 32 + fr, fq * 8);
#define PG8_SA(b, h) (((b) * 2 + (h)) * HTB)
#define PG8_SB(b, h) ((4 + (b) * 2 + (h)) * HTB)
#define PG8_STAGE(bufoff, gbase, voff) do { _Pragma("unroll") for (int _i = 0; _i < 2; ++_i) \
        __builtin_amdgcn_global_load_lds((const unsigned*)((const char*)(gbase) + (voff)[_i]), (PG8_LAS unsigned*)(lds + (bufoff) + ldsw + _i * 8192), 16, 0, 0); } while (0)
#define PG8_LDA(dst, b, h) do { _Pragma("unroll") for (int m = 0; m < 4; ++m) _Pragma("unroll") for (int k = 0; k < 2; ++k) dst[m][k] = *(const PG8_LAS bf16x8*)(lds + PG8_SA(b, h) + aoff + m * 2048 + k * 1024); } while (0)
#define PG8_LDB(dst, b, h) do { _Pragma("unroll") for (int n = 0; n < 2; ++n) _Pragma("unroll") for (int k = 0; k < 2; ++k) dst[n][k] = *(const PG8_LAS bf16x8*)(lds + PG8_SB(b, h) + boff + n * 2048 + k * 1024); } while (0)
#define PG8_CAT(x) __builtin_shufflevector(__builtin_bit_cast(v4i_t, x[0]), __builtin_bit_cast(v4i_t, x[1]), 0, 1, 2, 3, 4, 5, 6, 7)
#define PG8_MMA(ai, bj, At, Bt) do { __builtin_amdgcn_s_setprio(1); _Pragma("unroll") for (int m = 0; m < 4; ++m) _Pragma("unroll") for (int n = 0; n < 2; ++n) { \
        if constexpr (F8) asm volatile("v_mfma_f32_16x16x128_f8f6f4 %0, %1, %2, %0" : "+v"(acc[ai][bj][m][n]) : "v"(PG8_CAT(Bt[n])), "v"(PG8_CAT(At[m])));       \
        else { _Pragma("unroll") for (int k = 0; k < 2; ++k) acc[ai][bj][m][n] = __builtin_amdgcn_mfma_f32_16x16x32_bf16(Bt[n][k], At[m][k], acc[ai][bj][m][n], 0, 0, 0); } } __builtin_amdgcn_s_setprio(0); } while (0)
#define PG8_WAIT_V(n) asm volatile("s_waitcnt vmcnt(" #n ")" ::: "memory")
#define PG8_WAIT_L(n) asm volatile("s_waitcnt lgkmcnt(" #n ")" ::: "memory")
#define PG8_BAR __builtin_amdgcn_s_barrier()
#define PG8_SCHED __builtin_amdgcn_sched_barrier(0)
#define PG8_PIN_ACC(txt) do { _Pragma("unroll") for (int a_ = 0; a_ < 2; ++a_) _Pragma("unroll") for (int b_ = 0; b_ < 2; ++b_) \
        asm volatile(txt : "+v"(acc[a_][b_][0][0]), "+v"(acc[a_][b_][0][1]), "+v"(acc[a_][b_][1][0]), "+v"(acc[a_][b_][1][1]), "+v"(acc[a_][b_][2][0]), "+v"(acc[a_][b_][2][1]), "+v"(acc[a_][b_][3][0]), "+v"(acc[a_][b_][3][1])); } while (0)
    Unit cur, nxt; int ui = 0;
    if (!S.next(0, cur)) return;
    f32x4 acc[2][2][4][2];
#pragma unroll
    for (int a = 0; a < 2; ++a)
#pragma unroll
        for (int b = 0; b < 2; ++b)
#pragma unroll
            for (int m = 0; m < 4; ++m)
#pragma unroll
                for (int n = 0; n < 2; ++n) acc[a][b][m][n] = (f32x4){0.f, 0.f, 0.f, 0.f};
    if constexpr (F8) PG8_PIN_ACC("");
    bf16x8 At[4][2], B0[2][2], B1[2][2];
    const char* cA = (const char*)g.A + (size_t)cur.pm * tstep; const char* cB = (const char*)g.Bt + (size_t)cur.pn * tstep;
    S.a_ready(cur);
    if constexpr (SP2) {
        PG8_STAGE(PG8_SB(0, 0), cB, voffB); PG8_STAGE(PG8_SB(0, 1), cB + hstepB, voffB); PG8_STAGE(PG8_SA(0, 0), cA, voffA); PG8_STAGE(PG8_SA(0, 1), cA + hstep, voffA);
        if (wr == 1) PG8_BAR;
        PG8_WAIT_V(2); PG8_BAR;
        PG8_STAGE(PG8_SB(1, 0), cB + kstep, voffB); PG8_STAGE(PG8_SA(1, 0), cA + kstep, voffA); PG8_STAGE(PG8_SB(1, 1), cB + hstepB + kstep, voffB);
        PG8_WAIT_V(6); PG8_BAR;
    } else {
        PG8_STAGE(PG8_SB(0, 0), cB, voffB); PG8_STAGE(PG8_SA(0, 0), cA, voffA); PG8_STAGE(PG8_SB(0, 1), cB + hstepB, voffB); PG8_STAGE(PG8_SA(0, 1), cA + hstep, voffA);
        if (wr == 1) PG8_BAR;
        PG8_WAIT_V(4); PG8_BAR;
        PG8_STAGE(PG8_SB(1, 0), cB + kstep, voffB); PG8_STAGE(PG8_SA(1, 0), cA + kstep, voffA); PG8_STAGE(PG8_SB(1, 1), cB + hstepB + kstep, voffB);
        PG8_WAIT_V(6); PG8_BAR;
    }
    for (;;) {
        const bool has_next = S.next(ui + 1, nxt);
        const char* nA = has_next ? (const char*)g.A + (size_t)nxt.pm * tstep : cA; const char* nB = has_next ? (const char*)g.Bt + (size_t)nxt.pn * tstep : cB;
        for (int t = 0; t < nt; t += 2) {
            const bool last = (t == nt - 2);
            const char* a1 = cA + (size_t)(t + 1) * kstep;
            const char* a2 = last ? nA : cA + (size_t)(t + 2) * kstep; const char* b2 = last ? nB : cB + (size_t)(t + 2) * kstep;
            const char* a3 = a2 + kstep; const char* b3 = b2 + kstep;
            if (last && has_next) S.a_ready(nxt);
            if constexpr (SP2) {
            PG8_LDB(B0, 0, 0); PG8_LDB(B1, 0, 1); PG8_SCHED; PG8_LDA(At, 0, 0); PG8_STAGE(PG8_SA(1, 1), a1 + hstep, voffA);
            PG8_WAIT_V(8); PG8_WAIT_L(0); PG8_BAR; PG8_MMA(0, 0, At, B0); PG8_MMA(0, 1, At, B1); PG8_BAR; PG8_SCHED;
            PG8_LDA(At, 0, 1); PG8_STAGE(PG8_SB(0, 0), b2, voffB); PG8_STAGE(PG8_SB(0, 1), b2 + hstepB, voffB); PG8_STAGE(PG8_SA(0, 0), a2, voffA);
            PG8_WAIT_V(8); PG8_WAIT_L(0); PG8_BAR; PG8_MMA(1, 0, At, B0); PG8_MMA(1, 1, At, B1); PG8_BAR; PG8_SCHED;
            PG8_LDB(B0, 1, 0); PG8_LDB(B1, 1, 1); PG8_SCHED; PG8_LDA(At, 1, 0); PG8_STAGE(PG8_SA(0, 1), a2 + hstep, voffA);
            PG8_WAIT_V(8); PG8_WAIT_L(0); PG8_BAR; PG8_MMA(0, 0, At, B0); PG8_MMA(0, 1, At, B1); PG8_BAR; PG8_SCHED;
            PG8_LDA(At, 1, 1); PG8_STAGE(PG8_SB(1, 0), b3, voffB); PG8_STAGE(PG8_SB(1, 1), b3 + hstepB, voffB); PG8_STAGE(PG8_SA(1, 0), a3, voffA);
            PG8_WAIT_V(8); PG8_WAIT_L(0); PG8_BAR; PG8_MMA(1, 0, At, B0); PG8_MMA(1, 1, At, B1); PG8_BAR; PG8_SCHED;
            } else {
            PG8_LDB(B0, 0, 0); PG8_SCHED; PG8_LDA(At, 0, 0); PG8_STAGE(PG8_SA(1, 1), a1 + hstep, voffA);
            PG8_WAIT_L(8); PG8_BAR; PG8_WAIT_L(0); PG8_MMA(0, 0, At, B0); PG8_BAR; PG8_SCHED;
            PG8_LDB(B1, 0, 1); PG8_STAGE(PG8_SB(0, 0), b2, voffB);
            PG8_BAR; PG8_WAIT_L(0); PG8_MMA(0, 1, At, B1); PG8_BAR;
            PG8_LDA(At, 0, 1); PG8_STAGE(PG8_SA(0, 0), a2, voffA);
            PG8_BAR; PG8_WAIT_L(0); PG8_MMA(1, 0, At, B0); PG8_BAR; PG8_SCHED;
            PG8_STAGE(PG8_SB(0, 1), b2 + hstepB, voffB);
            PG8_WAIT_V(6); PG8_BAR; PG8_MMA(1, 1, At, B1); PG8_BAR;
            PG8_LDB(B0, 1, 0); PG8_SCHED; PG8_LDA(At, 1, 0); PG8_STAGE(PG8_SA(0, 1), a2 + hstep, voffA);
            PG8_WAIT_L(8); PG8_BAR; PG8_WAIT_L(0); PG8_MMA(0, 0, At, B0); PG8_BAR; PG8_SCHED;
            PG8_LDB(B1, 1, 1); PG8_STAGE(PG8_SB(1, 0), b3, voffB);
            PG8_BAR; PG8_WAIT_L(0); PG8_MMA(0, 1, At, B1); PG8_BAR;
            PG8_LDA(At, 1, 1); PG8_STAGE(PG8_SA(1, 0), a3, voffA);
            PG8_BAR; PG8_WAIT_L(0); PG8_MMA(1, 0, At, B0); PG8_BAR; PG8_SCHED;
            PG8_STAGE(PG8_SB(1, 1), b3 + hstepB, voffB);
            PG8_WAIT_V(6); PG8_BAR; PG8_MMA(1, 1, At, B1); PG8_BAR;
            }
        }
        if constexpr (F8) PG8_PIN_ACC("s_nop 15");
        if constexpr (ALIGN_EPI) { if (wr == 0) PG8_BAR; }
        if constexpr (!Epi::AFTER_DRAIN) { E(acc, cur, wr, wc, fr, fq); S.done(cur); }
        if (!has_next) break;
#pragma unroll
        for (int a = 0; a < 2; ++a)
#pragma unroll
            for (int b = 0; b < 2; ++b)
#pragma unroll
                for (int m = 0; m < 4; ++m)
#pragma unroll
                    for (int n = 0; n < 2; ++n) acc[a][b][m][n] = (f32x4){0.f, 0.f, 0.f, 0.f};
        if constexpr (F8) PG8_PIN_ACC("");
        cur = nxt; cA = nA; cB = nB; ++ui;
        if constexpr (ALIGN_EPI) { if (wr == 1) PG8_BAR; }
    }
    PG8_WAIT_V(0);
    if constexpr (!ALIGN_EPI) { if (wr == 0) PG8_BAR; }
    PG8_BAR;
    if constexpr (Epi::AFTER_DRAIN) { E.fused(acc, cur, wr, wc, fr, fq, lds, wid, lane); S.done(cur); }
#undef PG8_SA
#undef PG8_SB
#undef PG8_STAGE
#undef PG8_LDA
#undef PG8_LDB
#undef PG8_MMA
#undef PG8_CAT
#undef PG8_PIN_ACC
#undef PG8_WAIT_V
#undef PG8_WAIT_L
#undef PG8_BAR
#undef PG8_SCHED
}
}

#ifndef PG8_SP2
#define PG8_SP2 true
#endif
#ifndef PG8_ALIGN
#define PG8_ALIGN true
#endif

namespace attn_body {
using bf16=__hip_bfloat16;
using bf16x8=__attribute__((ext_vector_type(8)))short;
using s16x4=__attribute__((ext_vector_type(4)))short;
using f32x16=__attribute__((ext_vector_type(16)))float;
using u32x4=__attribute__((ext_vector_type(4)))unsigned;
constexpr int BATCH=8,NHEAD=8,SEQ=2048,D=64,DM=2560,YP=1024;
constexpr int NW=8,QBLK=32,QB=QBLK*NW,KVBLK=64,NQB=SEQ/QB;
constexpr int ATTN_PITCH=DM, ATTN_UNIT_ROWS=QB;
__device__ __forceinline__ int crow(int r,int hi){return (r&3)+8*(r>>2)+4*hi;}
#define SBAR() __builtin_amdgcn_sched_barrier(0)
__device__ __forceinline__ void cmask(f32x16&p0,f32x16&p1,int jb,int qrel,int hi){
  const float NEG=-INFINITY; int kb=64*jb+4*hi;
  #pragma unroll
  for(int r=0;r<16;++r){int kv=kb+(r&3)+8*(r>>2); if(kv>qrel)p0[r]=NEG; if(kv+32>qrel)p1[r]=NEG;}
}

constexpr int NSLOT=3, SLOTB=8192;
constexpr int LDS_K=0, LDS_V=NSLOT*SLOTB, LDS_WS=2*NSLOT*SLOTB, LDS_OST=LDS_WS+NW*64*4, LDS_BYTES=LDS_OST+NW*8192;
constexpr float YSC=16.0f;
constexpr float C2=0.125f*1.4426950408889634f;
__device__ __forceinline__ void glds16(const void*gsrc,unsigned lds_dst){unsigned keep;
  asm volatile("s_mov_b32 %0, m0\n\ts_mov_b32 m0, %2\n\ts_nop 0\n\tglobal_load_lds_dwordx4 %1, off\n\ts_mov_b32 m0, %0":"=&s"(keep):"v"(gsrc),"s"(lds_dst):"memory");}
__device__ __forceinline__ float max3f(float a,float b,float c){float r;asm("v_max3_f32 %0, %1, %2, %3":"=v"(r):"v"(a),"v"(b),"v"(c));return r;}
__device__ __forceinline__ float max2f(float a,float b){float r;asm("v_max_f32_e32 %0, %1, %2":"=v"(r):"v"(a),"v"(b));return r;}
__device__ __forceinline__ float fadd_s(float a,float b){float r;asm("v_add_f32_e32 %0, %1, %2":"=v"(r):"v"(a),"v"(b));return r;}
__device__ __forceinline__ float fsub_s(float a,float b){float r;asm("v_sub_f32_e32 %0, %1, %2":"=v"(r):"v"(a),"v"(b));return r;}
typedef float f32x2_t __attribute__((ext_vector_type(2))); typedef __bf16 bf16x2_t __attribute__((ext_vector_type(2))); typedef float f32x4_t __attribute__((ext_vector_type(4))); typedef unsigned u32x2_t __attribute__((ext_vector_type(2)));
__device__ __forceinline__ unsigned cvtpk_s(float lo,float hi){f32x2_t v={lo,hi};bf16x2_t b=__builtin_convertvector(v,bf16x2_t);return __builtin_bit_cast(unsigned,b);}
#define WAIT_BAR(N) asm volatile("s_waitcnt vmcnt(" #N ") lgkmcnt(0)\n\ts_barrier":::"memory")

__device__ __forceinline__ void qkt(f32x16&p0,f32x16&p1,const char*Kslot,const bf16x8*qr,const f32x16&negm,int r32,int hi){
  const char*kb=Kslot+hi*1024+r32*16;
  #pragma unroll
  for(int d0=0;d0<4;++d0){
    const bf16x8 b0=*reinterpret_cast<const bf16x8*>(kb+d0*2048);
    const bf16x8 b1=*reinterpret_cast<const bf16x8*>(kb+d0*2048+512);
    if(d0==0){p0=__builtin_amdgcn_mfma_f32_32x32x16_bf16(b0,qr[0],negm,0,0,0);p1=__builtin_amdgcn_mfma_f32_32x32x16_bf16(b1,qr[0],negm,0,0,0);}
    else{p0=__builtin_amdgcn_mfma_f32_32x32x16_bf16(b0,qr[d0],p0,0,0,0);p1=__builtin_amdgcn_mfma_f32_32x32x16_bf16(b1,qr[d0],p1,0,0,0);}}
}
typedef __attribute__((address_space(3))) const char* lds_cptr;
typedef short v4i16_t __attribute__((ext_vector_type(4)));
__device__ __forceinline__ void kload8(bf16x8*kf,lds_cptr kp){
  kf[0]=*(const __attribute__((address_space(3))) bf16x8*)(kp);      kf[1]=*(const __attribute__((address_space(3))) bf16x8*)(kp+512);
  kf[2]=*(const __attribute__((address_space(3))) bf16x8*)(kp+2048); kf[3]=*(const __attribute__((address_space(3))) bf16x8*)(kp+2560);
  kf[4]=*(const __attribute__((address_space(3))) bf16x8*)(kp+4096); kf[5]=*(const __attribute__((address_space(3))) bf16x8*)(kp+4608);
  kf[6]=*(const __attribute__((address_space(3))) bf16x8*)(kp+6144); kf[7]=*(const __attribute__((address_space(3))) bf16x8*)(kp+6656);
}
__device__ __forceinline__ void kload2(bf16x8*kf,lds_cptr kp,int j){ kf[2*j]=*(const __attribute__((address_space(3))) bf16x8*)(kp+j*2048); kf[2*j+1]=*(const __attribute__((address_space(3))) bf16x8*)(kp+j*2048+512); }
__device__ __forceinline__ s16x4 vtr(lds_cptr p){ return __builtin_bit_cast(s16x4,__builtin_amdgcn_ds_read_tr16_b64_v4i16((__attribute__((address_space(3))) v4i16_t*)p)); }
__device__ __forceinline__ float rowmax(const f32x16&p0,const f32x16&p1){
  float a=max3f(p0[0],p0[1],p1[0]),b=max3f(p0[2],p0[3],p1[1]);a=max3f(a,p1[2],p1[3]);
  #pragma unroll
  for(int r=4;r<16;r+=4){a=max3f(a,p0[r],p0[r+1]);b=max3f(b,p0[r+2],p0[r+3]);a=max3f(a,p1[r],p1[r+1]);b=max3f(b,p1[r+2],p1[r+3]);}
  const float m=max2f(a,b);
  auto rr=__builtin_amdgcn_permlane32_swap(__float_as_uint(m),__float_as_uint(m),false,false);
  return max2f(__uint_as_float(rr[0]),__uint_as_float(rr[1]));
}
__device__ __forceinline__ void pv(f32x16*o,int vb,bf16x8 pa0,bf16x8 pa1,bf16x8 pa2,bf16x8 pa3){
  #pragma unroll
  for(int d0=0;d0<2;++d0){s16x4 lo[4],hi[4];
    #pragma unroll
    for(int ks=0;ks<4;++ks){
      asm volatile("ds_read_b64_tr_b16 %0,%1 offset:%c2":"=&v"(lo[ks]):"v"(vb),"i"(d0*4096+ks*1024):"memory");
      asm volatile("ds_read_b64_tr_b16 %0,%1 offset:%c2":"=&v"(hi[ks]):"v"(vb),"i"(d0*4096+ks*1024+512):"memory");}
    asm volatile("s_waitcnt lgkmcnt(0)":::"memory");SBAR();
    #define PK(k) (bf16x8){lo[k][0],lo[k][1],lo[k][2],lo[k][3],hi[k][0],hi[k][1],hi[k][2],hi[k][3]}
    o[d0]=__builtin_amdgcn_mfma_f32_32x32x16_bf16(pa0,PK(0),o[d0],0,0,0);
    o[d0]=__builtin_amdgcn_mfma_f32_32x32x16_bf16(pa1,PK(1),o[d0],0,0,0);
    o[d0]=__builtin_amdgcn_mfma_f32_32x32x16_bf16(pa2,PK(2),o[d0],0,0,0);
    o[d0]=__builtin_amdgcn_mfma_f32_32x32x16_bf16(pa3,PK(3),o[d0],0,0,0);
    #undef PK
  }
}

#ifndef ATTN_STORE16
#define ATTN_STORE16(p,v) (*(u32x4*)(p)=(v))
#endif
template<int THRL> __device__ __forceinline__ void attn_unit(int b,int h,int qb,const bf16*Q,const bf16*__restrict__ K,const bf16*__restrict__ V,unsigned char*Y,const float*__restrict__ ksum,const float*__restrict__ onb_g,char*shm){
  int tid_=threadIdx.x; asm volatile("":"+v"(tid_)); const int tid=tid_,lane=tid&63,r32=lane&31,hi=lane>>5; const int wid=__builtin_amdgcn_readfirstlane(tid>>6);
  const long rowbase=(long)b*SEQ; const int q0=qb*QB;
  const bf16*Qw=Q+(rowbase+q0+wid*QBLK)*DM+h*D;
  const bf16*Kh=K+rowbase*DM+h*D,*Vh=V+rowbase*DM+h*D;
  const unsigned lds0=(unsigned)(uintptr_t)shm;
  float*wsf=(float*)(shm+LDS_WS)+wid*64;
  const bf16*ksrc=Kh+(long)lane*DM+wid*8;
  const bf16*vsrc=Vh+(long)(16*(wid&3)+(lane>>2))*DM+(wid>>2)*32+(lane&3)*8;
  const unsigned kdst=lds0+LDS_K+wid*1024, vdst=lds0+LDS_V+wid*1024;
  #define DMA_K(t,slot) glds16(ksrc+(long)(t)*KVBLK*DM,(unsigned)__builtin_amdgcn_readfirstlane(kdst+(slot)))
  #define DMA_V(t,slot) glds16(vsrc+(long)(t)*KVBLK*DM,(unsigned)__builtin_amdgcn_readfirstlane(vdst+(slot)))
  const int vb0=(int)(lds0+LDS_V)+((lane>>4)&1)*32+(lane&3)*8+(4*hi+((lane&15)>>2))*64;
  const char*Kbase=shm+LDS_K; bf16x8 kf[8];
  const lds_cptr shm3=(lds_cptr)shm; const lds_cptr kp0=shm3+LDS_K+hi*1024+r32*16; const lds_cptr vp0=shm3+LDS_V+((lane>>4)&1)*32+(lane&3)*8+(4*hi+((lane&15)>>2))*64;
  const int NT=(q0+QB)/KVBLK;
  DMA_K(0,0);DMA_V(0,0);DMA_K(1,SLOTB);
  bf16x8 qr[4];
  #pragma unroll
  for(int d0=0;d0<4;++d0)qr[d0]=*reinterpret_cast<const bf16x8*>(&Qw[(long)r32*DM+d0*16+hi*8]);
  unsigned selbits;
  { f32x16 g=f32x16{};
    const float*kr=ksum+((((long)(b*(SEQ/QB)+r32)*2)*NHEAD+h)*D)+hi*8;
    #pragma unroll
    for(int d0=0;d0<4;++d0){ f32x4_t a0={0.f,0.f,0.f,0.f},a1={0.f,0.f,0.f,0.f}; if(r32<qb){a0=*reinterpret_cast<const f32x4_t*>(kr+d0*16)+*reinterpret_cast<const f32x4_t*>(kr+NHEAD*D+d0*16);a1=*reinterpret_cast<const f32x4_t*>(kr+d0*16+4)+*reinterpret_cast<const f32x4_t*>(kr+NHEAD*D+d0*16+4);}
      float hv[8],lv[8];
      #pragma unroll
      for(int e=0;e<4;++e){const float t0=a0[e],t1=a1[e];     hv[e]=__uint_as_float(__float_as_uint(t0)&0xffff0000u);lv[e]=t0-hv[e];hv[4+e]=__uint_as_float(__float_as_uint(t1)&0xffff0000u);lv[4+e]=t1-hv[4+e];}
      u32x4 wh={cvtpk_s(hv[0],hv[1]),cvtpk_s(hv[2],hv[3]),cvtpk_s(hv[4],hv[5]),cvtpk_s(hv[6],hv[7])},wl={cvtpk_s(lv[0],lv[1]),cvtpk_s(lv[2],lv[3]),cvtpk_s(lv[4],lv[5]),cvtpk_s(lv[6],lv[7])};
      g=__builtin_amdgcn_mfma_f32_32x32x16_bf16(__builtin_bit_cast(bf16x8,wh),qr[d0],g,0,0,0);
      g=__builtin_amdgcn_mfma_f32_32x32x16_bf16(__builtin_bit_cast(bf16x8,wl),qr[d0],g,0,0,0);}
    float gt[8];
    #pragma unroll
    for(int r=0;r<4;++r){auto rr=__builtin_amdgcn_permlane32_swap(__float_as_uint(g[r]),__float_as_uint(g[r]),false,false);gt[r]=__uint_as_float(rr[0]);gt[4+r]=__uint_as_float(rr[1]);}
    selbits=1u<<qb;
    #pragma unroll
    for(int n=0;n<7;++n){int rank=0;
      #pragma unroll
      for(int m=0;m<7;++m)if(m!=n)rank+=(m<qb&&(gt[m]>gt[n]||(gt[m]==gt[n]&&m<n)))?1:0;
      if(n<qb&&rank<3)selbits|=1u<<n;}
  }
  #define MSKF(n) ((((selbits>>(n))&1u)!=0u)?0.f:-INFINITY)
  float mhat=0.f,l_reg=0.f;f32x16 o[2];o[0]=f32x16{};o[1]=f32x16{};f32x16 negm;{const float nm0=MSKF(0);
  #pragma unroll
  for(int r=0;r<16;++r)negm[r]=nm0;}asm volatile("":"+v"(negm));
  #define NEWBLK(tt) do{ if((((tt)&3)==0)){ const float nm_=MSKF((tt)>>2)-mhat; _Pragma("unroll") for(int r=0;r<16;++r)negm[r]=nm_; asm volatile("":"+v"(negm)); } }while(0)
  const int qrel=wid*QBLK+r32;
  #define CMASK(P0,P1,t) do{int jb_=(t)-(NT-4); if(jb_>=0)cmask(P0,P1,jb_,qrel,hi);}while(0)
  bool resc=false;
  #define START(P0,P1) do{ const float rm=rowmax(P0,P1); resc=false; \
    { const float dl=(rm==-INFINITY)?0.f:rm; mhat=fadd_s(mhat,dl); \
      _Pragma("unroll") for(int r=0;r<16;++r){P0[r]=fsub_s(P0[r],dl);P1[r]=fsub_s(P1[r],dl);} \
      const float nm_=MSKF(0)-mhat; _Pragma("unroll") for(int r=0;r<16;++r)negm[r]=nm_; asm volatile("":"+v"(negm)); } \
    _Pragma("unroll") for(int r=0;r<16;++r)P0[r]=__builtin_amdgcn_exp2f(P0[r]); }while(0)
  #define RESC() do{ if(resc){ asm volatile("s_waitcnt lgkmcnt(0)":::"memory"); \
      _Pragma("unroll") for(int d_=0;d_<2;++d_) _Pragma("unroll") for(int r=0;r<16;++r)o[d_][r]*=wsf[crow(r,hi)]; } }while(0)
  f32x16 pA0,pA1,pB0,pB1;
  int sl_prev=0,sl_cur=0,sl_next=SLOTB;
  #define ROT() do{sl_prev=sl_cur;sl_cur=sl_next;sl_next=(sl_next==(NSLOT-1)*SLOTB)?0:sl_next+SLOTB;}while(0)
  DMA_K(2,2*SLOTB);
  WAIT_BAR(3);
  qkt(pA0,pA1,Kbase,qr,negm,r32,hi);asm volatile("s_nop 15\n\ts_nop 7":"+v"(pA0),"+v"(pA1));CMASK(pA0,pA1,0);
  START(pA0,pA1);
  _Pragma("unroll") for(int r=0;r<16;++r)pA1[r]=__builtin_amdgcn_exp2f(pA1[r]);
  WAIT_BAR(0);
  DMA_K(3,0);DMA_V(1,SLOTB);
  ROT();
  kload8(kf,kp0+sl_cur);
  WAIT_BAR(2);
  s16x4 vlo[8],vhi[8]; u32x4 pw0,pw1,pw2,pw3;
  #define PKW(P,B) cvtpk_s(P[B],P[B+1])
  #define PAF(k) __builtin_bit_cast(bf16x8,pw##k)
  #define VFR(i) (bf16x8){vlo[i][0],vlo[i][1],vlo[i][2],vlo[i][3],vhi[i][0],vhi[i][1],vhi[i][2],vhi[i][3]}
  #define PIN(x) asm volatile("":"+v"(x))
  #define MX3(a,b,c) __builtin_fmaxf(__builtin_fmaxf((a),(b)),(c))
  #define GAPA(MF,A0,A1,A2,A3,W0,W1,PW) do{ MF; sacc+=A0; sacc+=A1; sacc+=A2; sacc+=A3; PIN(sacc); W0; W1; PIN(PW); SBAR(); }while(0)
  #define EX(v) __builtin_amdgcn_exp2f(v)
  #define GAPB(MF,X,B) do{ MF; X[B]=EX(X[B]); X[B+1]=EX(X[B+1]); X[B+2]=EX(X[B+2]); X[B+3]=EX(X[B+3]); PIN(X); SBAR(); }while(0)
  #define VRD(i) do{ vlo[i]=vtr(vp_+(((i)>>2)*4096+((i)&3)*1024)); vhi[i]=vtr(vp_+(((i)>>2)*4096+((i)&3)*1024+512)); }while(0)
  #define KRD(G,j) do{ if(G){ kload2(kf,kp0+sl_next,j); SBAR(); } }while(0)
  #define GAPAX(QK_,PV_,MF,A0,A1,A2,A3,W0,W1,PW) do{ MF; sacc+=A0; sacc+=A1; sacc+=A2; sacc+=A3; PIN(sacc); W0; W1; PIN(PW); SBAR(); }while(0)
  #define GAPBX(QK_,PV_,MF,X,B) do{ if(PV_){MF;} if(QK_){ X[B]=EX(X[B]); X[B+1]=EX(X[B+1]); X[B+2]=EX(X[B+2]); X[B+3]=EX(X[B+3]); } else { X[B]=0.f; X[B+1]=0.f; X[B+2]=0.f; X[B+3]=0.f; } PIN(X); SBAR(); }while(0)
  #define STEPX(QK_,PV_,C0,C1,P0,P1,t,GK,GV,GL) do{ SBAR(); \
    const lds_cptr vp_=vp0+sl_prev; \
    if(PV_){VRD(0);} SBAR(); float sacc=(P0[0]+P0[1]); \
    GAPAX(QK_,PV_,if(QK_){C0=__builtin_amdgcn_mfma_f32_32x32x16_bf16(kf[0],qr[0],negm,0,0,0);}else{C0=negm;}, P0[2],P0[3],P0[4],P0[5],     pw0[0]=PKW(P0,0), pw0[1]=PKW(P0,2), pw0); \
    if(PV_){VRD(4);} SBAR(); GAPAX(QK_,PV_,if(QK_){C1=__builtin_amdgcn_mfma_f32_32x32x16_bf16(kf[1],qr[0],negm,0,0,0);}else{C1=negm;}, P0[6],P0[7],P0[8],P0[9],     pw0[2]=PKW(P0,4), pw0[3]=PKW(P0,6), pw0); \
    if(PV_){VRD(1);} SBAR(); GAPAX(QK_,PV_,if(QK_){C0=__builtin_amdgcn_mfma_f32_32x32x16_bf16(kf[2],qr[1],C0,0,0,0);},   P0[10],P0[11],P0[12],P0[13], pw1[0]=PKW(P0,8), pw1[1]=PKW(P0,10), pw1); \
    if(PV_){VRD(5);} SBAR(); GAPAX(QK_,PV_,if(QK_){C1=__builtin_amdgcn_mfma_f32_32x32x16_bf16(kf[3],qr[1],C1,0,0,0);},   P0[14],P0[15],P1[0],P1[1],   pw1[2]=PKW(P0,12),pw1[3]=PKW(P0,14), pw1); \
    if(PV_){VRD(2);} SBAR(); GAPAX(QK_,PV_,if(QK_){C0=__builtin_amdgcn_mfma_f32_32x32x16_bf16(kf[4],qr[2],C0,0,0,0);},   P1[2],P1[3],P1[4],P1[5],     pw2[0]=PKW(P1,0), pw2[1]=PKW(P1,2), pw2); \
    if(PV_){VRD(6);} SBAR(); GAPAX(QK_,PV_,if(QK_){C1=__builtin_amdgcn_mfma_f32_32x32x16_bf16(kf[5],qr[2],C1,0,0,0);},   P1[6],P1[7],P1[8],P1[9],     pw2[2]=PKW(P1,4), pw2[3]=PKW(P1,6), pw2); \
    if(PV_){VRD(3);} SBAR(); GAPAX(QK_,PV_,if(QK_){C0=__builtin_amdgcn_mfma_f32_32x32x16_bf16(kf[6],qr[3],C0,0,0,0);},   P1[10],P1[11],P1[12],P1[13], pw3[0]=PKW(P1,8), pw3[1]=PKW(P1,10), pw3); \
    if(PV_){VRD(7);} SBAR(); GAPAX(QK_,PV_,if(QK_){C1=__builtin_amdgcn_mfma_f32_32x32x16_bf16(kf[7],qr[3],C1,0,0,0);},   P1[14],P1[15],0.f,0.f,       pw3[2]=PKW(P1,12),pw3[3]=PKW(P1,14), pw3); \
    l_reg+=sacc; \
    if(GK){DMA_K((t)+3,sl_cur);} if(GV){DMA_V((t)+1,sl_next);} \
    if(QK_){ \
    CMASK(C0,C1,t); \
    { float a=MX3(C0[0],C0[1],C1[0]),b=MX3(C0[2],C0[3],C1[1]); a=MX3(a,C1[2],C1[3]); \
      _Pragma("unroll") for(int r=4;r<16;r+=4){a=MX3(a,C0[r],C0[r+1]);b=MX3(b,C0[r+2],C0[r+3]);a=MX3(a,C1[r],C1[r+1]);b=MX3(b,C1[r+2],C1[r+3]);} \
      float rm=__builtin_fmaxf(a,b); { auto rr=__builtin_amdgcn_permlane32_swap(__float_as_uint(rm),__float_as_uint(rm),false,false); rm=__builtin_fmaxf(__uint_as_float(rr[0]),__uint_as_float(rr[1])); } \
      resc=false; \
      if(__builtin_expect(__any(rm>(float)THRL),0)){ const float dl=__builtin_fmaxf(rm,0.f); mhat+=dl; \
        _Pragma("unroll") for(int r=0;r<16;++r){C0[r]-=dl;C1[r]-=dl;} \
        const float nm_=MSKF((t)>>2)-mhat; _Pragma("unroll") for(int r=0;r<16;++r)negm[r]=nm_; asm volatile("":"+v"(negm)); \
        const float f=__builtin_amdgcn_exp2f(-dl); l_reg*=f; if(hi==0)wsf[r32]=f; resc=true; } } \
    } else { resc=false; } \
    SBAR(); \
    GAPBX(QK_,PV_,o[0]=__builtin_amdgcn_mfma_f32_32x32x16_bf16(PAF(0),VFR(0),o[0],0,0,0), C0,0); \
    GAPBX(QK_,PV_,o[1]=__builtin_amdgcn_mfma_f32_32x32x16_bf16(PAF(0),VFR(4),o[1],0,0,0), C0,4); \
    KRD(GL,0); GAPBX(QK_,PV_,o[0]=__builtin_amdgcn_mfma_f32_32x32x16_bf16(PAF(1),VFR(1),o[0],0,0,0), C0,8); \
    KRD(GL,1); GAPBX(QK_,PV_,o[1]=__builtin_amdgcn_mfma_f32_32x32x16_bf16(PAF(1),VFR(5),o[1],0,0,0), C0,12); \
    KRD(GL,2); GAPBX(QK_,PV_,o[0]=__builtin_amdgcn_mfma_f32_32x32x16_bf16(PAF(2),VFR(2),o[0],0,0,0), C1,0); \
    KRD(GL,3); GAPBX(QK_,PV_,o[1]=__builtin_amdgcn_mfma_f32_32x32x16_bf16(PAF(2),VFR(6),o[1],0,0,0), C1,4); \
    GAPBX(QK_,PV_,o[0]=__builtin_amdgcn_mfma_f32_32x32x16_bf16(PAF(3),VFR(3),o[0],0,0,0), C1,8); \
    GAPBX(QK_,PV_,o[1]=__builtin_amdgcn_mfma_f32_32x32x16_bf16(PAF(3),VFR(7),o[1],0,0,0), C1,12); \
    }while(0)
  #define STEP(C0,C1,P0,P1,t,GK,GV,GL) STEPX(true,true,C0,C1,P0,P1,t,GK,GV,GL)
  int t=1;
  #undef CMASK
  #define CMASK(P0,P1,t) do{}while(0)
  for(;t+5<NT;t+=2){
    STEP(pB0,pB1,pA0,pA1,t,true,true,true);     WAIT_BAR(2); RESC(); ROT(); NEWBLK(t+1);
    STEP(pA0,pA1,pB0,pB1,t+1,true,true,true);   WAIT_BAR(2); RESC(); ROT();
  }
  #undef CMASK
  #define CMASK(P0,P1,t) do{int jb_=(t)-(NT-4); if(jb_>=0)cmask(P0,P1,jb_,qrel,hi);}while(0)
  #define ENDW(tt) do{ if((tt)+3<NT){WAIT_BAR(2);} else if((tt)+2<NT){WAIT_BAR(1);} else {WAIT_BAR(0);} }while(0)
  const int tl=NT-4+(wid>>1);
  #define BSTEP(C0,C1,P0,P1,tt,GK,GV,GL) STEPX(((tt)<=tl),((tt)<=tl+1),C0,C1,P0,P1,tt,GK,GV,GL)
  for(;t+1<NT;t+=2){
    BSTEP(pB0,pB1,pA0,pA1,t,(t+3<NT),(t+1<NT),(t+1<NT));       ENDW(t);   RESC(); ROT(); NEWBLK(t+1);
    BSTEP(pA0,pA1,pB0,pB1,t+1,(t+4<NT),(t+2<NT),(t+2<NT));     ENDW(t+1); RESC(); ROT();
  }
  BSTEP(pB0,pB1,pA0,pA1,NT-1,false,false,false); RESC();
  if(tl==NT-1){ float sacc=pB0[0]+pB0[1]; _Pragma("unroll") for(int r=2;r<16;++r)sacc+=pB0[r]; _Pragma("unroll") for(int r=0;r<16;++r)sacc+=pB1[r]; l_reg+=sacc;
    pw0=(u32x4){PKW(pB0,0),PKW(pB0,2),PKW(pB0,4),PKW(pB0,6)};pw1=(u32x4){PKW(pB0,8),PKW(pB0,10),PKW(pB0,12),PKW(pB0,14)};pw2=(u32x4){PKW(pB1,0),PKW(pB1,2),PKW(pB1,4),PKW(pB1,6)};pw3=(u32x4){PKW(pB1,8),PKW(pB1,10),PKW(pB1,12),PKW(pB1,14)};
    SBAR(); pv(o,vb0+sl_cur,PAF(0),PAF(1),PAF(2),PAF(3)); }
  #undef PKW
  #undef PAF
  #undef VFR
  #undef PIN
  #undef MX3
  #undef GAPA
  #undef GAPAX
  #undef GAPBX
  #undef STEPX
  #undef BSTEP
  #undef GAPB
  #undef EX
  #undef VRD
  #undef KRD
  #undef STEP
  #undef ENDW
  {auto rr=__builtin_amdgcn_permlane32_swap(__float_as_uint(l_reg),__float_as_uint(l_reg),false,false);l_reg=__uint_as_float(rr[0])+__uint_as_float(rr[1]);}
  if(hi==0)wsf[32+r32]=l_reg;asm volatile("s_waitcnt lgkmcnt(0)":::"memory");
  float rli[16];
  #pragma unroll
  for(int r=0;r<16;++r)rli[r]=__builtin_amdgcn_rcpf(wsf[32+crow(r,hi)]);
  unsigned char*Yw=Y+(rowbase+q0+wid*QBLK)*YP+h*D;
  { float*stg=(float*)(shm+LDS_OST)+wid*2048;
    #pragma unroll
    for(int r=0;r<16;++r){const int orow=crow(r,hi);
      #pragma unroll
      for(int d0=0;d0<2;++d0)stg[orow*64+d0*32+r32]=o[d0][r]*rli[r];}
    asm volatile("s_waitcnt lgkmcnt(0)":::"memory");
    const int c8=lane&7; const f32x4_t g0=*reinterpret_cast<const f32x4_t*>(onb_g+h*D+c8*8),g1=*reinterpret_cast<const f32x4_t*>(onb_g+h*D+c8*8+4);
    #pragma unroll
    for(int i=0;i<4;++i){const int row=i*8+(lane>>3); const f32x4_t v0=*(const f32x4_t*)(stg+row*64+c8*8),v1=*(const f32x4_t*)(stg+row*64+c8*8+4);
      float ss=((v0[0]*v0[0]+v0[1]*v0[1])+(v0[2]*v0[2]+v0[3]*v0[3]))+((v1[0]*v1[0]+v1[1]*v1[1])+(v1[2]*v1[2]+v1[3]*v1[3])); ss+=__shfl_xor(ss,1); ss+=__shfl_xor(ss,2); ss+=__shfl_xor(ss,4);
      const float rs=__builtin_amdgcn_rsqf(ss*(1.0f/64.0f)+1e-6f)*YSC;
      int w0=__builtin_amdgcn_cvt_pk_fp8_f32(v0[0]*rs*g0[0],v0[1]*rs*g0[1],0,false); w0=__builtin_amdgcn_cvt_pk_fp8_f32(v0[2]*rs*g0[2],v0[3]*rs*g0[3],w0,true);
      int w1=__builtin_amdgcn_cvt_pk_fp8_f32(v1[0]*rs*g1[0],v1[1]*rs*g1[1],0,false); w1=__builtin_amdgcn_cvt_pk_fp8_f32(v1[2]*rs*g1[2],v1[3]*rs*g1[3],w1,true);
      u32x2_t w; w.x=(unsigned)w0; w.y=(unsigned)w1;
      *(u32x2_t*)(Yw+(long)row*YP+c8*8)=w;} }
  asm volatile("s_waitcnt lgkmcnt(0)\n\ts_barrier":::"memory");
  #undef DMA_K
  #undef DMA_V
  #undef MSKF
  #undef NEWBLK
  #undef CMASK
  #undef START
  #undef RESC
  #undef ROT
}
constexpr int ATTN_LDS_BYTES=LDS_BYTES;
struct AttnTensors { const bf16* Q; const bf16* K; const bf16* V; unsigned char* Y; const float* ksum; const float* onb_g; };
struct AttnUnit { int bh; int qb; };
struct StaticOrder {
  int vcu,G;
  __device__ __forceinline__ explicit StaticOrder(int grid,int block):vcu((grid%8==0)?(block%8)*(grid/8)+block/8:block),G(grid){}
  __device__ __forceinline__ bool next(int i,AttnUnit&u)const{ const int p=vcu+(i>>1)*G; if(p>=BATCH*NHEAD*4)return false; const int s=p&3; u.bh=p>>2; u.qb=(i&1)?7-s:s; return true; }
  __device__ __forceinline__ void a_ready(const AttnUnit&)const{}
  __device__ __forceinline__ void done(const AttnUnit&)const{}
};
template<class Sched,int THRL=8> __device__ __forceinline__ void attn_phase(char*lds,const AttnTensors&T,const Sched&S){
  AttnUnit u;
  for(int i=0;S.next(i,u);++i){ S.a_ready(u); attn_unit<THRL>(u.bh/NHEAD,u.bh%NHEAD,u.qb,T.Q,T.K,T.V,T.Y,T.ksum,T.onb_g,lds); S.done(u); }
}
#undef SBAR
#undef WAIT_BAR
}
constexpr int NWAVES = 8;
constexpr int CW_TMO = 0, CW_CODE = 1, CW_EXIT = 2, CW_START = 64;
constexpr int CW_BAR = 4096;
constexpr int RING_OFF = 0, RING_BYTES = 131072;
constexpr int LDSCTL_OFF = RING_BYTES, MISC_OFF = LDSCTL_OFF + 320;
constexpr int LDS_BYTES = 147456;
constexpr int PAR_OFF = LDSCTL_OFF + 1024;
constexpr int RSL_OFF = PAR_OFF + 5120;
static_assert(MISC_OFF + 128 <= PAR_OFF && PAR_OFF + 1152 * 4 <= RSL_OFF && RSL_OFF + 2048 <= LDS_BYTES, "LDS map");

#define GAS __attribute__((address_space(1)))
#define LAS __attribute__((address_space(3)))
typedef unsigned short bf16;
typedef unsigned v4u __attribute__((ext_vector_type(4)));
typedef float f32x4 __attribute__((ext_vector_type(4)));
typedef short bf16x8 __attribute__((ext_vector_type(8)));
typedef GAS unsigned gu32;
typedef GAS unsigned long long gu64;
#define RLX_AGENT __ATOMIC_RELAXED, __HIP_MEMORY_SCOPE_AGENT
#define LDS_WAIT() asm volatile("s_waitcnt lgkmcnt(0)" ::: "memory")
#define VM_WAIT() asm volatile("s_waitcnt vmcnt(0)" ::: "memory")
__device__ __forceinline__ unsigned long long rt() { return __builtin_amdgcn_s_memrealtime(); }
__device__ __forceinline__ unsigned f2bf(float f) { unsigned u = __builtin_bit_cast(unsigned, f); return (u + 0x7fffu + ((u >> 16) & 1u)) >> 16; }
__device__ __forceinline__ unsigned pk2(float lo, float hi) { return f2bf(lo) | (f2bf(hi) << 16); }

#define XB_TMO      128
#define XB_XCNT(j)  (256  + 64 * (j))
#define XB_XSUB(j)  (1280 + 64 * (j))
#define XB_XGEN(j)  (2304 + 64 * (j))
#define XB_TOP      3328
#define XB_TOPGEN   3392
#define XCD_BAR_WORDS 3456
#define XB_SPIN_CAP (1u << 18)

__device__ __forceinline__ unsigned xb_ld(unsigned* p)              { return __hip_atomic_load(p, __ATOMIC_RELAXED, __HIP_MEMORY_SCOPE_AGENT); }
__device__ __forceinline__ unsigned xb_add(unsigned* p, unsigned v) { return __hip_atomic_fetch_add(p, v, __ATOMIC_RELAXED, __HIP_MEMORY_SCOPE_AGENT); }
__device__ __forceinline__ unsigned xb_xcc_id() { return (unsigned)__builtin_amdgcn_s_getreg((3 << 11) | 20) & 0xFu; }
#define XB_SPIN(cond, bar) do { unsigned _sp = 0; while (cond) { __builtin_amdgcn_s_sleep(1); \
    if ((++_sp & 255u) == 0u) { if (xb_ld(&(bar)[XB_TMO])) break; if (_sp > XB_SPIN_CAP) { atomicAdd(&(bar)[XB_TMO], 1u); break; } } } } while (0)

struct XcdBarrier {
    unsigned* bar; unsigned x;
    volatile LAS unsigned* st;
};

__device__ __forceinline__ XcdBarrier xcd_barrier_post(unsigned* bar, volatile LAS unsigned* st) {
    XcdBarrier b; b.bar = bar; b.x = xb_xcc_id(); b.st = st;
    if (threadIdx.x == 0) (void)xb_add(&bar[XB_XCNT(b.x)], 1u);
    return b;
}
__device__ __forceinline__ void xcd_barrier_complete(unsigned* bar, unsigned x, unsigned& nloc, unsigned& nx) {
    const unsigned G = gridDim.x * gridDim.y * gridDim.z;
    unsigned sum, cnt, mine, sp = 0u;
    for (;;) {
        sum = 0u; cnt = 0u; mine = 0u;
#pragma unroll
        for (unsigned j = 0; j < 16; ++j) { const unsigned c = xb_ld(&bar[XB_XCNT(j)]); sum += c; cnt += (c > 0u) ? 1u : 0u; mine = (j == x) ? c : mine; }
        if (sum == G) break;
        __builtin_amdgcn_s_sleep(1);
        if ((++sp & 255u) == 0u) { if (xb_ld(&bar[XB_TMO])) break; if (sp > XB_SPIN_CAP) { atomicAdd(&bar[XB_TMO], 1u); break; } }
    }
    nloc = mine > 0u ? mine : 1u; nx = cnt > 0u ? cnt : 1u;
}

__device__ __forceinline__ void xcd_barrier(const XcdBarrier& b) {
    asm volatile("s_waitcnt vmcnt(0)" ::: "memory");
    __syncthreads();
    if (threadIdx.x == 0) {
        unsigned* bar = b.bar;
        __builtin_amdgcn_s_waitcnt(0);
        unsigned nloc = b.st[0], nx = b.st[1];
        if (nloc == 0u) { xcd_barrier_complete(bar, b.x, nloc, nx); b.st[0] = nloc; b.st[1] = nx; }
        const unsigned old = xb_add(&bar[XB_XSUB(b.x)], 1u);
        const unsigned gen = old / nloc;
        if (old + 1u == (gen + 1u) * nloc) {
            __builtin_amdgcn_fence(__ATOMIC_RELEASE, "agent");
            asm volatile("s_waitcnt vmcnt(0)" ::: "memory");
            const unsigned og = xb_add(&bar[XB_TOP], 1u);
            const unsigned tg = og / nx;
            if (og + 1u == (tg + 1u) * nx) xb_add(&bar[XB_TOPGEN], 1u);
            else XB_SPIN(xb_ld(&bar[XB_TOPGEN]) == tg, bar);
            __builtin_amdgcn_fence(__ATOMIC_ACQUIRE, "agent");
            xb_add(&bar[XB_XGEN(b.x)], 1u);
            asm volatile("s_waitcnt vmcnt(0)" ::: "memory");
        } else {
            XB_SPIN(xb_ld(&bar[XB_XGEN(b.x)]) == gen, bar);
            __builtin_amdgcn_fence(__ATOMIC_ACQUIRE, "agent");
            asm volatile("s_waitcnt vmcnt(0)" ::: "memory");
        }
    }
    __syncthreads();
}

struct Frame {
    LAS unsigned char* lds;
    volatile LAS unsigned* MISC;
    gu32* ctl;
    int tid, lane, wave;
    int vcu, G;
};

__device__ __forceinline__ float wave_sum(float v) {
#pragma unroll
    for (int o = 1; o < 64; o <<= 1) v += __shfl_xor(v, o);
    return v;
}
struct WTile { const float* W; const float* g; void* WT; int K, N, k0, n0; float scale; int f8, gu; };
constexpr int WT_S = 257;
__device__ __forceinline__ void wtile_load(const WTile& t, int wave, int lane, f32x4 (&v)[8]) {
#pragma unroll
    for (int i = 0; i < 8; ++i) v[i] = __builtin_nontemporal_load((const GAS f32x4*)(t.W + (size_t)(t.k0 + wave + 8 * i) * t.N + t.n0 + 4 * lane));
}
#define LDS_BAR() asm volatile("s_waitcnt lgkmcnt(0)\n\ts_barrier" ::: "memory")
__device__ __forceinline__ void wtile_gains(const WTile& t, int wave, float (&gs)[8]) {
    const float* gp = t.g ? t.g : t.W;
#pragma unroll
    for (int i = 0; i < 8; ++i) gs[i] = gp[t.k0 + wave + 8 * i];
}
__device__ __forceinline__ void wtile_store(const WTile& t, int tid, int wave, int lane, const f32x4 (&v)[8], const float (&gs)[8], LAS float* scr) {
#pragma unroll
    for (int i = 0; i < 8; ++i) { const int kk = wave + 8 * i; const f32x4 x = v[i] * ((t.g ? gs[i] : 1.0f) * t.scale);
        LAS float* p = scr + kk * WT_S + 4 * lane; p[0] = x.x; p[1] = x.y; p[2] = x.z; p[3] = x.w; }
    LDS_BAR();
    if (!t.f8) {
#pragma unroll
        for (int j = 0; j < 4; ++j) { const int p = tid + 512 * j, c = p & 7, n = p >> 3; const LAS float* s = scr + (8 * c) * WT_S + n;
            v4u o; o.x = pk2(s[0 * WT_S], s[1 * WT_S]); o.y = pk2(s[2 * WT_S], s[3 * WT_S]); o.z = pk2(s[4 * WT_S], s[5 * WT_S]); o.w = pk2(s[6 * WT_S], s[7 * WT_S]);
            const int jn = t.n0 + n, row = t.gu ? ((jn >> 7) * 256 + (jn & 127) + (t.gu == 2 ? 128 : 0)) : jn;
            *(GAS v4u*)((bf16*)t.WT + (size_t)row * t.K + t.k0 + 8 * c) = o; }
    } else {
#pragma unroll
        for (int j = 0; j < 2; ++j) { const int p = tid + 512 * j, c = p & 3, n = p >> 2; const LAS float* s = scr + (16 * c) * WT_S + n;
            int w[4];
#pragma unroll
            for (int e = 0; e < 4; ++e) { w[e] = __builtin_amdgcn_cvt_pk_fp8_f32(s[(4 * e) * WT_S], s[(4 * e + 1) * WT_S], 0, false); w[e] = __builtin_amdgcn_cvt_pk_fp8_f32(s[(4 * e + 2) * WT_S], s[(4 * e + 3) * WT_S], w[e], true); }
            v4u o; o.x = (unsigned)w[0]; o.y = (unsigned)w[1]; o.z = (unsigned)w[2]; o.w = (unsigned)w[3];
            const int jn = t.n0 + n, row = t.gu ? ((jn >> 7) * 256 + (jn & 127) + (t.gu == 2 ? 128 : 0)) : jn;
            *(GAS v4u*)((unsigned char*)t.WT + (size_t)row * t.K + t.k0 + 16 * c) = o; }
    }
    LDS_BAR();
}
template <int NR> __device__ __forceinline__ void rows_to_bf16_rstd(int lane, const float* xrow, size_t rstride, bf16* orow, float* rstd) {
    f32x4 v[NR][4];
#pragma unroll
    for (int r = 0; r < NR; ++r)
#pragma unroll
        for (int j = 0; j < 4; ++j) v[r][j] = __builtin_nontemporal_load((const GAS f32x4*)(xrow + r * rstride) + lane + 64 * j);
#pragma unroll
    for (int r = 0; r < NR; ++r) { float s = 0.f;
#pragma unroll
        for (int j = 0; j < 4; ++j) s += (v[r][j].x * v[r][j].x + v[r][j].y * v[r][j].y) + (v[r][j].z * v[r][j].z + v[r][j].w * v[r][j].w);
        const float rs = 1.f / sqrtf(wave_sum(s) * (1.f / DM) + EPS); if (lane == 0) rstd[r] = rs;
        GAS unsigned long long* o8 = (GAS unsigned long long*)(orow + r * rstride) + lane;
#pragma unroll
        for (int j = 0; j < 4; ++j) o8[64 * j] = (unsigned long long)pk2(v[r][j].x, v[r][j].y) | ((unsigned long long)pk2(v[r][j].z, v[r][j].w) << 32); }
}
struct P0Args { const float *x, *norm1_g, *w_in, *sgu_w, *w_out, *norm2_g, *w_gate, *w_up, *w_down; bf16* WinT; unsigned char *WoQ, *WguQ, *WdQ; bf16 *SW, *XN; float* rstd1; };
constexpr int WT_IN = (DM / 64) * (INW / 256), WT_O = (DM / 64) * (DM / 256), WT_G = (DM / 64) * (DFF / 256), WT_D = (DFF / 64) * (DM / 256);
__device__ __forceinline__ int wset_count(int set) { return set == 0 ? WT_IN : set == 1 ? WT_O + 2 * WT_G : WT_D; }
__device__ __forceinline__ WTile wset_tile(const P0Args& a, int set, int r) {
    if (set == 0) { const int nb = INW / 256; return WTile{a.w_in, a.norm1_g, a.WinT, DM, INW, 64 * (r / nb), 256 * (r % nb), 1.0f, 0, 0}; }
    if (set == 2) { const int nb = DM / 256; return WTile{a.w_down, nullptr, a.WdQ, DFF, DM, 64 * (r / nb), 256 * (r % nb), WD_SCALE, 1, 0}; }
    if (r < WT_O) { const int nb = DM / 256; return WTile{a.w_out, nullptr, a.WoQ, DM, DM, 64 * (r / nb), 256 * (r % nb), WO_SCALE, 1, 0}; } r -= WT_O;
    { const bool up = r >= WT_G; if (up) r -= WT_G; const int nb = DFF / 256; return WTile{up ? a.w_up : a.w_gate, a.norm2_g, a.WguQ, DM, DFF, 64 * (r / nb), 256 * (r % nb), WGU_SCALE, 1, up ? 2 : 1}; }
}
__device__ __forceinline__ void wset_convert(Frame& F, const P0Args& a, int set, int wg, int nwg) {
    LAS float* scr = (LAS float*)(F.lds + RING_OFF);
    const int cnt = wset_count(set); int r = wg; if (r >= cnt) return;
    WTile cur = wset_tile(a, set, r); f32x4 v[8], vn[8]; float gs[8], gsn[8]; wtile_load(cur, F.wave, F.lane, v); wtile_gains(cur, F.wave, gs);
    for (;;) {
        const int rn = r + nwg; const bool more = rn < cnt; WTile nxt = cur;
        if (more) { nxt = wset_tile(a, set, rn); wtile_load(nxt, F.wave, F.lane, vn); wtile_gains(nxt, F.wave, gsn); }
        wtile_store(cur, F.tid, F.wave, F.lane, v, gs, scr);
        if (!more) break;
#pragma unroll
        for (int i = 0; i < 8; ++i) { v[i] = vn[i]; gs[i] = gsn[i]; }
        cur = nxt; r = rn;
    }
}
template <class Mid> __device__ __forceinline__ void p0_prologue(Frame& F, const P0Args& a, const Mid& mid) {
    const int gw = F.vcu * NWAVES + F.wave, NGW = F.G * NWAVES;
    wset_convert(F, a, 0, F.vcu, F.G);
    if (F.G * NWAVES * 8 == M) { for (int p = 0; p < 2; ++p) { const int m = 8 * gw + 4 * p; rows_to_bf16_rstd<4>(F.lane, a.x + (size_t)m * DM, DM, a.XN + (size_t)m * DM, a.rstd1 + m); if (p == 0) mid(); } }
    else for (int m = 4 * gw; m < M; m += 4 * NGW) rows_to_bf16_rstd<4>(F.lane, a.x + (size_t)m * DM, DM, a.XN + (size_t)m * DM, a.rstd1 + m);
    for (int i = (F.vcu * NWAVES * 64 + F.tid); i < NH * CHUNK * CHUNK; i += F.G * NWAVES * 64) { const int t = (i / CHUNK) % CHUNK, s = i % CHUNK; a.SW[i] = (bf16)f2bf(s <= t ? a.sgu_w[i] : 0.0f); }
}

constexpr int SGU_V_BYTES = 16384, SGU_U_PITCH = 144, SGU_U_BYTES = 128 * SGU_U_PITCH, SGU_UOFF = 2 * SGU_V_BYTES;
struct SguArgs { const bf16* P; const bf16* SW; const float* sgu_b; const float* ona_g; unsigned char* Y; };
typedef float f32x16 __attribute__((ext_vector_type(16)));
typedef short s16x4 __attribute__((ext_vector_type(4)));
typedef unsigned u32x2 __attribute__((ext_vector_type(2)));
__device__ __forceinline__ int crow16(int r, int hi) { return (r & 3) + 8 * (r >> 2) + 4 * hi; }
struct SguStage { v4u vv[4], uu[4]; };
__device__ __forceinline__ void sgu_load(const SguArgs& a, int unit, int tid, SguStage& s) {
    const int b = unit >> 6, c = (unit >> 2) & 15, hp = unit & 3; const size_t row0 = (size_t)b * SEQ + c * CHUNK;
#pragma unroll
    for (int k = 0; k < 4; ++k) { const int i = tid + 512 * k, hl = i >> 10, row = (i >> 3) & 127, ch = i & 7;
        const bf16* src = a.P + (row0 + row) * INW + (2 * hp + hl) * 64 + ch * 8;
        s.vv[k] = *(const GAS v4u*)(src + COL_VA); s.uu[k] = *(const GAS v4u*)(src + COL_U); }
}
__device__ __forceinline__ void sgu_unit(Frame& F, const SguArgs& a, int unit, SguStage& st, int next_unit) {
    const int b = unit >> 6, c = (unit >> 2) & 15, hp = unit & 3;
    int tid_ = threadIdx.x; asm volatile("" : "+v"(tid_)); const int tid = tid_, lane = tid & 63, wid = F.wave, r32 = lane & 31, hi = lane >> 5;
    const size_t row0 = (size_t)b * SEQ + c * CHUNK;
    const int hl = wid >> 2, h = 2 * hp + hl, t0 = 32 * (wid & 3);
    const bf16* wrow = a.SW + ((size_t)h * CHUNK + t0 + r32) * CHUNK + 8 * hi;
    bf16x8 wf[8];
#pragma unroll
    for (int q = 0; q < 8; ++q) if (16 * q < t0 + 32) wf[q] = *(const GAS bf16x8*)(wrow + 16 * q);
#pragma unroll
    for (int k = 0; k < 4; ++k) { const int i = tid + 512 * k, hl2 = i >> 10, row = (i >> 3) & 127, ch = i & 7;
        *(LAS v4u*)(F.lds + RING_OFF + hl2 * SGU_V_BYTES + (ch >> 2) * 8192 + row * 64 + (ch & 3) * 16) = st.vv[k];
        *(LAS v4u*)(F.lds + RING_OFF + SGU_UOFF + hl2 * SGU_U_BYTES + row * SGU_U_PITCH + ch * 16) = st.uu[k]; }
    LDS_BAR();
    if (next_unit >= 0) sgu_load(a, next_unit, tid, st);
    f32x16 acc[2]; acc[0] = f32x16{}; acc[1] = f32x16{};
    const LAS unsigned char* vbase = F.lds + RING_OFF + hl * SGU_V_BYTES + (8 * hi + ((lane & 15) >> 2)) * 64 + 32 * ((lane >> 4) & 1) + 8 * (lane & 3);
#pragma unroll
    for (int q = 0; q < 8; ++q) if (16 * q < t0 + 32) {
#pragma unroll
        for (int d0 = 0; d0 < 2; ++d0) {
            const s16x4 lo = __builtin_bit_cast(s16x4, __builtin_amdgcn_ds_read_tr16_b64_v4i16((LAS s16x4*)(vbase + d0 * 8192 + q * 1024)));
            const s16x4 hh = __builtin_bit_cast(s16x4, __builtin_amdgcn_ds_read_tr16_b64_v4i16((LAS s16x4*)(vbase + d0 * 8192 + q * 1024 + 256)));
            const bf16x8 vf = (bf16x8){lo[0], lo[1], lo[2], lo[3], hh[0], hh[1], hh[2], hh[3]};
            acc[d0] = __builtin_amdgcn_mfma_f32_32x32x16_bf16(vf, wf[q], acc[d0], 0, 0, 0);
        }
    }
    const float bias = a.sgu_b[h * CHUNK + t0 + r32];
    LAS unsigned char* urow = F.lds + RING_OFF + SGU_UOFF + hl * SGU_U_BYTES + (t0 + r32) * SGU_U_PITCH;
    float y[2][16]; float ss = 0.f;
#pragma unroll
    for (int d0 = 0; d0 < 2; ++d0)
#pragma unroll
        for (int g = 0; g < 4; ++g) { const u32x2 uw = *(const LAS u32x2*)(urow + (32 * d0 + 8 * g + 4 * hi) * 2);
            const float u0 = __builtin_bit_cast(float, uw.x << 16), u1 = __builtin_bit_cast(float, uw.x & 0xffff0000u), u2 = __builtin_bit_cast(float, uw.y << 16), u3 = __builtin_bit_cast(float, uw.y & 0xffff0000u);
            y[d0][4 * g + 0] = u0 * (acc[d0][4 * g + 0] + bias); y[d0][4 * g + 1] = u1 * (acc[d0][4 * g + 1] + bias); y[d0][4 * g + 2] = u2 * (acc[d0][4 * g + 2] + bias); y[d0][4 * g + 3] = u3 * (acc[d0][4 * g + 3] + bias);
            ss += (y[d0][4 * g] * y[d0][4 * g] + y[d0][4 * g + 1] * y[d0][4 * g + 1]) + (y[d0][4 * g + 2] * y[d0][4 * g + 2] + y[d0][4 * g + 3] * y[d0][4 * g + 3]); }
    ss += __shfl_xor(ss, 32);
    const float rs = __builtin_amdgcn_rsqf(ss * (1.0f / 64.0f) + EPS) * Y_SCALE;
#pragma unroll
    for (int d0 = 0; d0 < 2; ++d0)
#pragma unroll
        for (int g = 0; g < 4; ++g) { const f32x4 gg = *(const GAS f32x4*)(a.ona_g + h * 64 + 32 * d0 + 8 * g + 4 * hi);
            int w = __builtin_amdgcn_cvt_pk_fp8_f32(y[d0][4 * g] * rs * gg.x, y[d0][4 * g + 1] * rs * gg.y, 0, false); w = __builtin_amdgcn_cvt_pk_fp8_f32(y[d0][4 * g + 2] * rs * gg.z, y[d0][4 * g + 3] * rs * gg.w, w, true);
            *(LAS int*)(urow + (32 * d0 + 8 * g + 4 * hi)) = w; }
    LDS_WAIT(); asm volatile("" ::: "memory");
#pragma unroll
    for (int i = 0; i < 2; ++i) { const int row = t0 + i * 16 + (lane >> 2), ch = lane & 3;
        const v4u vv = *(const LAS v4u*)(F.lds + RING_OFF + SGU_UOFF + hl * SGU_U_BYTES + row * SGU_U_PITCH + ch * 16);
        *(GAS v4u*)(a.Y + (row0 + row) * DM + h * 64 + ch * 16) = vv; }
    LDS_BAR();
}
struct Args { const float* in[16]; float* out; unsigned char* ws; };
__global__ void __launch_bounds__(NWAVES * 64, 2) mega_fwd(Args args) {
    extern __shared__ __attribute__((aligned(16))) unsigned char lds[];
    Frame F;
    F.lds = (LAS unsigned char*)lds;
    F.MISC = (volatile LAS unsigned*)(F.lds + MISC_OFF);
    F.tid = threadIdx.x; F.lane = F.tid & 63; F.wave = __builtin_amdgcn_readfirstlane(F.tid >> 6);
    F.G = gridDim.x; { const int bx = blockIdx.x; F.vcu = (F.G % 8 == 0) ? (bx % 8) * (F.G / 8) + bx / 8 : bx; }
    unsigned char* ws = args.ws;
    F.ctl = (gu32*)(ws + WS_CTL);
    const float* x = args.in[0]; const float* norm1_g = args.in[1]; const float* w_in = args.in[2]; const float* ln_g = args.in[3]; const float* ln_b = args.in[4];
    const float* sgu_w = args.in[5]; const float* sgu_b = args.in[6]; const float* q_g = args.in[7]; const float* k_g = args.in[8]; const float* ona_g = args.in[9]; const float* onb_g = args.in[10];
    const float* w_out = args.in[11]; const float* norm2_g = args.in[12]; const float* w_gate = args.in[13]; const float* w_up = args.in[14]; const float* w_down = args.in[15];
    float* out = args.out;
    bf16* WinT = (bf16*)(ws + WS_WIN); unsigned char* WoQ = ws + WS_WO; unsigned char* WguQ = ws + WS_WGU; unsigned char* WdQ = ws + WS_WD; unsigned char* X1Q = ws + WS_X1Q; bf16* SW = (bf16*)(ws + WS_SW);
    float* ksum = (float*)(ws + WS_KSUM); float* rowss = (float*)(ws + WS_ROWSS);
    bf16* XB = (bf16*)(ws + WS_XN); bf16* X1B = (bf16*)(ws + WS_X1B); float* rstd1 = (float*)(ws + WS_RSTD1); unsigned char* YQ = ws + WS_Y; bf16* PROJ = (bf16*)(ws + WS_PROJ); unsigned char* HIDQ = ws + WS_PROJ;
    for (int u = F.tid; u < (PAR_OFF - LDSCTL_OFF) / 4; u += NWAVES * 64) ((LAS unsigned*)(F.lds + LDSCTL_OFF))[u] = 0u;
    { LAS float* par = (LAS float*)(F.lds + PAR_OFF);
      for (int i = F.tid; i < 1152; i += NWAVES * 64) par[i] = (i < 512) ? ln_g[i] : (i < 1024) ? ln_b[i - 512] : (i < 1088) ? q_g[i - 1024] * C2 : k_g[i - 1088]; }
    __syncthreads();
    constexpr unsigned MAGIC = 0x600DF1A6u;
    if (blockIdx.x == 0) {
        for (int i = F.tid; i < XCD_BAR_WORDS; i += NWAVES * 64) F.ctl[CW_BAR + i] = 0u;
        if (F.tid < 64) F.ctl[F.tid] = 0u;
        asm volatile("s_waitcnt vmcnt(0)" ::: "memory"); __syncthreads();
        if (F.tid == 0) { __builtin_amdgcn_fence(__ATOMIC_RELEASE, "agent"); asm volatile("s_waitcnt vmcnt(0)" ::: "memory"); __hip_atomic_store(F.ctl + CW_START, MAGIC, RLX_AGENT); }
    }
    const P0Args p0a{x, norm1_g, w_in, sgu_w, w_out, norm2_g, w_gate, w_up, w_down, WinT, WoQ, WguQ, WdQ, SW, XB, rstd1};
    const bool late = (F.G == 256);

    XcdBarrier bar; bar.bar = (unsigned*)(F.ctl + CW_BAR); bar.x = xb_xcc_id(); bar.st = F.MISC + 8;
    bool joined = false;
    auto join = [&]() { if (F.tid == 0) { if (blockIdx.x != 0) { unsigned sp = 0; while (__hip_atomic_load(F.ctl + CW_START, RLX_AGENT) != MAGIC) { __builtin_amdgcn_s_sleep(2); if (++sp > (1u << 22)) break; } }
                                          (void)xb_add(&bar.bar[XB_XCNT(bar.x)], 1u); } joined = true; };
    p0_prologue(F, p0a, [&]() { if (late) join(); }); if (!late) { wset_convert(F, p0a, 1, F.vcu, F.G); wset_convert(F, p0a, 2, F.vcu, F.G); }
    if (!joined) join();
    xcd_barrier(bar);

    {
        pg8::Gemm g{XB, WinT, M, INW, DM}; pg8::P1Unit U; U.init(M, INW, F.G, (int)blockIdx.x);
        U.P = PROJ; U.par = (const LAS float*)(F.lds + PAR_OFF); U.ksum = ksum; U.rp.src = rstd1; U.rp.slots = (LAS float*)(F.lds + RSL_OFF); U.rp.mul = 1.0f;
        pg8::gemm_phase<pg8::P1Unit, pg8::P1Unit, PG8_ALIGN, PG8_SP2>(F.lds + RING_OFF, g, U, U);
        if (late && blockIdx.x >= 128) wset_convert(F, p0a, 1, (int)blockIdx.x - 128, 128);
        xcd_barrier(bar);
    }

    {
        const SguArgs sa{PROJ, SW, sgu_b, ona_g, YQ};
        if (late) { SguStage sst; const int u0 = ((F.vcu >> 5) << 6) | (F.vcu & 31);
          sgu_load(sa, u0, F.tid, sst); sgu_unit(F, sa, u0, sst, u0 + 32); sgu_unit(F, sa, u0 + 32, sst, -1); }
        else { SguStage sst; int u = F.vcu; if (u < BATCH * 16 * 4) sgu_load(sa, u, F.tid, sst);
          for (; u < BATCH * 16 * 4; u += F.G) { const int un = u + F.G; sgu_unit(F, sa, u, sst, un < BATCH * 16 * 4 ? un : -1); } }
        static_assert(attn_body::ATTN_LDS_BYTES <= RING_BYTES && attn_body::ATTN_PITCH == INW && attn_body::YSC == Y_SCALE, "attention body geometry / output scale vs frame");
        const attn_body::AttnTensors AT{(const attn_body::bf16*)(PROJ + COL_Q), (const attn_body::bf16*)(PROJ + COL_K), (const attn_body::bf16*)(PROJ + COL_V), YQ + WA, ksum, onb_g};
        const attn_body::StaticOrder S((int)F.G, (int)blockIdx.x);
        attn_body::attn_phase<attn_body::StaticOrder>((char*)lds + RING_OFF, AT, S);
        xcd_barrier(bar);
    }

    {
        pg8::Gemm g{(const bf16*)YQ, (const bf16*)WoQ, M, DM, DM / 2}; pg8::StaticOrder S; S.init(M, DM, F.G, (int)blockIdx.x);
        pg8::EpiOutProj E{XB, X1B, X1Q, rowss};
        if (F.G == 256) pg8::gemm_phase<pg8::EpiOutProj, pg8::StaticOrder, false, PG8_SP2, true>(F.lds + RING_OFF, g, S, E);
        xcd_barrier(bar);
    }

    {
        pg8::Gemm g{(const bf16*)X1Q, (const bf16*)WguQ, M, NGU, DM / 2}; pg8::P4Unit U; U.init(M, NGU, F.G, (int)blockIdx.x);
        U.H = HIDQ; U.rp.src = rowss; U.rp.slots = (LAS float*)(F.lds + RSL_OFF); U.rp.mul = 1.0f / WGU_SCALE;
        pg8::gemm_phase<pg8::P4Unit, pg8::P4Unit, PG8_ALIGN, PG8_SP2, true>(F.lds + RING_OFF, g, U, U);
        if (late && blockIdx.x >= 128) wset_convert(F, p0a, 2, (int)blockIdx.x - 128, 128);
        xcd_barrier(bar);
    }

    {
        pg8::Gemm g{(const bf16*)HIDQ, (const bf16*)WdQ, M, DM, DFF / 2}; pg8::StaticOrder S; S.init(M, DM, F.G, (int)blockIdx.x);
        pg8::EpiDown E{X1B, out};
        pg8::gemm_phase<pg8::EpiDown, pg8::StaticOrder, PG8_ALIGN, PG8_SP2, true>(F.lds + RING_OFF, g, S, E);
    }
    asm volatile("s_waitcnt vmcnt(0)" ::: "memory"); __syncthreads();
    if (F.tid == 0) { const unsigned old = __hip_atomic_fetch_add(F.ctl + CW_EXIT, 1u, RLX_AGENT); if (old == (unsigned)F.G - 1u) __hip_atomic_store(F.ctl + CW_START, 0u, RLX_AGENT); }
}

extern "C" void kernel_launch(void* const* d_in, const int* in_sizes, int n_in, void* d_out, int out_size, void* d_ws, size_t ws_size, hipStream_t stream) {
    static int grid = 0;
    if (grid == 0) {
        if (n_in != 16 || in_sizes[0] != M * DM || out_size != M * DM || ws_size < WS_END) { fprintf(stderr, "kernel_launch: built for 16 inputs, x and out of %d floats, >= %zu bytes of workspace; got n_in %d, in0 %d, out %d, ws %zu; nothing launched\n", M * DM, (size_t)WS_END, n_in, n_in > 0 ? in_sizes[0] : -1, out_size, ws_size); grid = -1; return; }
        int dev = 0, cus = 0, per_cu = 0;
        if (hipGetDevice(&dev) != hipSuccess || hipDeviceGetAttribute(&cus, hipDeviceAttributeMultiprocessorCount, dev) != hipSuccess) { fprintf(stderr, "kernel_launch: hipGetDevice / hipDeviceGetAttribute failed; nothing launched\n"); grid = -1; return; }
        if (hipFuncSetAttribute((const void*)mega_fwd, hipFuncAttributeMaxDynamicSharedMemorySize, LDS_BYTES) != hipSuccess) { fprintf(stderr, "kernel_launch: hipFuncSetAttribute failed\n"); grid = -1; return; }
        if (hipOccupancyMaxActiveBlocksPerMultiprocessor(&per_cu, (const void*)mega_fwd, NWAVES * 64, LDS_BYTES) != hipSuccess || per_cu < 1) { fprintf(stderr, "kernel_launch: occupancy query reports %d workgroups per CU; nothing launched\n", per_cu); (void)hipGetLastError(); grid = -1; return; }
        grid = cus;
        if (grid != 256) fprintf(stderr, "kernel_launch: %d CUs; the out-proj phase needs exactly 256 workgroups\n", grid);
    }
    if (grid < 0) return;
    Args a{};
    for (int i = 0; i < 16; ++i) a.in[i] = (const float*)d_in[i];
    a.out = (float*)d_out; a.ws = (unsigned char*)d_ws;
    hipLaunchKernelGGL(mega_fwd, dim3(grid), dim3(NWAVES * 64), LDS_BYTES, stream, a);
    const hipError_t le = hipPeekAtLastError();
    if (le != hipSuccess) fprintf(stderr, "kernel_launch: launch failed: %s (grid %d x %d threads, %d B LDS)\n", hipGetErrorName(le), grid, NWAVES * 64, LDS_BYTES);
}
```
